# Optimizing an MI355X kernel written in HIP

```python
import jax, jax.numpy as jnp
from jax import lax
import numpy as np

D_MODEL = 2048
BATCH = 2
SEQ = 4096
DEPTH = 2

N_A_LAYERS = DEPTH // 2
N_B_LAYERS = DEPTH - N_A_LAYERS
N_SUB = 3
D_FF = ((8 * D_MODEL // 3 + 255) // 256) * 256

HGRN_HEAD_DIM = 128
HGRN_HEADS = D_MODEL // HGRN_HEAD_DIM
HGRN_CHUNK = 64

ATTN_HEAD_DIM = 128
ATTN_HEADS = D_MODEL // ATTN_HEAD_DIM
ATTN_KV_HEADS = ATTN_HEADS // 4
MOBA_BLOCK = 256
MOBA_TOP_K = 3
MOBA_Q_CHUNK = 16
ROPE_THETA = 10000.0
EPS = 1e-6

kernel_name = "yoco_hgrn2_moba_macaron_adaln"


def rms_norm(x, gain):
    xf = x.astype(jnp.float32)
    y = xf * lax.rsqrt(jnp.mean(xf * xf, axis=-1, keepdims=True) + EPS)
    return (y * gain.astype(jnp.float32)).astype(x.dtype)


def split_heads(a, n):
    b, t, _ = a.shape
    return a.reshape(b, t, n, -1).transpose(0, 2, 1, 3)


def merge_heads(a):
    b, n, t, hd = a.shape
    return a.transpose(0, 2, 1, 3).reshape(b, t, n * hd)


def rotary(x, positions):
    half = x.shape[-1] // 2
    inv = ROPE_THETA ** (-jnp.arange(half, dtype=jnp.float32) / half)
    ang = positions.astype(jnp.float32)[:, None] * inv[None, :]
    cos, sin = jnp.cos(ang), jnp.sin(ang)
    xf = x.astype(jnp.float32)
    x1, x2 = xf[..., :half], xf[..., half:]
    return jnp.concatenate([x1 * cos - x2 * sin, x2 * cos + x1 * sin], axis=-1).astype(x.dtype)


def swiglu(h, w_gate_up, w_down):
    g, u = jnp.split(h @ w_gate_up, 2, axis=-1)
    return (jax.nn.silu(g) * u) @ w_down


def sublayer(x, shift, scale, gate, pre, post, weight, y_fn):
    h = rms_norm(x, pre) * (1.0 + scale[:, None, :]) + shift[:, None, :]
    y = rms_norm(y_fn(h), post)
    return x + weight * gate[:, None, :] * y


def hgrn2_chunk_scan(q, k, v, log_f):
    b, h, t, dk = q.shape
    dv = v.shape[-1]
    n = t // HGRN_CHUNK

    def to_chunks(a):
        return a.reshape(b, h, n, HGRN_CHUNK, a.shape[-1]).transpose(2, 0, 1, 3, 4).astype(jnp.float32)

    causal = jnp.tril(jnp.ones((HGRN_CHUNK, HGRN_CHUNK), dtype=bool))[None, None, :, :, None]

    def step(state, inp):
        qi, ki, vi, gi = inp
        cum = jnp.cumsum(gi, axis=2)
        o_inter = jnp.einsum('bhtd,bhde->bhte', qi * jnp.exp(cum), state)
        rel = jnp.where(causal, cum[:, :, :, None, :] - cum[:, :, None, :, :], -jnp.inf)
        att = jnp.einsum('bhtd,bhsd,bhtsd->bhts', qi, ki, jnp.exp(rel))
        o_intra = jnp.einsum('bhts,bhse->bhte', att, vi)
        last = cum[:, :, -1:, :]
        new_state = jnp.exp(last[:, :, 0, :])[..., None] * state + jnp.einsum(
            'bhsd,bhse->bhde', ki * jnp.exp(last - cum), vi)
        return new_state, o_inter + o_intra

    s0 = jnp.zeros((b, h, dk, dv), jnp.float32)
    _, o = lax.scan(step, s0, (to_chunks(q), to_chunks(k), to_chunks(v), to_chunks(log_f)))
    return o.transpose(1, 2, 0, 3, 4).reshape(b, h, t, dv)


def hgrn2_mixer(h, w_in, lower_bound, g_norm, w_out):
    b, t, d = h.shape
    q, f, i, g = jnp.split(h @ w_in, 4, axis=-1)
    q = jax.nn.silu(q)
    forget = lower_bound + (1.0 - lower_bound) * jax.nn.sigmoid(f.astype(jnp.float32))
    k = 1.0 - forget
    o = hgrn2_chunk_scan(split_heads(q, HGRN_HEADS), split_heads(k, HGRN_HEADS),
                         split_heads(i, HGRN_HEADS), split_heads(jnp.log(forget), HGRN_HEADS))
    o = rms_norm(o.transpose(0, 2, 1, 3), g_norm).reshape(b, t, d).astype(h.dtype)
    return (o * jax.nn.silu(g)) @ w_out


def shared_kv(x, kv_norm, w_kv, positions):
    b, t, _ = x.shape
    k, v = jnp.split(rms_norm(x, kv_norm) @ w_kv, 2, axis=-1)
    k = rotary(split_heads(k, ATTN_KV_HEADS), positions)
    v = split_heads(v, ATTN_KV_HEADS)
    rep = ATTN_HEADS // ATTN_KV_HEADS
    k = jnp.repeat(k, rep, axis=1)
    v = jnp.repeat(v, rep, axis=1)
    t_pad = -(-t // MOBA_BLOCK) * MOBA_BLOCK
    pad = ((0, 0), (0, 0), (0, t_pad - t), (0, 0))
    nb = t_pad // MOBA_BLOCK
    k_blocks = jnp.pad(k, pad).reshape(b, ATTN_HEADS, nb, MOBA_BLOCK, ATTN_HEAD_DIM)
    v_blocks = jnp.pad(v, pad).reshape(b, ATTN_HEADS, nb, MOBA_BLOCK, ATTN_HEAD_DIM)
    k_mean = jnp.mean(k_blocks.astype(jnp.float32), axis=3)
    return k_blocks, v_blocks, k_mean


def moba_attention(q, k_blocks, v_blocks, k_mean):
    b, h, t, hd = q.shape
    nb = k_blocks.shape[2]
    t_pad = nb * MOBA_BLOCK
    n_q = t_pad // MOBA_Q_CHUNK
    k_sel = min(MOBA_TOP_K, nb)
    q = jnp.pad(q, ((0, 0), (0, 0), (0, t_pad - t), (0, 0)))
    q_chunks = q.reshape(b, h, n_q, MOBA_Q_CHUNK, hd).transpose(2, 0, 1, 3, 4)
    starts = jnp.arange(n_q, dtype=jnp.int32) * MOBA_Q_CHUNK
    bi = jnp.arange(b)[:, None, None, None]
    hi = jnp.arange(h)[None, :, None, None]
    scale = hd ** -0.5

    def one_chunk(args):
        qi, start = args
        own = start // MOBA_BLOCK
        gate = jnp.einsum('bhqd,bhnd->bhqn', qi.astype(jnp.float32), k_mean)
        gate = jnp.where(jnp.arange(nb) < own, gate, -jnp.inf)
        _, top_idx = lax.top_k(gate, k_sel)
        sel_valid = jnp.arange(k_sel) < own
        k_g = k_blocks[bi, hi, top_idx]
        v_g = v_blocks[bi, hi, top_idx]
        s_sel = jnp.einsum('bhqd,bhqkpd->bhqkp', qi, k_g).astype(jnp.float32) * scale
        s_sel = jnp.where(sel_valid[:, None], s_sel, -jnp.inf).reshape(b, h, MOBA_Q_CHUNK, k_sel * MOBA_BLOCK)
        k_own = lax.dynamic_index_in_dim(k_blocks, own, axis=2, keepdims=False)
        v_own = lax.dynamic_index_in_dim(v_blocks, own, axis=2, keepdims=False)
        s_own = jnp.einsum('bhqd,bhpd->bhqp', qi, k_own).astype(jnp.float32) * scale
        q_pos = start + jnp.arange(MOBA_Q_CHUNK)
        k_pos = own * MOBA_BLOCK + jnp.arange(MOBA_BLOCK)
        s_own = jnp.where(k_pos[None, :] <= q_pos[:, None], s_own, -jnp.inf)
        p = jax.nn.softmax(jnp.concatenate([s_sel, s_own], axis=-1), axis=-1)
        p_sel = p[..., :k_sel * MOBA_BLOCK].reshape(b, h, MOBA_Q_CHUNK, k_sel, MOBA_BLOCK).astype(v_g.dtype)
        p_own = p[..., k_sel * MOBA_BLOCK:].astype(v_own.dtype)
        return (jnp.einsum('bhqkp,bhqkpd->bhqd', p_sel, v_g)
                + jnp.einsum('bhqp,bhpd->bhqd', p_own, v_own))

    o = lax.map(one_chunk, (q_chunks, starts))
    return o.transpose(1, 2, 0, 3, 4).reshape(b, h, t_pad, hd)[:, :, :t]


def moba_mixer(h, w_q, w_o, kv, positions):
    q = rotary(split_heads(h @ w_q, ATTN_HEADS), positions)
    k_blocks, v_blocks, k_mean = kv
    return merge_heads(moba_attention(q, k_blocks, v_blocks, k_mean)) @ w_o


def setup_inputs(seed: int = 0) -> dict:
    key = jax.random.key(seed)
    ks = jax.random.split(key, 16)
    d, f = D_MODEL, D_FF
    nrm = jax.random.normal
    return {
        "x": nrm(ks[0], (BATCH, SEQ, d), jnp.float32),
        "c": nrm(ks[1], (BATCH, d), jnp.float32),
        "ada_w": nrm(ks[2], (DEPTH, d, N_SUB * 3 * d), jnp.float32) * (0.5 * d ** -0.5),
        "ada_b": nrm(ks[3], (DEPTH, N_SUB * 3 * d), jnp.float32) * 0.02,
        "norm_pre": 1.0 + 0.05 * nrm(ks[4], (DEPTH, N_SUB, d), jnp.float32),
        "norm_post": 1.0 + 0.05 * nrm(ks[5], (DEPTH, N_SUB, d), jnp.float32),
        "ffn_w_gate_up": nrm(ks[6], (DEPTH, 2, d, 2 * f), jnp.float32) * d ** -0.5,
        "ffn_w_down": nrm(ks[7], (DEPTH, 2, f, d), jnp.float32) * f ** -0.5,
        "hgrn_w_in": nrm(ks[8], (N_A_LAYERS, d, 4 * d), jnp.float32) * d ** -0.5,
        "hgrn_lb": nrm(ks[9], (N_A_LAYERS + 1, d), jnp.float32) * 0.1,
        "hgrn_gnorm": 1.0 + 0.05 * nrm(ks[10], (N_A_LAYERS, HGRN_HEAD_DIM), jnp.float32),
        "hgrn_w_out": nrm(ks[11], (N_A_LAYERS, d, d), jnp.float32) * d ** -0.5,
        "kv_norm": 1.0 + 0.05 * nrm(ks[12], (d,), jnp.float32),
        "w_kv": nrm(ks[13], (d, 2 * ATTN_KV_HEADS * ATTN_HEAD_DIM), jnp.float32) * d ** -0.5,
        "moba_w_q": nrm(ks[14], (N_B_LAYERS, d, ATTN_HEADS * ATTN_HEAD_DIM), jnp.float32) * d ** -0.5,
        "moba_w_o": nrm(ks[15], (N_B_LAYERS, ATTN_HEADS * ATTN_HEAD_DIM, d), jnp.float32) * d ** -0.5,
    }


def reference(x, c, ada_w, ada_b, norm_pre, norm_post, ffn_w_gate_up, ffn_w_down,
              hgrn_w_in, hgrn_lb, hgrn_gnorm, hgrn_w_out, kv_norm, w_kv, moba_w_q, moba_w_o):
    b, t, d = x.shape
    positions = jnp.arange(t, dtype=jnp.int32)
    lower_bounds = jnp.cumsum(jax.nn.softmax(hgrn_lb.astype(jnp.float32), axis=0), axis=0)
    kv = None
    for l in range(DEPTH):
        if l == N_A_LAYERS:
            kv = shared_kv(x, kv_norm, w_kv, positions)
        mods = (jax.nn.silu(c) @ ada_w[l] + ada_b[l]).reshape(b, N_SUB, 3, d)

        x = sublayer(x, mods[:, 0, 0], mods[:, 0, 1], mods[:, 0, 2], norm_pre[l, 0], norm_post[l, 0], 0.5,
                     lambda h: swiglu(h, ffn_w_gate_up[l, 0], ffn_w_down[l, 0]))
        if l < N_A_LAYERS:
            x = sublayer(x, mods[:, 1, 0], mods[:, 1, 1], mods[:, 1, 2], norm_pre[l, 1], norm_post[l, 1], 1.0,
                         lambda h: hgrn2_mixer(h, hgrn_w_in[l], lower_bounds[l], hgrn_gnorm[l], hgrn_w_out[l]))
        else:
            j = l - N_A_LAYERS
            x = sublayer(x, mods[:, 1, 0], mods[:, 1, 1], mods[:, 1, 2], norm_pre[l, 1], norm_post[l, 1], 1.0,
                         lambda h: moba_mixer(h, moba_w_q[j], moba_w_o[j], kv, positions))
        x = sublayer(x, mods[:, 2, 0], mods[:, 2, 1], mods[:, 2, 2], norm_pre[l, 2], norm_post[l, 2], 0.5,
                     lambda h: swiglu(h, ffn_w_gate_up[l, 1], ffn_w_down[l, 1]))
    return x
```

```cpp
#include <hip/hip_runtime.h>
#include <cstdio>
#include <cstdint>

typedef _Float16 f16;
typedef unsigned short u16;
typedef float f32x4 __attribute__((ext_vector_type(4)));
typedef float f32x2 __attribute__((ext_vector_type(2)));
typedef _Float16 f16x2 __attribute__((ext_vector_type(2)));
typedef _Float16 f16x4 __attribute__((ext_vector_type(4)));
typedef _Float16 f16x8 __attribute__((ext_vector_type(8)));
typedef unsigned u32x4 __attribute__((ext_vector_type(4)));

constexpr int DM = 2048, BATCH = 2, SEQ = 4096, M = BATCH * SEQ, FF = 5632, MODW = 9 * DM;
constexpr int HD = 128, NH = 16, NKV = 4, MBLK = 256, NBLK = SEQ / MBLK;
constexpr float EPS = 1e-6f;
constexpr float ATT_SCALE = 0.08838834764831845f;

constexpr size_t MiB = 1u << 20;
constexpr size_t WS_CTL = 0;
constexpr size_t WS_MODS = 1 * MiB;
constexpr size_t WS_LBT = 1 * MiB + 512 * 1024;
constexpr size_t WS_ROPE = 2 * MiB;
constexpr size_t WS_KMEAN = 4 * MiB;
constexpr size_t WS_H = 8 * MiB;
constexpr size_t WS_HKV = 40 * MiB;
constexpr size_t WS_Y = 72 * MiB;
constexpr size_t WS_K = 136 * MiB;
constexpr size_t WS_V = 144 * MiB;
constexpr size_t WS_ST = 152 * MiB;
constexpr size_t WS_RA = 176 * MiB;
constexpr size_t WS_QH = WS_RA, WS_KH = WS_RA + 32 * MiB, WS_VH = WS_RA + 64 * MiB, WS_GH = WS_RA + 96 * MiB, WS_LF = WS_RA + 128 * MiB, WS_OG = WS_RA + 192 * MiB;
constexpr size_t WS_ACT = WS_RA;
constexpr size_t WS_Q = WS_RA, WS_O = WS_RA + 32 * MiB;
constexpr size_t WS_C = 400 * MiB;
constexpr size_t WS_W16 = 752 * MiB;
constexpr size_t WS_END = 1100 * MiB;

__device__ __forceinline__ float silu_f(float x) { return x / (1.f + __expf(-x)); }
__device__ __forceinline__ float wave_sum(float v) {
#pragma unroll
    for (int o = 1; o < 64; o <<= 1) v += __shfl_xor(v, o);
    return v;
}

__device__ __forceinline__ u16 f2bf(float f) { unsigned u = __builtin_bit_cast(unsigned, f); return (u16)((u + 0x7fffu + ((u >> 16) & 1u)) >> 16); }
__device__ __forceinline__ float bf2f(u16 b) { return __builtin_bit_cast(float, (unsigned)b << 16); }
__device__ __forceinline__ int lane_id_opaque() { int l; asm volatile("v_mbcnt_lo_u32_b32 %0, -1, 0\n\tv_mbcnt_hi_u32_b32 %0, -1, %0" : "=v"(l)); return l; }

__global__ __launch_bounds__(512) void k_mods(const float* __restrict__ c, const float* __restrict__ ada_w, const float* __restrict__ ada_b, float* __restrict__ mods) {
    __shared__ float sc[2][DM];
    __shared__ float red[8][2][64];
    const int tid = threadIdx.x, lane = tid & 63, w = tid >> 6;
    for (int i = tid; i < 2 * DM; i += 512) sc[i / DM][i % DM] = silu_f(c[i]);
    __syncthreads();
    const int nchunk = MODW / 64;
    for (int u = blockIdx.x; u < 2 * nchunk; u += gridDim.x) {
        const int l = u / nchunk, c0 = (u % nchunk) * 64;
        const float* W = ada_w + (size_t)l * DM * MODW + c0 + lane;
        float a0 = 0.f, a1 = 0.f;
        const int k0 = w * 256;
#pragma unroll 8
        for (int k = 0; k < 256; ++k) { const float wv = W[(size_t)(k0 + k) * MODW]; a0 += sc[0][k0 + k] * wv; a1 += sc[1][k0 + k] * wv; }
        red[w][0][lane] = a0; red[w][1][lane] = a1;
        __syncthreads();
        if (tid < 128) { const int b = tid >> 6; float s = 0.f;
#pragma unroll
            for (int ww = 0; ww < 8; ++ww) s += red[ww][b][lane];
            mods[(size_t)(l * 2 + b) * MODW + c0 + lane] = s + ada_b[(size_t)l * MODW + c0 + lane]; }
        __syncthreads();
    }
}
__global__ void k_rope(float* __restrict__ rope) {
    const int i = blockIdx.x * blockDim.x + threadIdx.x;
    if (i >= SEQ * 64) return;
    const int t = i / 64, d = i % 64;
    const float inv = powf(10000.0f, -(float)d / 64.0f);
    const float ang = (float)t * inv;
    float s, c; sincosf(ang, &s, &c);
    rope[i] = c; rope[SEQ * 64 + i] = s;
}

struct NormArgs {
    const float* x_in; const float* y; float* x_out; f16* h; f16* h2;
    const float* gate; const float* post; const float* pre; const float* scale; const float* shift; const float* kvn;
    float w; int has_y, has_h, has_kv, pad;
};
__device__ __forceinline__ void norm_rows(const NormArgs& a, int gw, int ngw, int lane) {
    for (int row = gw; row < M; row += ngw) {
        const int b = row / SEQ;
        const f32x4* xr = (const f32x4*)(a.x_in + (size_t)row * DM) + lane;
        f32x4 v[8];
#pragma unroll
        for (int j = 0; j < 8; ++j) v[j] = xr[64 * j];
        if (a.has_y) {
            const f32x4* yr = (const f32x4*)(a.y + (size_t)row * DM) + lane;
            f32x4 yv[8]; float s = 0.f;
#pragma unroll
            for (int j = 0; j < 8; ++j) { yv[j] = yr[64 * j]; s += (yv[j].x * yv[j].x + yv[j].y * yv[j].y) + (yv[j].z * yv[j].z + yv[j].w * yv[j].w); }
            const float r1 = rsqrtf(wave_sum(s) * (1.f / DM) + EPS) * a.w;
            const f32x4* gp = (const f32x4*)(a.gate + (size_t)b * MODW) + lane; const f32x4* pp = (const f32x4*)a.post + lane;
#pragma unroll
            for (int j = 0; j < 8; ++j) { const f32x4 g = gp[64 * j], p = pp[64 * j]; v[j] = v[j] + (yv[j] * r1) * p * g; }
            f32x4* xo = (f32x4*)(a.x_out + (size_t)row * DM) + lane;
#pragma unroll
            for (int j = 0; j < 8; ++j) xo[64 * j] = v[j];
        }
        if (a.has_h || a.has_kv) {
            float s = 0.f;
#pragma unroll
            for (int j = 0; j < 8; ++j) s += (v[j].x * v[j].x + v[j].y * v[j].y) + (v[j].z * v[j].z + v[j].w * v[j].w);
            const float r2 = rsqrtf(wave_sum(s) * (1.f / DM) + EPS);
            if (a.has_h) {
                const f32x4* pp = (const f32x4*)a.pre + lane; const f32x4* sp = (const f32x4*)(a.scale + (size_t)b * MODW) + lane; const f32x4* hp = (const f32x4*)(a.shift + (size_t)b * MODW) + lane;
                f16x4* ho = (f16x4*)(a.h + (size_t)row * DM) + lane;
#pragma unroll
                for (int j = 0; j < 8; ++j) { const f32x4 p = pp[64 * j], sc = sp[64 * j], sh = hp[64 * j]; const f32x4 o = (v[j] * r2) * p * (sc + 1.f) + sh;
                    ho[64 * j] = __builtin_convertvector(o, f16x4); }
            }
            if (a.has_kv) {
                const f32x4* pp = (const f32x4*)a.kvn + lane; f16x4* ho = (f16x4*)(a.h2 + (size_t)row * DM) + lane;
#pragma unroll
                for (int j = 0; j < 8; ++j) { const f32x4 o = (v[j] * r2) * pp[64 * j]; ho[64 * j] = __builtin_convertvector(o, f16x4); }
            }
        }
    }
}
__global__ __launch_bounds__(512) void k_norm(NormArgs a) {
    const int lane = threadIdx.x & 63, w = threadIdx.x >> 6;
    norm_rows(a, blockIdx.x * 8 + w, gridDim.x * 8, lane);
}


namespace pg8 {
#define PG8_LAS __attribute__((address_space(3)))
typedef unsigned short bf16_t;
typedef _Float16 bf16x8 __attribute__((ext_vector_type(8)));
typedef float f32x4 __attribute__((ext_vector_type(4)));
typedef unsigned u32x4 __attribute__((ext_vector_type(4)));
constexpr int BM = 256, BK = 64, HALF = 128, HTB = HALF * BK * 2  , STAGE_BYTES = 8 * HTB, NXCD = 8, WGM = 8;

__host__ __device__ __forceinline__ int lds_byte(int r, int c) { const int st = (r >> 4) * 2 + (c >> 5), rr = r & 15, cc = c & 31, ob = rr * 64 + cc * 2; return st * 1024 + (ob ^ (((ob >> 9) & 1) << 5)); }
__host__ __device__ __forceinline__ void stage_rc(int b, int& R, int& C) { const int st = b / 1024, sb = b % 1024, swz = sb ^ (((sb >> 9) & 1) << 5); R = (st >> 1) * 16 + swz / 64; C = (st & 1) * 32 + (swz % 64) / 2; }
__host__ __device__ __forceinline__ int perm32(int rho) { const int n = rho >> 4, i = rho & 15; return 8 * (i >> 2) + 4 * n + (i & 3); }

struct Unit { int pm, pn; };
struct Gemm { const bf16_t* A; const bf16_t* Bt; int M, N, K; };

struct StaticOrder {
    int nM, nN, nwg, G, c;
    __host__ __device__ void init(int M, int N, int G_, int c_) { nM = M / BM; nN = N / BM; nwg = nM * nN; G = G_; c = c_; }
    __host__ __device__ bool next(int i, Unit& u) const {
        const long L = (long)i * G + c; if (L >= nwg) return false;
        int wgid = (int)L; { const int q = nwg / NXCD, r = nwg % NXCD, xcd = wgid % NXCD, off = wgid / NXCD; wgid = (xcd < r ? xcd * (q + 1) : r * (q + 1) + (xcd - r) * q) + off; }
        const int nig = WGM * nN, gid = wgid / nig, fm = gid * WGM, gsz = (nM - fm) < WGM ? (nM - fm) : WGM;
        u.pm = fm + ((wgid % nig) % gsz); u.pn = (wgid % nig) / gsz; return true;
    }
    __device__ __forceinline__ void a_ready(const Unit&) const {}
    __device__ __forceinline__ void done(const Unit&) const {}
};
template <class Epi, class Sched, bool ALIGN_EPI = false, bool SP2 = false>
__device__ __forceinline__ void gemm_phase(PG8_LAS unsigned char* lds, const Gemm g, const Sched& S, const Epi& E, const int wid  ) {
    const int lane = lane_id_opaque(), tid = wid * 64 + lane, wr = wid >> 2, wc = wid & 3, fr = lane & 15, fq = lane >> 4;
    const int K = g.K, nt = K / BK;
    unsigned voffA[2], voffB[2];
#pragma unroll
    for (int i = 0; i < 2; ++i) { int R, C; stage_rc(tid * 16 + i * 8192, R, C); const int Rb = Epi::PERM ? ((R & ~31) + perm32(R & 31)) : R;
        voffA[i] = (unsigned)(R * K + C) * 2u; voffB[i] = (unsigned)(Rb * K + C) * 2u; }
    const size_t kstep = (size_t)(BK * 2);
    const size_t hstep = (size_t)HALF * K * 2;
    const size_t tstep = 2 * hstep;
    const unsigned ldsw = (unsigned)wid * 1024u;
    const int aoff = lds_byte(wr * 64 + fr, fq * 8), boff = lds_byte(wc * 32 + fr, fq * 8);
#define PG8_SA(b, h) (((b) * 2 + (h)) * HTB)
#define PG8_SB(b, h) ((4 + (b) * 2 + (h)) * HTB)
#define PG8_STAGE(bufoff, gbase, voff) do { _Pragma("unroll") for (int _i = 0; _i < 2; ++_i) \
        __builtin_amdgcn_global_load_lds((const unsigned*)((const char*)(gbase) + (voff)[_i]), (PG8_LAS unsigned*)(lds + (bufoff) + ldsw + _i * 8192), 16, 0, 0); } while (0)
#define PG8_LDA(dst, b, h) do { _Pragma("unroll") for (int m = 0; m < 4; ++m) _Pragma("unroll") for (int k = 0; k < 2; ++k) dst[m][k] = *(const PG8_LAS bf16x8*)(lds + PG8_SA(b, h) + aoff + m * 2048 + k * 1024); } while (0)
#define PG8_LDB(dst, b, h) do { _Pragma("unroll") for (int n = 0; n < 2; ++n) _Pragma("unroll") for (int k = 0; k < 2; ++k) dst[n][k] = *(const PG8_LAS bf16x8*)(lds + PG8_SB(b, h) + boff + n * 2048 + k * 1024); } while (0)
#define PG8_MMA(ai, bj, At, Bt) do { __builtin_amdgcn_s_setprio(1); _Pragma("unroll") for (int m = 0; m < 4; ++m) _Pragma("unroll") for (int n = 0; n < 2; ++n) _Pragma("unroll") for (int k = 0; k < 2; ++k) \
        acc[ai][bj][m][n] = __builtin_amdgcn_mfma_f32_16x16x32_f16(Bt[n][k], At[m][k], acc[ai][bj][m][n], 0, 0, 0); __builtin_amdgcn_s_setprio(0); } while (0)
#define PG8_WAIT_V(n) asm volatile("s_waitcnt vmcnt(" #n ")" ::: "memory")
#define PG8_WAIT_L(n) asm volatile("s_waitcnt lgkmcnt(" #n ")" ::: "memory")
#define PG8_BAR __builtin_amdgcn_s_barrier()
#define PG8_SCHED __builtin_amdgcn_sched_barrier(0)
    Unit cur, nxt; int ui = 0;
    if (!S.next(0, cur)) return;
    f32x4 acc[2][2][4][2];
#pragma unroll
    for (int a = 0; a < 2; ++a)
#pragma unroll
        for (int b = 0; b < 2; ++b)
#pragma unroll
            for (int m = 0; m < 4; ++m)
#pragma unroll
                for (int n = 0; n < 2; ++n) acc[a][b][m][n] = (f32x4){0.f, 0.f, 0.f, 0.f};
    bf16x8 At[4][2], B0[2][2], B1[2][2];
    const char* cA = (const char*)g.A + (size_t)cur.pm * tstep; const char* cB = (const char*)g.Bt + (size_t)cur.pn * tstep;
    S.a_ready(cur);
    if constexpr (SP2) {
        PG8_STAGE(PG8_SB(0, 0), cB, voffB); PG8_STAGE(PG8_SB(0, 1), cB + hstep, voffB); PG8_STAGE(PG8_SA(0, 0), cA, voffA); PG8_STAGE(PG8_SA(0, 1), cA + hstep, voffA);
        if (wr == 1) PG8_BAR;
        PG8_WAIT_V(2); PG8_BAR;
        PG8_STAGE(PG8_SB(1, 0), cB + kstep, voffB); PG8_STAGE(PG8_SA(1, 0), cA + kstep, voffA); PG8_STAGE(PG8_SB(1, 1), cB + hstep + kstep, voffB);
        PG8_WAIT_V(6); PG8_BAR;
    } else {
        PG8_STAGE(PG8_SB(0, 0), cB, voffB); PG8_STAGE(PG8_SA(0, 0), cA, voffA); PG8_STAGE(PG8_SB(0, 1), cB + hstep, voffB); PG8_STAGE(PG8_SA(0, 1), cA + hstep, voffA);
        if (wr == 1) PG8_BAR;
        PG8_WAIT_V(4); PG8_BAR;
        PG8_STAGE(PG8_SB(1, 0), cB + kstep, voffB); PG8_STAGE(PG8_SA(1, 0), cA + kstep, voffA); PG8_STAGE(PG8_SB(1, 1), cB + hstep + kstep, voffB);
        PG8_WAIT_V(6); PG8_BAR;
    }
    for (;;) {
        const bool has_next = S.next(ui + 1, nxt);
        const char* nA = has_next ? (const char*)g.A + (size_t)nxt.pm * tstep : cA; const char* nB = has_next ? (const char*)g.Bt + (size_t)nxt.pn * tstep : cB;
        for (int t = 0; t < nt; t += 2) {
            const bool last = (t == nt - 2);
            const char* a1 = cA + (size_t)(t + 1) * kstep;
            const char* a2 = last ? nA : cA + (size_t)(t + 2) * kstep; const char* b2 = last ? nB : cB + (size_t)(t + 2) * kstep;
            const char* a3 = a2 + kstep; const char* b3 = b2 + kstep;
            if (last && has_next) S.a_ready(nxt);
            if constexpr (SP2) {
            PG8_LDB(B0, 0, 0); PG8_LDB(B1, 0, 1); PG8_SCHED; PG8_LDA(At, 0, 0); PG8_STAGE(PG8_SA(1, 1), a1 + hstep, voffA);
            PG8_WAIT_V(8); PG8_WAIT_L(0); PG8_BAR; PG8_MMA(0, 0, At, B0); PG8_MMA(0, 1, At, B1); PG8_BAR; PG8_SCHED;
            PG8_LDA(At, 0, 1); PG8_STAGE(PG8_SB(0, 0), b2, voffB); PG8_STAGE(PG8_SB(0, 1), b2 + hstep, voffB); PG8_STAGE(PG8_SA(0, 0), a2, voffA);
            PG8_WAIT_V(8); PG8_WAIT_L(0); PG8_BAR; PG8_MMA(1, 0, At, B0); PG8_MMA(1, 1, At, B1); PG8_BAR; PG8_SCHED;
            PG8_LDB(B0, 1, 0); PG8_LDB(B1, 1, 1); PG8_SCHED; PG8_LDA(At, 1, 0); PG8_STAGE(PG8_SA(0, 1), a2 + hstep, voffA);
            PG8_WAIT_V(8); PG8_WAIT_L(0); PG8_BAR; PG8_MMA(0, 0, At, B0); PG8_MMA(0, 1, At, B1); PG8_BAR; PG8_SCHED;
            PG8_LDA(At, 1, 1); PG8_STAGE(PG8_SB(1, 0), b3, voffB); PG8_STAGE(PG8_SB(1, 1), b3 + hstep, voffB); PG8_STAGE(PG8_SA(1, 0), a3, voffA);
            PG8_WAIT_V(8); PG8_WAIT_L(0); PG8_BAR; PG8_MMA(1, 0, At, B0); PG8_MMA(1, 1, At, B1); PG8_BAR; PG8_SCHED;
            } else {
            PG8_LDB(B0, 0, 0); PG8_SCHED; PG8_LDA(At, 0, 0); PG8_STAGE(PG8_SA(1, 1), a1 + hstep, voffA);
            PG8_WAIT_L(8); PG8_BAR; PG8_WAIT_L(0); PG8_MMA(0, 0, At, B0); PG8_BAR; PG8_SCHED;
            PG8_LDB(B1, 0, 1); PG8_STAGE(PG8_SB(0, 0), b2, voffB);
            PG8_BAR; PG8_WAIT_L(0); PG8_MMA(0, 1, At, B1); PG8_BAR;
            PG8_LDA(At, 0, 1); PG8_STAGE(PG8_SA(0, 0), a2, voffA);
            PG8_BAR; PG8_WAIT_L(0); PG8_MMA(1, 0, At, B0); PG8_BAR; PG8_SCHED;
            PG8_STAGE(PG8_SB(0, 1), b2 + hstep, voffB);
            PG8_WAIT_V(6); PG8_BAR; PG8_MMA(1, 1, At, B1); PG8_BAR;
            PG8_LDB(B0, 1, 0); PG8_SCHED; PG8_LDA(At, 1, 0); PG8_STAGE(PG8_SA(0, 1), a2 + hstep, voffA);
            PG8_WAIT_L(8); PG8_BAR; PG8_WAIT_L(0); PG8_MMA(0, 0, At, B0); PG8_BAR; PG8_SCHED;
            PG8_LDB(B1, 1, 1); PG8_STAGE(PG8_SB(1, 0), b3, voffB);
            PG8_BAR; PG8_WAIT_L(0); PG8_MMA(0, 1, At, B1); PG8_BAR;
            PG8_LDA(At, 1, 1); PG8_STAGE(PG8_SA(1, 0), a3, voffA);
            PG8_BAR; PG8_WAIT_L(0); PG8_MMA(1, 0, At, B0); PG8_BAR; PG8_SCHED;
            PG8_STAGE(PG8_SB(1, 1), b3 + hstep, voffB);
            PG8_WAIT_V(6); PG8_BAR; PG8_MMA(1, 1, At, B1); PG8_BAR;
            }
        }
        if constexpr (ALIGN_EPI) { if (wr == 0) PG8_BAR; }
        if constexpr (!Epi::AFTER_DRAIN) { E(acc, cur, wr, wc, fr, fq); S.done(cur); }
        if (!has_next) break;
#pragma unroll
        for (int a = 0; a < 2; ++a)
#pragma unroll
            for (int b = 0; b < 2; ++b)
#pragma unroll
                for (int m = 0; m < 4; ++m)
#pragma unroll
                    for (int n = 0; n < 2; ++n) acc[a][b][m][n] = (f32x4){0.f, 0.f, 0.f, 0.f};
        cur = nxt; cA = nA; cB = nB; ++ui;
        if constexpr (ALIGN_EPI) { if (wr == 1) PG8_BAR; }
    }
    PG8_WAIT_V(0);
    if constexpr (!ALIGN_EPI) { if (wr == 0) PG8_BAR; }
    PG8_BAR;
    if constexpr (Epi::AFTER_DRAIN) { E.fused(acc, cur, wr, wc, fr, fq, lds, wid, lane); S.done(cur); }
#undef PG8_SA
#undef PG8_SB
#undef PG8_STAGE
#undef PG8_LDA
#undef PG8_LDB
#undef PG8_MMA
#undef PG8_WAIT_V
#undef PG8_WAIT_L
#undef PG8_BAR
#undef PG8_SCHED
}
}

namespace pg8 {
typedef _Float16 h16x8 __attribute__((ext_vector_type(8)));
typedef float f32x8 __attribute__((ext_vector_type(8)));
__device__ __forceinline__ h16x8 cvt8(f32x4 a, f32x4 b) { const f32x8 v = {a[0], a[1], a[2], a[3], b[0], b[1], b[2], b[3]}; return __builtin_convertvector(v, h16x8); }
__device__ __forceinline__ float silu1(float x) { return x * __builtin_amdgcn_rcpf(1.f + __expf(-x)); }
__device__ __forceinline__ f32x4 silu4(f32x4 x) { return (f32x4){silu1(x[0]), silu1(x[1]), silu1(x[2]), silu1(x[3])}; }

struct EpiF32 {
    static constexpr bool PERM = false, AFTER_DRAIN = false;
    float* C; int ldc;
    __device__ __forceinline__ void operator()(const f32x4 (&acc)[2][2][4][2], const Unit& u, int wr, int wc, int, int) const {
        const int lane_ = lane_id_opaque(); const int fr = lane_ & 15, fq = lane_ >> 4;
        const int row0 = u.pm * BM + wr * 64 + fr, col0 = u.pn * BM + wc * 32 + 4 * fq;
#pragma unroll
        for (int ai = 0; ai < 2; ++ai)
#pragma unroll
            for (int m = 0; m < 4; ++m) { float* rowp = C + (size_t)(row0 + ai * HALF + m * 16) * ldc + col0;
#pragma unroll
                for (int bj = 0; bj < 2; ++bj)
#pragma unroll
                    for (int n = 0; n < 2; ++n) *(f32x4*)(rowp + bj * HALF + n * 16) = acc[ai][bj][m][n]; }
    }
};
struct EpiSwiGLU {
    static constexpr bool PERM = true, AFTER_DRAIN = false;
    f16* act;
    __device__ __forceinline__ void operator()(const f32x4 (&acc)[2][2][4][2], const Unit& u, int wr, int wc, int, int) const {
        const int lane_ = lane_id_opaque(); const int fr = lane_ & 15, fq = lane_ >> 4;
        const int row0 = u.pm * BM + wr * 64 + fr, col0 = u.pn * 128 + wc * 32 + 8 * fq;
#pragma unroll
        for (int ai = 0; ai < 2; ++ai)
#pragma unroll
            for (int m = 0; m < 4; ++m) {
                const f32x4 o0 = silu4(acc[ai][0][m][0]) * acc[ai][1][m][0], o1 = silu4(acc[ai][0][m][1]) * acc[ai][1][m][1];
                *(h16x8*)(act + (size_t)(row0 + ai * HALF + m * 16) * FF + col0) = cvt8(o0, o1); }
    }
};
struct EpiHgrn {
    static constexpr bool PERM = true, AFTER_DRAIN = false;
    f16* qh; f16* kh; u16* vh; f16* gh; float* lf; const float* lb;
    __device__ __forceinline__ void operator()(const f32x4 (&acc)[2][2][4][2], const Unit& u, int wr, int wc, int, int) const {
        const int lane_ = lane_id_opaque(); const int fr = lane_ & 15, fq = lane_ >> 4;
        const int grp = u.pn >> 3, row0 = u.pm * BM + wr * 64 + fr, col0 = (u.pn & 7) * BM + wc * 32 + 8 * fq;
        if (grp == 1) {
#pragma unroll
            for (int bj = 0; bj < 2; ++bj) {
                const f32x4 lba = *(const f32x4*)(lb + col0 + bj * HALF), lbb = *(const f32x4*)(lb + col0 + bj * HALF + 4);
#pragma unroll
                for (int ai = 0; ai < 2; ++ai)
#pragma unroll
                    for (int m = 0; m < 4; ++m) { const size_t ro = (size_t)(row0 + ai * HALF + m * 16) * DM + col0 + bj * HALF; f32x4 kk[2], lg[2];
#pragma unroll
                        for (int n = 0; n < 2; ++n)
#pragma unroll
                            for (int j = 0; j < 4; ++j) { const float l = n ? lbb[j] : lba[j]; const float sg = __builtin_amdgcn_rcpf(1.f + __expf(-acc[ai][bj][m][n][j])); const float fg = l + (1.f - l) * sg;
                                kk[n][j] = 1.f - fg; lg[n][j] = __logf(fg); }
                        *(h16x8*)(kh + ro) = cvt8(kk[0], kk[1]);
                        *(f32x4*)(lf + ro) = lg[0]; *(f32x4*)(lf + ro + 4) = lg[1];
                        asm volatile("" ::: "memory"); }
            }
        } else if (grp == 2) {
#pragma unroll
            for (int ai = 0; ai < 2; ++ai)
#pragma unroll
                for (int m = 0; m < 4; ++m) { const size_t ro = (size_t)(row0 + ai * HALF + m * 16) * DM + col0;
#pragma unroll
                    for (int bj = 0; bj < 2; ++bj) { const f32x4 a = acc[ai][bj][m][0], b = acc[ai][bj][m][1];
                        u32x4 w; w.x = f2bf(a[0]) | ((unsigned)f2bf(a[1]) << 16); w.y = f2bf(a[2]) | ((unsigned)f2bf(a[3]) << 16); w.z = f2bf(b[0]) | ((unsigned)f2bf(b[1]) << 16); w.w = f2bf(b[2]) | ((unsigned)f2bf(b[3]) << 16);
                        *(u32x4*)(vh + ro + bj * HALF) = w; } }
        } else {
            f16* dst = grp == 0 ? qh : gh;
#pragma unroll
            for (int ai = 0; ai < 2; ++ai)
#pragma unroll
                for (int m = 0; m < 4; ++m) { const size_t ro = (size_t)(row0 + ai * HALF + m * 16) * DM + col0;
#pragma unroll
                    for (int bj = 0; bj < 2; ++bj) *(h16x8*)(dst + ro + bj * HALF) = cvt8(silu4(acc[ai][bj][m][0]), silu4(acc[ai][bj][m][1])); }
        }
    }
};
struct EpiRot {
    static constexpr bool PERM = true, AFTER_DRAIN = false;
    f16* dst; int nheads; const float* rope; float* kmean; f16* vdst; int nrot;
    __device__ __forceinline__ void operator()(const f32x4 (&acc)[2][2][4][2], const Unit& u, int wr, int wc, int, int) const {
        const int lane_ = lane_id_opaque(); const int fr = lane_ & 15, fq = lane_ >> 4;
        const int b = u.pm >> 4, t0 = (u.pm & 15) * BM + wr * 64 + fr;
        if (u.pn < nrot) {
            const int head = 2 * u.pn + (wc >> 1), dd0 = 32 * (wc & 1) + 8 * fq;
            f16* base = dst + ((size_t)(b * nheads + head) * SEQ) * 128 + dd0;
            f32x4 s1a = {0.f, 0.f, 0.f, 0.f}, s1b = s1a, s2a = s1a, s2b = s1a;
#pragma unroll
            for (int ai = 0; ai < 2; ++ai)
#pragma unroll
                for (int m = 0; m < 4; ++m) { const int t = t0 + ai * HALF + m * 16;
                    const f32x4 c0 = *(const f32x4*)(rope + t * 64 + dd0), c1 = *(const f32x4*)(rope + t * 64 + dd0 + 4), s0 = *(const f32x4*)(rope + SEQ * 64 + t * 64 + dd0), s1 = *(const f32x4*)(rope + SEQ * 64 + t * 64 + dd0 + 4);
                    const f32x4 xa = acc[ai][0][m][0], xb = acc[ai][0][m][1], ya = acc[ai][1][m][0], yb = acc[ai][1][m][1];
                    const f32x4 o1a = xa * c0 - ya * s0, o1b = xb * c1 - yb * s1, o2a = ya * c0 + xa * s0, o2b = yb * c1 + xb * s1;
                    *(h16x8*)(base + (size_t)t * 128) = cvt8(o1a, o1b); *(h16x8*)(base + (size_t)t * 128 + 64) = cvt8(o2a, o2b);
                    s1a += o1a; s1b += o1b; s2a += o2a; s2b += o2b; }
            if (kmean) {
#pragma unroll
                for (int j = 0; j < 4; ++j) {
#pragma unroll
                    for (int o = 1; o < 16; o <<= 1) { s1a[j] += __shfl_xor(s1a[j], o); s1b[j] += __shfl_xor(s1b[j], o); s2a[j] += __shfl_xor(s2a[j], o); s2b[j] += __shfl_xor(s2b[j], o); } }
                if (fr == 0) { float* km = kmean + ((size_t)(b * nheads + head) * NBLK + (u.pm & 15)) * 128 + dd0;
#pragma unroll
                    for (int j = 0; j < 4; ++j) { atomicAdd(km + j, s1a[j] * (1.f / MBLK)); atomicAdd(km + 4 + j, s1b[j] * (1.f / MBLK)); atomicAdd(km + 64 + j, s2a[j] * (1.f / MBLK)); atomicAdd(km + 68 + j, s2b[j] * (1.f / MBLK)); } }
            }
        } else {
            const int d0 = 32 * wc + 8 * fq;
#pragma unroll
            for (int bj = 0; bj < 2; ++bj) { f16* base = vdst + ((size_t)(b * nheads + 2 * (u.pn - nrot) + bj) * SEQ) * 128 + d0;
#pragma unroll
                for (int ai = 0; ai < 2; ++ai)
#pragma unroll
                    for (int m = 0; m < 4; ++m) *(h16x8*)(base + (size_t)(t0 + ai * HALF + m * 16) * 128) = cvt8(acc[ai][bj][m][0], acc[ai][bj][m][1]); }
        }
    }
};
}

__global__ __launch_bounds__(256) void k_naive_gemm(const f16* __restrict__ A, const float* __restrict__ W, float* __restrict__ C, int N, int K) {
    __shared__ float As[16][132];
    __shared__ float Bs[16][132];
    const int tid = threadIdx.x, tx = tid & 15, ty = tid >> 4;
    const int bm = blockIdx.y * 128, bn = blockIdx.x * 128;
    float acc[8][8];
#pragma unroll
    for (int i = 0; i < 8; ++i)
#pragma unroll
        for (int j = 0; j < 8; ++j) acc[i][j] = 0.f;
    const int ar = tid >> 1, ac = (tid & 1) * 8;
    const int br = tid >> 4, bc = (tid & 15) * 8;
    for (int k0 = 0; k0 < K; k0 += 16) {
        const f16x8 av = *(const f16x8*)(A + (size_t)(bm + ar) * K + k0 + ac);
        const f32x4 b0 = *(const f32x4*)(W + (size_t)(k0 + br) * N + bn + bc), b1 = *(const f32x4*)(W + (size_t)(k0 + br) * N + bn + bc + 4);
        __syncthreads();
#pragma unroll
        for (int i = 0; i < 8; ++i) As[ac + i][ar] = (float)av[i];
        *(f32x4*)&Bs[br][bc] = b0; *(f32x4*)&Bs[br][bc + 4] = b1;
        __syncthreads();
#pragma unroll
        for (int kk = 0; kk < 16; ++kk) {
            float a[8], b[8];
            const f32x4 a0 = *(const f32x4*)&As[kk][ty * 8], a1 = *(const f32x4*)&As[kk][ty * 8 + 4];
            const f32x4 bb0 = *(const f32x4*)&Bs[kk][tx * 8], bb1 = *(const f32x4*)&Bs[kk][tx * 8 + 4];
            a[0] = a0.x; a[1] = a0.y; a[2] = a0.z; a[3] = a0.w; a[4] = a1.x; a[5] = a1.y; a[6] = a1.z; a[7] = a1.w;
            b[0] = bb0.x; b[1] = bb0.y; b[2] = bb0.z; b[3] = bb0.w; b[4] = bb1.x; b[5] = bb1.y; b[6] = bb1.z; b[7] = bb1.w;
#pragma unroll
            for (int i = 0; i < 8; ++i)
#pragma unroll
                for (int j = 0; j < 8; ++j) acc[i][j] += a[i] * b[j];
        }
    }
#pragma unroll
    for (int i = 0; i < 8; ++i) {
        float* cp = C + (size_t)(bm + ty * 8 + i) * N + bn + tx * 8;
        *(f32x4*)cp = (f32x4){acc[i][0], acc[i][1], acc[i][2], acc[i][3]}; *(f32x4*)(cp + 4) = (f32x4){acc[i][4], acc[i][5], acc[i][6], acc[i][7]};
    }
}
__global__ void k_naive_ffn_act(const float* __restrict__ C, f16* __restrict__ act) {
    const size_t i = (size_t)blockIdx.x * blockDim.x + threadIdx.x;
    if (i >= (size_t)M * FF) return;
    const size_t m = i / FF, j = i % FF;
    act[i] = (f16)(silu_f(C[m * (2 * FF) + j]) * C[m * (2 * FF) + FF + j]);
}
__global__ void k_naive_hgrn_split(const float* __restrict__ C, const float* __restrict__ hgrn_lb, f16* __restrict__ qh, f16* __restrict__ kh, u16* __restrict__ vh, f16* __restrict__ gh, float* __restrict__ lf) {
    const size_t i = (size_t)blockIdx.x * blockDim.x + threadIdx.x;
    if (i >= (size_t)M * DM) return;
    const size_t m = i / DM, j = i % DM;
    const float* c = C + m * (4 * DM);
    const float l0 = hgrn_lb[j], l1 = hgrn_lb[DM + j];
    const float lb = 1.f / (1.f + expf(l1 - l0));
    const float sg = 1.f / (1.f + expf(-c[DM + j]));
    const float forget = lb + (1.f - lb) * sg;
    qh[i] = (f16)silu_f(c[j]);
    kh[i] = (f16)(1.f - forget);
    lf[i] = logf(forget);
    vh[i] = f2bf(c[2 * DM + j]);
    gh[i] = (f16)silu_f(c[3 * DM + j]);
}
__global__ __launch_bounds__(128) void k_naive_scan(const f16* __restrict__ qh, const f16* __restrict__ kh, const u16* __restrict__ vh, const f16* __restrict__ gh, const float* __restrict__ lf,
                                                   const float* __restrict__ gnorm, f16* __restrict__ og) {
    __shared__ float qs[8][128], ks[8][128], fs[8][128];
    __shared__ float red[2];
    const int b = blockIdx.x / NH, h = blockIdx.x % NH, e = threadIdx.x;
    float S[128];
#pragma unroll
    for (int d = 0; d < 128; ++d) S[d] = 0.f;
    const float gn = gnorm[e];
    for (int t0 = 0; t0 < SEQ; t0 += 8) {
        __syncthreads();
#pragma unroll
        for (int i = 0; i < 8; ++i) { const size_t o = (size_t)(b * SEQ + t0 + i) * DM + h * 128 + e; qs[i][e] = (float)qh[o]; ks[i][e] = (float)kh[o]; fs[i][e] = __expf(lf[o]); }
        __syncthreads();
        for (int i = 0; i < 8; ++i) {
            const size_t o = (size_t)(b * SEQ + t0 + i) * DM + h * 128 + e;
            const float v = bf2f(vh[o]);
            float acc = 0.f;
#pragma unroll
            for (int d = 0; d < 128; d += 4) {
                const f32x4 f = *(const f32x4*)&fs[i][d], k = *(const f32x4*)&ks[i][d], q = *(const f32x4*)&qs[i][d];
                S[d] = f.x * S[d] + k.x * v; S[d + 1] = f.y * S[d + 1] + k.y * v; S[d + 2] = f.z * S[d + 2] + k.z * v; S[d + 3] = f.w * S[d + 3] + k.w * v;
                acc += S[d] * q.x + S[d + 1] * q.y + S[d + 2] * q.z + S[d + 3] * q.w;
            }
            const float ss = wave_sum(acc * acc);
            __syncthreads();
            if ((e & 63) == 0) red[e >> 6] = ss;
            __syncthreads();
            const float rstd = rsqrtf((red[0] + red[1]) * (1.f / 128.f) + EPS);
            og[o] = (f16)(acc * rstd * gn * (float)gh[o]);
        }
    }
}
__global__ void k_naive_kv_split(const float* __restrict__ C, const float* __restrict__ rope, f16* __restrict__ K, f16* __restrict__ V) {
    const size_t i = (size_t)blockIdx.x * blockDim.x + threadIdx.x;
    if (i >= (size_t)M * 512) return;
    const int m = (int)(i / 512), j = (int)(i % 512), hh = j / 128, d = j % 128, b = m / SEQ, t = m % SEQ;
    const float* c = C + (size_t)m * 1024;
    const int dd = d & 63; const float cs = rope[t * 64 + dd], sn = rope[SEQ * 64 + t * 64 + dd];
    const float x1 = c[hh * 128 + dd], x2 = c[hh * 128 + dd + 64];
    const float r = d < 64 ? x1 * cs - x2 * sn : x2 * cs + x1 * sn;
    const size_t o = ((size_t)(b * NKV + hh) * SEQ + t) * 128 + d;
    K[o] = (f16)r; V[o] = (f16)c[512 + j];
}
__global__ void k_naive_kmean(const float* __restrict__ C, const float* __restrict__ rope, float* __restrict__ kmean) {
    const int i = blockIdx.x * blockDim.x + threadIdx.x;
    if (i >= BATCH * NKV * NBLK * 128) return;
    const int d = i % 128, blk = (i / 128) % NBLK, hh = (i / (128 * NBLK)) % NKV, b = i / (128 * NBLK * NKV);
    const int dd = d & 63; float s = 0.f;
    for (int tt = 0; tt < MBLK; ++tt) { const int t = blk * MBLK + tt; const float* c = C + (size_t)(b * SEQ + t) * 1024;
        const float cs = rope[t * 64 + dd], sn = rope[SEQ * 64 + t * 64 + dd], x1 = c[hh * 128 + dd], x2 = c[hh * 128 + dd + 64];
        s += d < 64 ? x1 * cs - x2 * sn : x2 * cs + x1 * sn; }
    kmean[i] = s * (1.f / MBLK);
}
__global__ void k_naive_q_split(const float* __restrict__ C, const float* __restrict__ rope, f16* __restrict__ Q) {
    const size_t i = (size_t)blockIdx.x * blockDim.x + threadIdx.x;
    if (i >= (size_t)M * DM) return;
    const int m = (int)(i / DM), j = (int)(i % DM), hh = j / 128, d = j % 128, b = m / SEQ, t = m % SEQ;
    const float* c = C + (size_t)m * DM;
    const int dd = d & 63; const float cs = rope[t * 64 + dd], sn = rope[SEQ * 64 + t * 64 + dd];
    const float x1 = c[hh * 128 + dd], x2 = c[hh * 128 + dd + 64];
    const float r = d < 64 ? x1 * cs - x2 * sn : x2 * cs + x1 * sn;
    Q[((size_t)(b * NH + hh) * SEQ + t) * 128 + d] = (f16)r;
}
__global__ __launch_bounds__(256) void k_naive_attn(const f16* __restrict__ Q, const f16* __restrict__ K, const f16* __restrict__ V, const float* __restrict__ kmean, f16* __restrict__ O) {
    __shared__ float qs[4][128];
    __shared__ float sc[4][4 * MBLK];
    const int w = threadIdx.x >> 6, lane = threadIdx.x & 63;
    const int qi = blockIdx.x * 4 + w;
    const int t = qi % SEQ, bh = qi / SEQ, h = bh % NH, b = bh / NH, kvh = h / (NH / NKV), own = t / MBLK;
    const f16* q = Q + (size_t)qi * 128;
    qs[w][lane] = (float)q[lane]; qs[w][lane + 64] = (float)q[lane + 64];
    __syncthreads();
    float g = -__builtin_inff();
    if (lane < own) { const float* km = kmean + ((size_t)(b * NKV + kvh) * NBLK + lane) * 128; float s = 0.f; for (int d = 0; d < 128; ++d) s += qs[w][d] * km[d]; g = s; }
    int b0 = 0, b1 = 0, b2 = 0, b3 = 0; const int nsel = own < 3 ? own : 3;
    for (int s = 0; s < 3; ++s) {
        float best = g; int bi = lane;
#pragma unroll
        for (int o = 1; o < 64; o <<= 1) { const float ob = __shfl_xor(best, o); const int oi = __shfl_xor(bi, o); if (ob > best || (ob == best && oi < bi)) { best = ob; bi = oi; } }
        if (s == 0) b0 = bi; else if (s == 1) b1 = bi; else b2 = bi;
        if (lane == bi) g = -__builtin_inff();
    }
    if (nsel == 0) b0 = own; else if (nsel == 1) b1 = own; else if (nsel == 2) b2 = own; else b3 = own;
    const int nb = nsel + 1;
#define BLK_OF(s) ((s) == 0 ? b0 : (s) == 1 ? b1 : (s) == 2 ? b2 : b3)
    const f16* Kb = K + (size_t)(b * NKV + kvh) * SEQ * 128; const f16* Vb = V + (size_t)(b * NKV + kvh) * SEQ * 128;
    float mx = -__builtin_inff();
    for (int s = 0; s < nb; ++s) {
        const int blk = BLK_OF(s);
        for (int kk = lane; kk < MBLK; kk += 64) {
            const int key = blk * MBLK + kk; float a = -__builtin_inff();
            if (key <= t) { const f16x8* kr = (const f16x8*)(Kb + (size_t)key * 128); float acc = 0.f;
                for (int d8 = 0; d8 < 16; ++d8) { const f16x8 kv = kr[d8];
#pragma unroll
                    for (int j = 0; j < 8; ++j) acc += qs[w][d8 * 8 + j] * (float)kv[j]; }
                a = acc * ATT_SCALE; }
            sc[w][s * MBLK + kk] = a; mx = fmaxf(mx, a);
        }
    }
#pragma unroll
    for (int o = 1; o < 64; o <<= 1) mx = fmaxf(mx, __shfl_xor(mx, o));
    float sum = 0.f;
    for (int i = lane; i < nb * MBLK; i += 64) { const float p = __expf(sc[w][i] - mx); sc[w][i] = p; sum += p; }
    sum = wave_sum(sum);
    __syncthreads();
    float o0 = 0.f, o1 = 0.f;
    for (int s = 0; s < nb; ++s) { const int blk = BLK_OF(s);
        for (int kk = 0; kk < MBLK; ++kk) { const float p = sc[w][s * MBLK + kk]; if (p != 0.f) { const f16x2 vv = *(const f16x2*)(Vb + (size_t)(blk * MBLK + kk) * 128 + 2 * lane); o0 += p * (float)vv[0]; o1 += p * (float)vv[1]; } } }
    const float inv = 1.f / sum;
    f16x2 ov; ov[0] = (f16)(o0 * inv); ov[1] = (f16)(o1 * inv);
    *(f16x2*)(O + (size_t)(b * SEQ + t) * DM + h * 128 + 2 * lane) = ov;
}


#define LAS __attribute__((address_space(3)))
#define XB_TMO      128
#define XB_XCNT(j)  (256  + 64 * (j))
#define XB_XSUB(j)  (1280 + 64 * (j))
#define XB_XGEN(j)  (2304 + 64 * (j))
#define XB_TOP      3328
#define XB_TOPGEN   3392
#define XCD_BAR_WORDS 3456
#define XB_SPIN_CAP (1u << 18)

__device__ __forceinline__ unsigned xb_ld(unsigned* p)              { return __hip_atomic_load(p, __ATOMIC_RELAXED, __HIP_MEMORY_SCOPE_AGENT); }
__device__ __forceinline__ unsigned xb_add(unsigned* p, unsigned v) { return __hip_atomic_fetch_add(p, v, __ATOMIC_RELAXED, __HIP_MEMORY_SCOPE_AGENT); }
__device__ __forceinline__ unsigned xb_xcc_id() { return (unsigned)__builtin_amdgcn_s_getreg((3 << 11) | 20) & 0xFu; }
#define XB_SPIN(cond, bar) do { unsigned _sp = 0; while (cond) { __builtin_amdgcn_s_sleep(1); \
    if ((++_sp & 255u) == 0u) { if (xb_ld(&(bar)[XB_TMO])) break; if (_sp > XB_SPIN_CAP) { atomicAdd(&(bar)[XB_TMO], 1u); break; } } } } while (0)

struct XcdBarrier {
    unsigned* bar; unsigned x;
    volatile LAS unsigned* st;
};

__device__ __forceinline__ XcdBarrier xcd_barrier_post(unsigned* bar, volatile LAS unsigned* st) {
    XcdBarrier b; b.bar = bar; b.x = xb_xcc_id(); b.st = st;
    if (threadIdx.x == 0) (void)xb_add(&bar[XB_XCNT(b.x)], 1u);
    return b;
}
__device__ __forceinline__ void xcd_barrier_complete(unsigned* bar, unsigned x, unsigned& nloc, unsigned& nx) {
    const unsigned G = gridDim.x * gridDim.y * gridDim.z;
    unsigned sum, cnt, mine, sp = 0u;
    for (;;) {
        sum = 0u; cnt = 0u; mine = 0u;
#pragma unroll
        for (unsigned j = 0; j < 16; ++j) { const unsigned c = xb_ld(&bar[XB_XCNT(j)]); sum += c; cnt += (c > 0u) ? 1u : 0u; mine = (j == x) ? c : mine; }
        if (sum == G) break;
        __builtin_amdgcn_s_sleep(1);
        if ((++sp & 255u) == 0u) { if (xb_ld(&bar[XB_TMO])) break; if (sp > XB_SPIN_CAP) { atomicAdd(&bar[XB_TMO], 1u); break; } }
    }
    nloc = mine > 0u ? mine : 1u; nx = cnt > 0u ? cnt : 1u;
}

__device__ __forceinline__ void xcd_barrier(const XcdBarrier& b, const int wave  ) {
    asm volatile("s_waitcnt vmcnt(0)" ::: "memory");
    __syncthreads();
    if (wave == 0 && lane_id_opaque() == 0) {
        unsigned* bar = b.bar;
        __builtin_amdgcn_s_waitcnt(0);
        unsigned nloc = b.st[0], nx = b.st[1];
        if (nloc == 0u) { xcd_barrier_complete(bar, b.x, nloc, nx); b.st[0] = nloc; b.st[1] = nx; }
        const unsigned old = xb_add(&bar[XB_XSUB(b.x)], 1u);
        const unsigned gen = old / nloc;
        if (old + 1u == (gen + 1u) * nloc) {
            __builtin_amdgcn_fence(__ATOMIC_RELEASE, "agent");
            asm volatile("s_waitcnt vmcnt(0)" ::: "memory");
            const unsigned og = xb_add(&bar[XB_TOP], 1u);
            const unsigned tg = og / nx;
            if (og + 1u == (tg + 1u) * nx) xb_add(&bar[XB_TOPGEN], 1u);
            else XB_SPIN(xb_ld(&bar[XB_TOPGEN]) == tg, bar);
            __builtin_amdgcn_fence(__ATOMIC_ACQUIRE, "agent");
            xb_add(&bar[XB_XGEN(b.x)], 1u);
            asm volatile("s_waitcnt vmcnt(0)" ::: "memory");
        } else {
            XB_SPIN(xb_ld(&bar[XB_XGEN(b.x)]) == gen, bar);
            __builtin_amdgcn_fence(__ATOMIC_ACQUIRE, "agent");
            asm volatile("s_waitcnt vmcnt(0)" ::: "memory");
        }
    }
    __syncthreads();
}

namespace scan {
typedef short bf16x8 __attribute__((ext_vector_type(8)));
typedef short bf16x4 __attribute__((ext_vector_type(4)));
typedef unsigned u32x2 __attribute__((ext_vector_type(2)));
constexpr int QT_STRIDE = 272, KT_STRIDE = 144, OB_STRIDE = 132;
constexpr int SC_QT = 0, SC_KH = 17408, SC_KTT = 34816, SC_VT = 53248, SC_P = 71680, SC_AL = 80896, SC_TW = 81408, SC_OB = 85504, SC_END = SC_OB + 64 * OB_STRIDE * 4;
static_assert(SC_END <= 131072, "scan LDS map");
constexpr size_t ST_ATOT = (size_t)256 * 16384;
__device__ __forceinline__ unsigned pkbf(float lo, float hi) { unsigned r; asm volatile("v_cvt_pk_bf16_f32 %0, %1, %2" : "=v"(r) : "v"(lo), "v"(hi)); return r; }
#define MFMA16(a, b, c) __builtin_amdgcn_mfma_f32_16x16x32_bf16((a), (b), (c), 0, 0, 0)

template <bool PHASE_A>
__device__ __forceinline__ void scan_unit(LAS unsigned char* lds, const int u, const int w, const int lane, const f16* __restrict__ QH, const f16* __restrict__ KH, const u16* __restrict__ VH,
                                          const f16* __restrict__ GH, const float* __restrict__ LF, const float* __restrict__ gnorm, float* __restrict__ ST, f16* __restrict__ OG) {
    const int bh = u >> 3, sc = u & 7, b = bh >> 4, h = bh & 15, fl = lane & 15, g = lane >> 4, tid = w * 64 + lane;
    const size_t tok0 = (size_t)b * SEQ + (size_t)sc * 512;
    const size_t eoff = (size_t)h * 128 + 2 * lane;
    LAS unsigned char* Qt = lds + SC_QT; LAS unsigned char* Kh = lds + SC_KH; LAS unsigned char* KtT = lds + SC_KTT; LAS unsigned char* VT = lds + SC_VT; LAS unsigned char* P = lds + SC_P;
    LAS float* AL = (LAS float*)(lds + SC_AL); LAS float* TW = (LAS float*)(lds + SC_TW); LAS float* OB = (LAS float*)(lds + SC_OB);
    f32x4 X[8];
    float* STu = ST + (size_t)u * 16384;
    if (PHASE_A) {
#pragma unroll
        for (int i = 0; i < 8; ++i) X[i] = (f32x4){0.f, 0.f, 0.f, 0.f};
    } else {
#pragma unroll
        for (int i = 0; i < 8; ++i)
#pragma unroll
            for (int r = 0; r < 4; ++r) X[i][r] = STu[(16 * i + 4 * g + r) * 128 + 16 * w + fl];
    }
    float cs0 = 0.f, cs1 = 0.f;
    unsigned rq[8], rk[8], rv[8]; f32x2 rl[8];
#define SCAN_LOAD(c) do { _Pragma("unroll") for (int i = 0; i < 8; ++i) { const size_t o = (tok0 + (size_t)(c) * 64 + 8 * w + i) * DM + eoff; \
        if (!PHASE_A) rq[i] = *(const unsigned*)(QH + o); rk[i] = *(const unsigned*)(KH + o); rv[i] = *(const unsigned*)(VH + o); rl[i] = *(const f32x2*)(LF + o); } } while (0)
    SCAN_LOAD(0);
    for (int c = 0; c < 8; ++c) {
        float c0[8], c1[8]; { float r0 = 0.f, r1 = 0.f;
#pragma unroll
            for (int i = 0; i < 8; ++i) { r0 += rl[i].x; r1 += rl[i].y; c0[i] = r0; c1[i] = r1; }
            *(LAS f32x2*)(TW + w * 128 + 2 * lane) = (f32x2){r0, r1}; }
        __syncthreads();
        float off0 = 0.f, off1 = 0.f, tot0 = 0.f, tot1 = 0.f;
#pragma unroll
        for (int ww = 0; ww < 8; ++ww) { const f32x2 t = *(const LAS f32x2*)(TW + ww * 128 + 2 * lane); if (ww < w) { off0 += t.x; off1 += t.y; } tot0 += t.x; tot1 += t.y; }
        unsigned kt0[4], kt1[4], vt0[4], vt1[4];
#pragma unroll
        for (int i = 0; i < 8; ++i) {
            const float cu0 = off0 + c0[i], cu1 = off1 + c1[i];
            const f16x2 kk = __builtin_bit_cast(f16x2, rk[i]); const float k0 = (float)kk[0], k1 = (float)kk[1];
            const float t0 = k0 * __expf(tot0 - cu0), t1 = k1 * __expf(tot1 - cu1);
            if (!PHASE_A) {
                const f16x2 qq = __builtin_bit_cast(f16x2, rq[i]);
                *(LAS unsigned*)(Qt + (8 * w + i) * QT_STRIDE + 4 * lane) = pkbf((float)qq[0] * __expf(cu0), (float)qq[1] * __expf(cu1));
                *(LAS unsigned*)(Kh + (8 * w + i) * QT_STRIDE + 4 * lane) = pkbf(k0 * __expf(-cu0), k1 * __expf(-cu1));
            }
            if (i & 1) { kt0[i >> 1] |= (pkbf(t0, 0.f) << 16); kt1[i >> 1] |= (pkbf(t1, 0.f) << 16); vt0[i >> 1] |= (rv[i] << 16); vt1[i >> 1] |= (rv[i] & 0xffff0000u); }
            else { kt0[i >> 1] = pkbf(t0, 0.f) & 0xffffu; kt1[i >> 1] = pkbf(t1, 0.f) & 0xffffu; vt0[i >> 1] = rv[i] & 0xffffu; vt1[i >> 1] = rv[i] >> 16; }
        }
        *(LAS u32x4*)(KtT + (2 * lane) * KT_STRIDE + 16 * w) = (u32x4){kt0[0], kt0[1], kt0[2], kt0[3]};
        *(LAS u32x4*)(KtT + (2 * lane + 1) * KT_STRIDE + 16 * w) = (u32x4){kt1[0], kt1[1], kt1[2], kt1[3]};
        *(LAS u32x4*)(VT + (2 * lane) * KT_STRIDE + 16 * w) = (u32x4){vt0[0], vt0[1], vt0[2], vt0[3]};
        *(LAS u32x4*)(VT + (2 * lane + 1) * KT_STRIDE + 16 * w) = (u32x4){vt1[0], vt1[1], vt1[2], vt1[3]};
        if (w == 0) *(LAS f32x2*)(AL + 2 * lane) = (f32x2){__expf(tot0), __expf(tot1)};
        cs0 += tot0; cs1 += tot1;
        if (c + 1 < 8) SCAN_LOAD(c + 1);
        __syncthreads();
        f32x4 Y[4];
        if (!PHASE_A) {
            const int ti = w >> 1;
#pragma unroll
            for (int sx = 0; sx < 2; ++sx) { const int si = 2 * (w & 1) + sx; f32x4 z = {0.f, 0.f, 0.f, 0.f};
                if (si <= ti) {
#pragma unroll
                    for (int kd = 0; kd < 4; ++kd) { const bf16x8 a = *(const LAS bf16x8*)(Kh + (16 * si + fl) * QT_STRIDE + (32 * kd + 8 * g) * 2), bq = *(const LAS bf16x8*)(Qt + (16 * ti + fl) * QT_STRIDE + (32 * kd + 8 * g) * 2);
                        z = MFMA16(a, bq, z); }
                    const int t = 16 * ti + fl, s0 = 16 * si + 4 * g;
#pragma unroll
                    for (int r = 0; r < 4; ++r) z[r] = (s0 + r <= t) ? z[r] : 0.f;
                }
                *(LAS u32x2*)(P + (16 * ti + fl) * KT_STRIDE + (16 * si + 4 * g) * 2) = (u32x2){pkbf(z[0], z[1]), pkbf(z[2], z[3])}; }
#pragma unroll
            for (int jt = 0; jt < 4; ++jt) Y[jt] = (f32x4){0.f, 0.f, 0.f, 0.f};
#pragma unroll
            for (int i = 0; i < 4; ++i) { const u32x4 aw = {pkbf(X[2 * i][0], X[2 * i][1]), pkbf(X[2 * i][2], X[2 * i][3]), pkbf(X[2 * i + 1][0], X[2 * i + 1][1]), pkbf(X[2 * i + 1][2], X[2 * i + 1][3])};
                const bf16x8 af = __builtin_bit_cast(bf16x8, aw);
#pragma unroll
                for (int jt = 0; jt < 4; ++jt) { const u32x2 lo = *(const LAS u32x2*)(Qt + (16 * jt + fl) * QT_STRIDE + (32 * i + 4 * g) * 2), hi = *(const LAS u32x2*)(Qt + (16 * jt + fl) * QT_STRIDE + (32 * i + 16 + 4 * g) * 2);
                    const u32x4 bw = {lo.x, lo.y, hi.x, hi.y}; Y[jt] = MFMA16(af, __builtin_bit_cast(bf16x8, bw), Y[jt]); } }
            __syncthreads();
        }
        bf16x8 vf[2];
#pragma unroll
        for (int ks = 0; ks < 2; ++ks) vf[ks] = *(const LAS bf16x8*)(VT + (16 * w + fl) * KT_STRIDE + (32 * ks + 8 * g) * 2);
        if (!PHASE_A) {
#pragma unroll
            for (int jt = 0; jt < 4; ++jt)
#pragma unroll
                for (int ks = 0; ks < 2; ++ks) if (32 * ks <= 16 * jt + 15) { const bf16x8 pf = *(const LAS bf16x8*)(P + (16 * jt + fl) * KT_STRIDE + (32 * ks + 8 * g) * 2); Y[jt] = MFMA16(vf[ks], pf, Y[jt]); }
#pragma unroll
            for (int jt = 0; jt < 4; ++jt) *(LAS f32x4*)(OB + (16 * jt + fl) * OB_STRIDE + 16 * w + 4 * g) = Y[jt];
        }
#pragma unroll
        for (int i = 0; i < 8; ++i) { X[i] = X[i] * *(const LAS f32x4*)(AL + 16 * i + 4 * g);
#pragma unroll
            for (int ks = 0; ks < 2; ++ks) { const bf16x8 a = *(const LAS bf16x8*)(KtT + (16 * i + fl) * KT_STRIDE + (32 * ks + 8 * g) * 2); X[i] = MFMA16(a, vf[ks], X[i]); } }
        __syncthreads();
        if (!PHASE_A) {
            const int t = tid >> 3, es = (tid & 7) * 16; f32x4 o[4]; float ss = 0.f;
#pragma unroll
            for (int q = 0; q < 4; ++q) { o[q] = *(const LAS f32x4*)(OB + t * OB_STRIDE + es + 4 * q); ss += (o[q][0] * o[q][0] + o[q][1] * o[q][1]) + (o[q][2] * o[q][2] + o[q][3] * o[q][3]); }
            ss += __shfl_xor(ss, 1); ss += __shfl_xor(ss, 2); ss += __shfl_xor(ss, 4);
            const float rstd = rsqrtf(ss * (1.f / 128.f) + EPS);
            const size_t ro = (tok0 + (size_t)c * 64 + t) * DM + (size_t)h * 128 + es;
            const f16x8 g0 = *(const f16x8*)(GH + ro), g1 = *(const f16x8*)(GH + ro + 8);
            pg8::f32x8 r0, r1;
#pragma unroll
            for (int q = 0; q < 2; ++q) { const f32x4 gn = *(const f32x4*)(gnorm + es + 4 * q);
#pragma unroll
                for (int j = 0; j < 4; ++j) r0[4 * q + j] = o[q][j] * rstd * gn[j] * (float)g0[4 * q + j]; }
#pragma unroll
            for (int q = 0; q < 2; ++q) { const f32x4 gn = *(const f32x4*)(gnorm + es + 8 + 4 * q);
#pragma unroll
                for (int j = 0; j < 4; ++j) r1[4 * q + j] = o[2 + q][j] * rstd * gn[j] * (float)g1[4 * q + j]; }
            *(f16x8*)(OG + ro) = __builtin_convertvector(r0, f16x8); *(f16x8*)(OG + ro + 8) = __builtin_convertvector(r1, f16x8);
        }
    }
#undef SCAN_LOAD
    if (PHASE_A) {
#pragma unroll
        for (int i = 0; i < 8; ++i)
#pragma unroll
            for (int r = 0; r < 4; ++r) STu[(16 * i + 4 * g + r) * 128 + 16 * w + fl] = X[i][r];
        if (w == 0) *(f32x2*)(ST + ST_ATOT + (size_t)u * 128 + 2 * lane) = (f32x2){__expf(cs0), __expf(cs1)};
    }
    __syncthreads();
}
__device__ __forceinline__ void scan_carry(float* __restrict__ ST, const int gtid, const int nthreads) {
    for (int i = gtid; i < 32 * 4096; i += nthreads) {
        const int bh = i >> 12, q = i & 4095, d = q >> 5;
        f32x4 s = {0.f, 0.f, 0.f, 0.f};
#pragma unroll
        for (int sc = 0; sc < 8; ++sc) { f32x4* p = (f32x4*)(ST + (size_t)(bh * 8 + sc) * 16384) + q;
            if (sc < 7) { const f32x4 l = *p; const float a = ST[ST_ATOT + (size_t)(bh * 8 + sc) * 128 + d]; *p = s; s = s * a + l; } else *p = s; }
    }
}
#undef MFMA16
}

namespace attn {
constexpr int D = 128;
constexpr float THR = 8.f;
constexpr bool WSKIP = false;
constexpr int OSTRIDE = DM;
constexpr float SCALE = 0.08838834764831845f;
constexpr int NW = 8, QBLK = 32, KVBLK = 64, QB = NW * QBLK;
constexpr int SHM_V = KVBLK * D * 2, SHM_K = KVBLK * D * 2;
constexpr int LDS_BYTES = 2 * SHM_V + 2 * SHM_K + NW * 96 * 4;
using bf16 = _Float16;
typedef short s16x8 __attribute__((ext_vector_type(8)));
typedef _Float16 bf16x8 __attribute__((ext_vector_type(8)));
typedef short s16x4 __attribute__((ext_vector_type(4)));
typedef float f32x16 __attribute__((ext_vector_type(16)));
template <class A, class Bt> struct same_t { static constexpr bool v = false; };
template <class A> struct same_t<A, A> { static constexpr bool v = true; };

#define KSWZ(row, colB) ((row) * 256 + ((colB) ^ (((row) & 7) << 4)))
#define SBAR() __builtin_amdgcn_sched_barrier(0)
__device__ __forceinline__ int v_st(int k, int c) { const int kk = (k & ~0xC) | ((k & 4) << 1) | ((k & 8) >> 1); return ((kk >> 3) * 4 + (c >> 5)) * 512 + ((kk & 7) * 32 + (c & 31)) * 2; }
__device__ __forceinline__ int v_rd_base(int lane) { return ((lane & 3) << 3) | (((lane >> 2) & 3) << 6) | (((lane >> 4) & 1) << 5) | (((lane >> 5) & 1) << 8); }
constexpr int v_rd_off(int d0, int ks, int half) { return d0 * 512 + ks * 4096 + half * 2048; }
__device__ __forceinline__ int crow(int r, int hi) { return (r & 3) + 8 * (r >> 2) + 4 * hi; }
__device__ __forceinline__ unsigned cvtpk(float lo, float hi) {
    unsigned r; asm volatile("v_cvt_pk_f16_f32 %0, %1, %2" : "=v"(r) : "v"(lo), "v"(hi)); return r;
}
__device__ __forceinline__ bf16x8 pack8(f32x4 a, f32x4 b) {
    u32x4 w = {cvtpk(a[0], a[1]), cvtpk(a[2], a[3]), cvtpk(b[0], b[1]), cvtpk(b[2], b[3])};
    return *reinterpret_cast<bf16x8*>(&w);
}
template <class T> __device__ __forceinline__ bf16x8 load8(const T* p) {
    if constexpr (same_t<T, float>::v) { return pack8(*(const f32x4*)p, *(const f32x4*)(p + 4)); }
    else { return *reinterpret_cast<const bf16x8*>(p); }
}
__device__ __forceinline__ void mask_tile(f32x16& p0, f32x16& p1, int dq, unsigned W) {
    const float NEG = -__builtin_inff();
#pragma unroll
    for (int r = 0; r < 16; ++r) {
        const int c = (r & 3) + 8 * (r >> 2);
        if ((unsigned)(dq - c) >= W) p0[r] = NEG;
        if ((unsigned)(dq - c - 32) >= W) p1[r] = NEG;
    }
}
__device__ __forceinline__ void partialSM(f32x16& p0, f32x16& p1, float& m_reg, float& mn, float& alpha) {
    float pmax = p0[0]; for (int r = 1; r < 16; ++r) pmax = fmaxf(pmax, p0[r]); for (int r = 0; r < 16; ++r) pmax = fmaxf(pmax, p1[r]);
    { auto rr = __builtin_amdgcn_permlane32_swap(__float_as_uint(pmax), __float_as_uint(pmax), false, false);
      pmax = fmaxf(__uint_as_float(rr[0]), __uint_as_float(rr[1])); }
    constexpr float C2 = 1.4426950408889634f * SCALE;
    if (__builtin_expect(__all((pmax - m_reg) * SCALE <= THR), 1)) { mn = m_reg; alpha = 1.f; }
    else { mn = fmaxf(m_reg, pmax); alpha = __builtin_amdgcn_exp2f((m_reg - mn) * C2); m_reg = mn; }
    const float mnL = -mn * C2;
    for (int r = 0; r < 16; ++r) p0[r] = fmaf(p0[r], C2, mnL); for (int r = 0; r < 16; ++r) p1[r] = fmaf(p1[r], C2, mnL);
    for (int r = 0; r < 16; ++r) p0[r] = __builtin_amdgcn_exp2f(p0[r]);
}
__device__ __forceinline__ void finishSM(f32x16& p0, f32x16& p1, float alpha, float& l_reg, bf16x8& pa0, bf16x8& pa1, bf16x8& pa2, bf16x8& pa3) {
    for (int r = 0; r < 16; ++r) p1[r] = __builtin_amdgcn_exp2f(p1[r]);
    float ps = 0; for (int r = 0; r < 16; ++r) ps += p0[r]; for (int r = 0; r < 16; ++r) ps += p1[r];
    { auto rr = __builtin_amdgcn_permlane32_swap(__float_as_uint(ps), __float_as_uint(ps), false, false);
      ps = __uint_as_float(rr[0]) + __uint_as_float(rr[1]); }
    l_reg = l_reg * alpha + ps;
#define PK4(P, B_, OUT) do { unsigned a0 = cvtpk(P[B_+0], P[B_+1]), a1 = cvtpk(P[B_+2], P[B_+3]);                          \
        unsigned b0 = cvtpk(P[B_+4], P[B_+5]), b1 = cvtpk(P[B_+6], P[B_+7]);                                             \
        auto r0 = __builtin_amdgcn_permlane32_swap(a0, b0, false, false); auto r1 = __builtin_amdgcn_permlane32_swap(a1, b1, false, false); \
        u32x4 w = {r0[0], r1[0], r0[1], r1[1]}; OUT = *reinterpret_cast<bf16x8*>(&w); } while (0)
    PK4(p0, 0, pa0); PK4(p0, 8, pa1); PK4(p1, 0, pa2); PK4(p1, 8, pa3);
#undef PK4
}
template <int KB, bool SK>
__device__ __forceinline__ void qkt(f32x16& p0, f32x16& p1, const char* K_lds, int r32, int hi, const bf16x8* qr, bool act) {
    if (SK && !act) { const float NEG = -__builtin_inff();
#pragma unroll
        for (int r = 0; r < 16; ++r) { p0[r] = NEG; p1[r] = NEG; } return; }
    p0 = f32x16{}; p1 = f32x16{};
    const char* kb[4];
#pragma unroll
    for (int dd = 0; dd < 4; ++dd) kb[dd] = K_lds + KB * SHM_K + KSWZ(r32, (dd * 16 + hi * 8) * 2);
#pragma unroll
    for (int d0 = 0; d0 < 8; ++d0) { const char* a = kb[d0 & 3] + (d0 >> 2) * 128;
        bf16x8 b0 = *reinterpret_cast<const bf16x8*>(a);
        bf16x8 b1 = *reinterpret_cast<const bf16x8*>(a + 32 * 256);
        p0 = __builtin_amdgcn_mfma_f32_32x32x16_f16(b0, qr[d0], p0, 0, 0, 0);
        p1 = __builtin_amdgcn_mfma_f32_32x32x16_f16(b1, qr[d0], p1, 0, 0, 0); }
}
template <int VB, bool SK>
__device__ __forceinline__ void pv_tile(f32x16* o, int vb0, bf16x8 pa0, bf16x8 pa1, bf16x8 pa2, bf16x8 pa3, bool act) {
    if (SK && !act) return;
#define TRRD(dst, off) asm volatile("ds_read_b64_tr_b16 %0, %1 offset:%2" : "=&v"(dst) : "v"(vb0), "i"(off) : "memory")
#define PV_D0(d0) do { s16x4 l0, l1, l2, l3, h0, h1, h2, h3; constexpr int b_ = VB * SHM_V + v_rd_off(d0, 0, 0);     \
        TRRD(l0, b_); TRRD(h0, b_ + 2048); TRRD(l1, b_ + 4096); TRRD(h1, b_ + 6144); TRRD(l2, b_ + 8192); TRRD(h2, b_ + 10240); TRRD(l3, b_ + 12288); TRRD(h3, b_ + 14336); \
        asm volatile("s_waitcnt lgkmcnt(0)" ::: "memory"); SBAR();                 \
        o[d0] = __builtin_amdgcn_mfma_f32_32x32x16_f16(pa0, __builtin_bit_cast(bf16x8, (s16x8){l0[0], l0[1], l0[2], l0[3], h0[0], h0[1], h0[2], h0[3]}), o[d0], 0, 0, 0);   \
        o[d0] = __builtin_amdgcn_mfma_f32_32x32x16_f16(pa1, __builtin_bit_cast(bf16x8, (s16x8){l1[0], l1[1], l1[2], l1[3], h1[0], h1[1], h1[2], h1[3]}), o[d0], 0, 0, 0);   \
        o[d0] = __builtin_amdgcn_mfma_f32_32x32x16_f16(pa2, __builtin_bit_cast(bf16x8, (s16x8){l2[0], l2[1], l2[2], l2[3], h2[0], h2[1], h2[2], h2[3]}), o[d0], 0, 0, 0);   \
        o[d0] = __builtin_amdgcn_mfma_f32_32x32x16_f16(pa3, __builtin_bit_cast(bf16x8, (s16x8){l3[0], l3[1], l3[2], l3[3], h3[0], h3[1], h3[2], h3[3]}), o[d0], 0, 0, 0); } while (0)
    PV_D0(0); PV_D0(1); PV_D0(2); PV_D0(3);
#undef PV_D0
#undef TRRD
}

template <class TIn, class TOut> struct BlockRef { const TIn* Q; const TIn* K; const TIn* V; TOut* O; int P0; const float* KM; int own; };
template <class TIn> struct Seam {
    bf16x8 qr[8];
    bf16x8 st_v0, st_v1, st_k0, st_k1; f32x4 sf0, sf1, sf2, sf3;
    f32x4 tq[16];
};
__device__ __forceinline__ int swa_jlo(int P0, int W) { const int lowk = P0 - W + 1; return lowk > 0 ? lowk / KVBLK : 0; }
#define ROW(p, k0, rr) ((p) + (size_t)((k0) + (rr)) * D + sc)
#define VMW() asm volatile("s_waitcnt vmcnt(0)" ::: "memory")
#define VMWN(n) asm volatile("s_waitcnt vmcnt(%0)" :: "i"(n) : "memory")
#define SLOAD_H(Kp, Vp, k0) do { S.st_v0 = load8<TIn>(ROW(Vp, k0, sr)); S.st_v1 = load8<TIn>(ROW(Vp, k0, 32 + sr));              \
                         S.st_k0 = load8<TIn>(ROW(Kp, k0, sr)); S.st_k1 = load8<TIn>(ROW(Kp, k0, 32 + sr)); } while (0)
#define SWRITE_HK(bf) do { *(bf16x8*)(K_lds + (bf) * SHM_K + kws) = S.st_k0; *(bf16x8*)(K_lds + (bf) * SHM_K + kws + 32 * 256) = S.st_k1; } while (0)
#define SWRITE_HV(bf) do { *(bf16x8*)(V_lds + (bf) * SHM_V + vst0) = S.st_v0; *(bf16x8*)(V_lds + (bf) * SHM_V + vst1) = S.st_v1; } while (0)
#define SWRITE_H(bf) do { SWRITE_HV(bf); SWRITE_HK(bf); } while (0)
#define SLOAD_F(p, k0) do { S.sf0 = *(const f32x4*)ROW(p, k0, sr); S.sf1 = *(const f32x4*)(ROW(p, k0, sr) + 4);                \
                            S.sf2 = *(const f32x4*)ROW(p, k0, 32 + sr); S.sf3 = *(const f32x4*)(ROW(p, k0, 32 + sr) + 4); } while (0)
#define SWRITE_KF(bf) do { *(bf16x8*)(K_lds + (bf) * SHM_K + kws) = pack8(S.sf0, S.sf1); *(bf16x8*)(K_lds + (bf) * SHM_K + kws + 32 * 256) = pack8(S.sf2, S.sf3); } while (0)
#define SWRITE_VF(bf) do { *(bf16x8*)(V_lds + (bf) * SHM_V + vst0) = pack8(S.sf0, S.sf1); *(bf16x8*)(V_lds + (bf) * SHM_V + vst1) = pack8(S.sf2, S.sf3); } while (0)
template <class TIn, class TOut>
__device__ __forceinline__ void causal_swa_prime(const BlockRef<TIn, TOut>& cur, char* lds, Seam<TIn>& S, const int wid) {
    constexpr bool F32 = same_t<TIn, float>::v;
    const int lane = lane_id_opaque(), tid = wid * 64 + lane, r32 = lane & 31, hi = lane >> 5;
    const int sr = tid >> 4, sc = (tid & 15) * 8, kws = KSWZ(sr, sc * 2); char* K_lds = lds + 2 * SHM_V;
    const int kb0 = 0;
    for (int d0 = 0; d0 < 8; ++d0) S.qr[d0] = load8<TIn>(cur.Q + (size_t)(wid * QBLK + r32) * D + d0 * 16 + hi * 8);
    if constexpr (F32) { SLOAD_F((const float*)cur.K, kb0); VMW(); SWRITE_KF(0); SBAR(); SLOAD_F((const float*)cur.V, kb0); }
    else { SLOAD_H(cur.K, cur.V, kb0); VMW(); SWRITE_HK(0); }
    __syncthreads();
}
template <class TIn, class TOut>
__device__ __forceinline__ void causal_swa_block(const BlockRef<TIn, TOut>& cur, const BlockRef<TIn, TOut>& nxt, int skv, char* lds, Seam<TIn>& S, const int wid) {
    constexpr bool F32 = same_t<TIn, float>::v;
    const int lane = lane_id_opaque(), tid = wid * 64 + lane, r32 = lane & 31, hi = lane >> 5;
    const int j_lo = 0, own = cur.own; constexpr int W = 0x7fffffff;
    int j_hi = (cur.P0 + QB - 1) / KVBLK + 1; if (j_hi > skv / KVBLK) j_hi = skv / KVBLK;
    const int NT = j_hi - j_lo;
    const int kbn = 0;
    const int qlo = cur.P0 + wid * QBLK, qm = qlo + r32 - 4 * hi;
    char* V_lds = lds; char* K_lds = lds + 2 * SHM_V;
    float* ws = (float*)(lds + 2 * SHM_V + 2 * SHM_K) + wid * 96; float* li_l = ws, * al_l = ws + 32; unsigned* sel_l = (unsigned*)(ws + 64);
    float m_reg = -1e30f, l_reg = 0; f32x16 o[4] = {};
    const int sr = tid >> 4, sc = (tid & 15) * 8, vst0 = v_st(sr, sc), vst1 = v_st(32 + sr, sc), kws = KSWZ(sr, sc * 2);
    const int vb0 = (int)(uintptr_t)V_lds + v_rd_base(lane);
    const TIn* Kh = cur.K; const TIn* Vh = cur.V;
#define RESC(a) do { if (__any((a) < 1.f)) { if (hi == 0) al_l[r32] = (a); asm volatile("s_waitcnt lgkmcnt(0)" ::: "memory");              \
                     for (int d_ = 0; d_ < 4; ++d_) for (int r = 0; r < 16; ++r) o[d_][r] *= al_l[crow(r, hi)]; } } while (0)
#define KBASE(t) ((j_lo + (t)) * KVBLK)
#define ACT(t) (KBASE(t) <= qlo + QBLK - 1 && KBASE(t) + KVBLK - 1 >= qlo - W + 1)
#define MASKT(P0_, P1_, t) do { const int kb_ = KBASE(t), jb_ = (t) >> 2; \
        if (jb_ == own) { if (kb_ + KVBLK - 1 > qlo) mask_tile(P0_, P1_, qm - kb_, (unsigned)W); }                          \
        else { const unsigned sw_ = sel_l[r32]; if (!((sw_ >> jb_) & 1u)) { const float NEG_ = -__builtin_inff();            \
            _Pragma("unroll") for (int r_ = 0; r_ < 16; ++r_) { P0_[r_] = NEG_; P1_[r_] = NEG_; } } } } while (0)
    constexpr int NQL = F32 ? 16 : 8;
    constexpr bool SK = WSKIP && !F32;
#define SEAM_K0() do { VMWN(NQL); if constexpr (F32) { SWRITE_KF(0); SBAR(); SLOAD_F((const float*)nxt.V, kbn); } else { SWRITE_HK(0); } SBAR(); } while (0)
    f32x16 pA0, pA1, pB0, pB1; float mnA, mnB, alA, alB; bf16x8 pa0, pa1, pa2, pa3;
    { f32x16 pg = {};
      const int jg = (r32 & 3) + 4 * (r32 >> 3); const bool live = (r32 & 4) == 0;
#pragma unroll
      for (int d0 = 0; d0 < 8; ++d0) { f32x4 a = {0.f, 0.f, 0.f, 0.f}, b2 = a;
          if (live) { a = *(const f32x4*)(cur.KM + jg * 128 + d0 * 16 + hi * 8); b2 = *(const f32x4*)(cur.KM + jg * 128 + d0 * 16 + hi * 8 + 4); }
          pg = __builtin_amdgcn_mfma_f32_32x32x16_f16(pack8(a, b2), S.qr[d0], pg, 0, 0, 0); }
      unsigned sel = 0u;
#pragma unroll
      for (int rep_ = 0; rep_ < 3; ++rep_) { float best = -__builtin_inff(); int bi = -1;
#pragma unroll
          for (int j = 0; j < 16; ++j) { const bool ok = (j < own) && !((sel >> j) & 1u) && (pg[j] > best); best = ok ? pg[j] : best; bi = ok ? j : bi; }
          if (bi >= 0) sel |= 1u << bi; }
      if (hi == 0) sel_l[r32] = sel;
      asm volatile("s_waitcnt lgkmcnt(0)" ::: "memory"); }
    if constexpr (F32) { VMW(); SWRITE_VF(0); SBAR(); } else { SWRITE_HV(0); SBAR(); }
    if (NT > 1) { if constexpr (F32) SLOAD_F((const float*)Kh, KBASE(1)); else SLOAD_H(Kh, Vh, KBASE(1)); }
    SBAR(); qkt<0, SK>(pA0, pA1, K_lds, r32, hi, S.qr, ACT(0));
    if constexpr (F32) { if (NT > 1) { VMW(); SWRITE_KF(1); SBAR(); SLOAD_F((const float*)Vh, KBASE(1)); } }
    MASKT(pA0, pA1, 0); partialSM(pA0, pA1, m_reg, mnA, alA);
    if (NT > 1) { VMW(); if constexpr (F32) { SWRITE_VF(1); SBAR(); if (NT > 2) SLOAD_F((const float*)Kh, KBASE(2)); } else SWRITE_H(1); }
    __syncthreads();
#define HALF_STEP(PX0, PX1, mnX, alX, PY0, PY1, alY, t, KB, VB, SB) do {                                                      \
        SBAR(); qkt<KB, SK>(PX0, PX1, K_lds, r32, hi, S.qr, ACT(t));                                             \
        finishSM(PY0, PY1, alY, l_reg, pa0, pa1, pa2, pa3); SBAR();                                                           \
        if ((t) + 1 < NT) { if constexpr (F32) { VMW(); SWRITE_KF(SB); SBAR(); SLOAD_F((const float*)Vh, KBASE((t) + 1)); }  \
                            else { SLOAD_H(Kh, Vh, KBASE((t) + 1)); } SBAR(); }                                               \
        pv_tile<VB, SK>(o, vb0, pa0, pa1, pa2, pa3, ACT((t) - 1)); MASKT(PX0, PX1, (t)); partialSM(PX0, PX1, m_reg, mnX, alX);                                        \
        __syncthreads();                                                                                                      \
        if ((t) + 1 < NT) { VMW(); if constexpr (F32) { SWRITE_VF(SB); SBAR(); if ((t) + 2 < NT) SLOAD_F((const float*)Kh, KBASE((t) + 2)); } \
                            else { SWRITE_H(SB); } }                                                                          \
        RESC(alX); __syncthreads(); } while (0)
    for (int t = 1; t + 1 < NT; t += 2) {
        HALF_STEP(pB0, pB1, mnB, alB, pA0, pA1, alA, t, 1, 0, 0);
        HALF_STEP(pA0, pA1, mnA, alA, pB0, pB1, alB, t + 1, 0, 1, 1);
    }
    const bool even = (NT & 1) == 0;
    if (even) { SBAR(); qkt<1, SK>(pB0, pB1, K_lds, r32, hi, S.qr, ACT(NT - 1)); SBAR(); }
#define QROW(e) (nxt.Q + (size_t)(wid * QBLK + r32) * D + ((e) >> 1) * 16 + hi * 8 + ((e) & 1) * 4)
    if constexpr (F32) { SLOAD_F((const float*)nxt.K, kbn); SBAR();
#pragma unroll
        for (int e = 0; e < 8; ++e) S.tq[e] = *(const f32x4*)QROW(e); }
    else { SLOAD_H(nxt.K, nxt.V, kbn); SBAR();
#pragma unroll
        for (int d0 = 0; d0 < 8; ++d0) S.qr[d0] = load8<TIn>(nxt.Q + (size_t)(wid * QBLK + r32) * D + d0 * 16 + hi * 8); }
    SBAR();
    finishSM(pA0, pA1, alA, l_reg, pa0, pa1, pa2, pa3); SBAR();
    if constexpr (F32) {
#pragma unroll
        for (int e = 8; e < 16; ++e) S.tq[e] = *(const f32x4*)QROW(e); SBAR(); }
#undef QROW
    pv_tile<0, SK>(o, vb0, pa0, pa1, pa2, pa3, ACT(even ? NT - 2 : NT - 1));
    if (even) { MASKT(pB0, pB1, NT - 1); partialSM(pB0, pB1, m_reg, mnB, alB); __syncthreads(); RESC(alB);
        finishSM(pB0, pB1, alB, l_reg, pa0, pa1, pa2, pa3); SBAR(); pv_tile<1, SK>(o, vb0, pa0, pa1, pa2, pa3, ACT(NT - 1)); }
    SBAR(); SEAM_K0();
    if (hi == 0) li_l[r32] = l_reg; asm volatile("s_waitcnt lgkmcnt(0)" ::: "memory");
    float rli[16];
#pragma unroll
    for (int r = 0; r < 16; ++r) rli[r] = __builtin_amdgcn_rcpf(li_l[crow(r, hi)]);
    TOut* Ow = cur.O + (size_t)(wid * QBLK) * OSTRIDE;
#pragma unroll
    for (int r = 0; r < 16; ++r) { const int orow = crow(r, hi);
#pragma unroll
        for (int d0 = 0; d0 < 4; ++d0) { const float v = o[d0][r] * rli[r];
            if constexpr (same_t<TOut, float>::v) { Ow[(size_t)orow * OSTRIDE + d0 * 32 + r32] = v; }
            else { const float vn = __shfl_xor(v, 1);
                   if ((r32 & 1) == 0) *(unsigned*)(Ow + (size_t)orow * OSTRIDE + d0 * 32 + r32) = cvtpk(v, vn); } } }
    if constexpr (F32) {
#pragma unroll
        for (int d0 = 0; d0 < 8; ++d0) S.qr[d0] = pack8(S.tq[2 * d0], S.tq[2 * d0 + 1]); }
    __syncthreads();
#undef RESC
#undef KBASE
#undef ACT
#undef MASKT
#undef SEAM_K0
#undef HALF_STEP
}
#undef ROW
#undef VMW
#undef VMWN
#undef SLOAD_H
#undef SWRITE_HK
#undef SWRITE_HV
#undef SWRITE_H
#undef SLOAD_F
#undef SWRITE_KF
#undef SWRITE_VF
__device__ __forceinline__ BlockRef<f16, f16> moba_ref(const int L, const int pass, const f16* Q, const f16* K, const f16* V, const float* KM, f16* O) {
    const int grp = L >> 5, hq = (L >> 3) & 3, y = L & 7, b = grp >> 2, kvh = grp & 3, h = kvh * 4 + hq, qb = pass ? 15 - y : y;
    BlockRef<f16, f16> r;
    r.Q = Q + ((size_t)(b * NH + h) * SEQ + (size_t)qb * QB) * D; r.K = K + (size_t)(b * NKV + kvh) * SEQ * D; r.V = V + (size_t)(b * NKV + kvh) * SEQ * D;
    r.O = O + ((size_t)b * SEQ + (size_t)qb * QB) * OSTRIDE + h * D; r.P0 = qb * QB; r.KM = KM + (size_t)(b * NKV + kvh) * NBLK * D; r.own = qb;
    return r;
}
__device__ __forceinline__ void moba_phase(char* lds, const int wid, const int vcu, const int G, const f16* Q, const f16* K, const f16* V, const float* KM, f16* O) {
    constexpr int total = BATCH * NH * (NBLK / 2);
    int L = vcu; if (L >= total) return;
    int pass = 0;
    BlockRef<f16, f16> cur = moba_ref(L, 0, Q, K, V, KM, O);
    Seam<f16> S;
    causal_swa_prime<f16, f16>(cur, lds, S, wid);
    for (;;) {
        const bool more_pass = pass == 0, more_item = L + G < total, last = !more_pass && !more_item;
        int passn = pass + 1, Ln = L;
        if (!more_pass) { passn = 0; Ln = more_item ? L + G : L; }
        const BlockRef<f16, f16> nxt = last ? cur : moba_ref(Ln, passn, Q, K, V, KM, O);
        causal_swa_block<f16, f16>(cur, nxt, SEQ, lds, S, wid);
        if (last) break;
        cur = nxt; pass = passn; L = Ln;
    }
}
}

constexpr int NWAVES = 8;
constexpr int RING_BYTES = 131072, LDSCTL_OFF = RING_BYTES, MISC_OFF = LDSCTL_OFF + 320, LDS_BYTES = 147456;
constexpr size_t W16_GU = 0, W16_GU_SZ = (size_t)2 * FF * DM, W16_DN = 4 * W16_GU_SZ, W16_DN_SZ = (size_t)DM * FF, W16_IN = W16_DN + 4 * W16_DN_SZ, W16_OUT = W16_IN + (size_t)4 * DM * DM,
                 W16_KV = W16_OUT + (size_t)DM * DM, W16_Q = W16_KV + (size_t)1024 * DM, W16_O = W16_Q + (size_t)DM * DM, W16_END = W16_O + (size_t)DM * DM;
static_assert(WS_W16 + W16_END * 2 <= WS_END, "fp16 weights fit");
enum { PC_PRO = 0, PC_NORM0 = 1, PC_S0_FA = 2, PC_S0_FB = 3, PC_S0_NF = 4, PC_HG = 5, PC_SA = 6, PC_SB = 7, PC_SC = 8, PC_HO = 9, PC_NM0 = 10, PC_S1_FA = 11, PC_S1_FB = 12, PC_S1_NF = 13,
       PC_KV = 14, PC_S2_FA = 15, PC_S2_FB = 16, PC_S2_NF = 17, PC_QP = 18, PC_AT = 19, PC_OP = 20, PC_NM1 = 21, PC_S3_FA = 22, PC_S3_FB = 23, PC_S3_NF = 24, PC_END = 25 };

struct MegaArgs { const float* in[16]; float* out; unsigned char* ws; int lo, hi; };

enum { MAP_NAT = 0, MAP_SWIGLU = 1, MAP_ROT = 2 };
__device__ __forceinline__ int map_col(int kind, int nrot_rows, int n) {
    if (kind == MAP_SWIGLU) return ((n >> 7) & 1) * FF + (n >> 8) * 128 + (n & 127);
    if (kind == MAP_ROT && n < nrot_rows) return (2 * (n >> 8) + ((n >> 6) & 1)) * 128 + ((n >> 7) & 1) * 64 + (n & 63);
    return n;
}
__device__ __forceinline__ void conv_item(const float* W, int K, int N, f16* WT, int kind, int nrot_rows, int item, int lane) {
    const int nblk = N >> 5, kb = item / nblk, nb = item - kb * nblk, k0 = kb * 64, n0 = nb * 32, ns0 = map_col(kind, nrot_rows, n0);
    const int r = lane >> 3, q = lane & 7;
    const float* src = W + (size_t)(k0 + 8 * r) * N + ns0 + 4 * q;
    f32x4 v[8];
#pragma unroll
    for (int i = 0; i < 8; ++i) v[i] = *(const f32x4*)(src + (size_t)i * N);
    f16* dst = WT + (size_t)(n0 + 4 * q) * K + k0 + 8 * r;
#pragma unroll
    for (int nn = 0; nn < 4; ++nn) { const pg8::f32x8 o = {v[0][nn], v[1][nn], v[2][nn], v[3][nn], v[4][nn], v[5][nn], v[6][nn], v[7][nn]};
        *(pg8::h16x8*)(dst + (size_t)nn * K) = __builtin_convertvector(o, pg8::h16x8); }
}

constexpr int PTAB_OFF = LDSCTL_OFF + 1024;
__device__ __forceinline__ unsigned long long ldptr(LAS unsigned char* lds, int i) {
    const volatile LAS unsigned* t = (const volatile LAS unsigned*)(lds + PTAB_OFF) + 2 * i;
    const unsigned a = __builtin_amdgcn_readfirstlane(t[0]), b = __builtin_amdgcn_readfirstlane(t[1]);
    return ((unsigned long long)b << 32) | a;
}
#define WSP(T, off) ((T)(ws + (off)))
#define PHASE_LANE() const int lane = lane_id_opaque(); const int tid = wave * 64 + lane; (void)tid
#define LDP(T, i) ((T)ldptr(lds, (i)))
#define PH_BEGIN if (pc >= lo && pc < hi) { unsigned char* const ws = LDP(unsigned char*, 17); PHASE_LANE();
#define PH_END if (pc + 1 < hi) xcd_barrier(bar, wave); } ++pc;
#define GEMM_CALL(EpiT, Aptr, Btptr, Nn, Kk, Eobj) do { pg8::Gemm g_{(const pg8::bf16_t*)(Aptr), (const pg8::bf16_t*)(Btptr), M, (Nn), (Kk)}; pg8::StaticOrder S_; S_.init(M, (Nn), G, bx); \
        pg8::gemm_phase<EpiT, pg8::StaticOrder, true, true>(lds, g_, S_, (Eobj), wave); } while (0)
#define W16P(off) (WSP(f16*, WS_W16) + (off))


template <int s>
__device__ __forceinline__ void sub_body(LAS unsigned char* lds, const int G, const int bx, const int vcu, const int wave, const int lo, const int hi, const XcdBarrier bar, int& pc) {
    constexpr int l = s >> 1, half = s & 1;

        if (half == 1) {
            if (l == 0) {
                PH_BEGIN { pg8::EpiHgrn E{WSP(f16*, WS_QH), WSP(f16*, WS_KH), WSP(u16*, WS_VH), WSP(f16*, WS_GH), WSP(float*, WS_LF), WSP(const float*, WS_LBT)}; GEMM_CALL(pg8::EpiHgrn, WSP(f16*, WS_H), W16P(W16_IN), 4 * DM, DM, E); } PH_END
                PH_BEGIN { for (int u = vcu; u < 256; u += G) if ((u & 7) != 7) scan::scan_unit<true>(lds, u, wave, lane, WSP(const f16*, WS_QH), WSP(const f16*, WS_KH), WSP(const u16*, WS_VH), WSP(const f16*, WS_GH), WSP(const float*, WS_LF), LDP(const float*, 10), WSP(float*, WS_ST), WSP(f16*, WS_OG)); } PH_END
                PH_BEGIN { scan::scan_carry(WSP(float*, WS_ST), vcu * 512 + tid, G * 512); } PH_END
                PH_BEGIN { for (int u = vcu; u < 256; u += G) scan::scan_unit<false>(lds, u, wave, lane, WSP(const f16*, WS_QH), WSP(const f16*, WS_KH), WSP(const u16*, WS_VH), WSP(const f16*, WS_GH), WSP(const float*, WS_LF), LDP(const float*, 10), WSP(float*, WS_ST), WSP(f16*, WS_OG)); } PH_END
                PH_BEGIN { pg8::EpiF32 E{WSP(float*, WS_Y), DM}; GEMM_CALL(pg8::EpiF32, WSP(f16*, WS_OG), W16P(W16_OUT), DM, DM, E); } PH_END
            } else {
                PH_BEGIN { pg8::EpiRot E{WSP(f16*, WS_Q), NH, WSP(const float*, WS_ROPE), nullptr, nullptr, DM / 256}; GEMM_CALL(pg8::EpiRot, WSP(f16*, WS_H), W16P(W16_Q), DM, DM, E); } PH_END
                PH_BEGIN { attn::moba_phase((char*)lds, wave, vcu, G, WSP(const f16*, WS_Q), WSP(const f16*, WS_K), WSP(const f16*, WS_V), WSP(const float*, WS_KMEAN), WSP(f16*, WS_O)); } PH_END
                PH_BEGIN { pg8::EpiF32 E{WSP(float*, WS_Y), DM}; GEMM_CALL(pg8::EpiF32, WSP(f16*, WS_O), W16P(W16_O), DM, DM, E); } PH_END
            }
            PH_BEGIN
            {
                float* mods = WSP(float*, WS_MODS); float* out = LDP(float*, 16); const float* norm_pre = LDP(const float*, 4); const float* norm_post = LDP(const float*, 5);
                NormArgs a{}; a.x_in = out; a.y = WSP(const float*, WS_Y); a.x_out = out; a.h = WSP(f16*, WS_H); a.gate = mods + (size_t)(l * 2) * MODW + 1 * 3 * DM + 2 * DM; a.post = norm_post + (l * 3 + 1) * DM;
                a.pre = norm_pre + (l * 3 + 2) * DM; a.shift = mods + (size_t)(l * 2) * MODW + 2 * 3 * DM; a.scale = a.shift + DM; a.w = 1.0f; a.has_y = 1; a.has_h = 1;
                norm_rows(a, vcu * NWAVES + wave, G * NWAVES, lane);
            }
            PH_END
        }
        if (s == 2) {
            PH_BEGIN { pg8::EpiRot E{WSP(f16*, WS_K), NKV, WSP(const float*, WS_ROPE), WSP(float*, WS_KMEAN), WSP(f16*, WS_V), 2}; GEMM_CALL(pg8::EpiRot, WSP(f16*, WS_HKV), W16P(W16_KV), 1024, DM, E); } PH_END
        }
        PH_BEGIN { pg8::EpiSwiGLU E{WSP(f16*, WS_ACT)}; GEMM_CALL(pg8::EpiSwiGLU, WSP(f16*, WS_H), W16P(W16_GU + s * W16_GU_SZ), 2 * FF, DM, E); } PH_END
        PH_BEGIN { pg8::EpiF32 E{WSP(float*, WS_Y), DM}; GEMM_CALL(pg8::EpiF32, WSP(f16*, WS_ACT), W16P(W16_DN + s * W16_DN_SZ), DM, FF, E); } PH_END
        PH_BEGIN
        {
            float* mods = WSP(float*, WS_MODS); float* out = LDP(float*, 16); const float* norm_pre = LDP(const float*, 4); const float* norm_post = LDP(const float*, 5);
            NormArgs a{}; a.x_in = (s == 0) ? LDP(const float*, 0) : out; a.y = WSP(const float*, WS_Y); a.x_out = out; a.h = WSP(f16*, WS_H); a.h2 = WSP(f16*, WS_HKV); a.kvn = LDP(const float*, 12);
            a.gate = mods + (size_t)(l * 2) * MODW + (half * 2) * 3 * DM + 2 * DM; a.post = norm_post + (l * 3 + half * 2) * DM; a.w = 0.5f; a.has_y = 1;
            if (half == 0) { a.pre = norm_pre + (l * 3 + 1) * DM; a.shift = mods + (size_t)(l * 2) * MODW + 1 * 3 * DM; a.scale = a.shift + DM; a.has_h = 1; }
            else if (l == 0) { a.pre = norm_pre + 3 * DM; a.shift = mods + (size_t)2 * MODW; a.scale = a.shift + DM; a.has_h = 1; a.has_kv = 1; }
            else { a.pre = norm_pre; a.shift = mods; a.scale = mods; }
            norm_rows(a, vcu * NWAVES + wave, G * NWAVES, lane);
        }
        PH_END
    }

__global__ void __launch_bounds__(NWAVES * 64, 2) mega(MegaArgs args) {
    extern __shared__ __attribute__((aligned(16))) unsigned char lds_raw[];
    LAS unsigned char* lds = (LAS unsigned char*)lds_raw;
    volatile LAS unsigned* MISC = (volatile LAS unsigned*)(lds + MISC_OFF);
    const int wave = __builtin_amdgcn_readfirstlane(threadIdx.x >> 6);
    const int G = gridDim.x, bx = blockIdx.x, vcu = (G % 8 == 0) ? (bx % 8) * (G / 8) + bx / 8 : bx;
    const int lo = args.lo, hi = args.hi;
    { const int tid = threadIdx.x;
    if (tid < 18) ((LAS unsigned long long*)(lds + PTAB_OFF))[tid] = (tid < 16) ? (unsigned long long)args.in[tid] : (tid == 16 ? (unsigned long long)args.out : (unsigned long long)args.ws);
    for (int u = tid; u < 64; u += NWAVES * 64) ((LAS unsigned*)(lds + LDSCTL_OFF))[u + 80] = 0u; }
    __syncthreads();
    XcdBarrier bar; bar.bar = (unsigned*)(args.ws + WS_CTL) + 4096; bar.x = 0; bar.st = nullptr;
    if (hi - lo > 1) bar = xcd_barrier_post((unsigned*)(args.ws + WS_CTL) + 4096, MISC + 8);

    int pc = 0;
    PH_BEGIN
    {
        const float* cvec = LDP(const float*, 1); const float* ada_w = LDP(const float*, 2); const float* ada_b = LDP(const float*, 3);
        float* mods = WSP(float*, WS_MODS); float* rope = WSP(float*, WS_ROPE); float* kmean = WSP(float*, WS_KMEAN);
        LAS float* sc = (LAS float*)lds; LAS float* red = (LAS float*)(lds + 16384);
        for (int i = tid; i < 2 * DM; i += 512) sc[i] = silu_f(cvec[i]);
        __syncthreads();
        constexpr int nchunk = MODW / 64;
        for (int u = vcu; u < 2 * nchunk; u += G) {
            const int l = u / nchunk, c0 = (u % nchunk) * 64;
            const float* W = ada_w + (size_t)l * DM * MODW + c0 + lane;
            float a0 = 0.f, a1 = 0.f; const int k0 = wave * 256;
#pragma unroll 16
            for (int k = 0; k < 256; ++k) { const float wv = W[(size_t)(k0 + k) * MODW]; a0 += sc[k0 + k] * wv; a1 += sc[DM + k0 + k] * wv; }
            red[(wave * 2 + 0) * 64 + lane] = a0; red[(wave * 2 + 1) * 64 + lane] = a1;
            __syncthreads();
            if (tid < 128) { const int b = tid >> 6; float s = 0.f;
#pragma unroll
                for (int ww = 0; ww < 8; ++ww) s += red[(ww * 2 + b) * 64 + lane];
                mods[(size_t)(l * 2 + b) * MODW + c0 + lane] = s + ada_b[(size_t)l * MODW + c0 + lane]; }
            __syncthreads();
        }
        for (int i = vcu * 512 + tid; i < SEQ * 64; i += G * 512) { const int t = i >> 6, d = i & 63; const float inv = powf(10000.0f, -(float)d / 64.0f); const float ang = (float)t * inv; float s, c; sincosf(ang, &s, &c); rope[i] = c; rope[SEQ * 64 + i] = s; }
        for (int i = vcu * 512 + tid; i < BATCH * NKV * NBLK * 128; i += G * 512) kmean[i] = 0.f;
        { const float* hl = LDP(const float*, 9); float* lbt = WSP(float*, WS_LBT); for (int i = vcu * 512 + tid; i < DM; i += G * 512) lbt[i] = 1.f / (1.f + expf(hl[DM + i] - hl[i])); }
        constexpr int I_GU = (DM / 64) * (2 * FF / 32), I_DN = (FF / 64) * (DM / 32), I_IN = (DM / 64) * (4 * DM / 32), I_SQ = (DM / 64) * (DM / 32), I_KV = (DM / 64) * (1024 / 32);
        constexpr int NITEMS = 4 * I_GU + 4 * I_DN + I_IN + I_SQ + I_KV + I_SQ + I_SQ;
        const int gw = vcu * NWAVES + wave, NGW = G * NWAVES;
        for (int it = gw; it < NITEMS; it += NGW) {
            int r = it;
            if (r < 4 * I_GU) { const int s = r / I_GU; conv_item(LDP(const float*, 6) + (size_t)s * DM * 2 * FF, DM, 2 * FF, W16P(W16_GU + s * W16_GU_SZ), MAP_SWIGLU, 0, r - s * I_GU, lane); continue; } r -= 4 * I_GU;
            if (r < 4 * I_DN) { const int s = r / I_DN; conv_item(LDP(const float*, 7) + (size_t)s * FF * DM, FF, DM, W16P(W16_DN + s * W16_DN_SZ), MAP_NAT, 0, r - s * I_DN, lane); continue; } r -= 4 * I_DN;
            if (r < I_IN) { conv_item(LDP(const float*, 8), DM, 4 * DM, W16P(W16_IN), MAP_NAT, 0, r, lane); continue; } r -= I_IN;
            if (r < I_SQ) { conv_item(LDP(const float*, 11), DM, DM, W16P(W16_OUT), MAP_NAT, 0, r, lane); continue; } r -= I_SQ;
            if (r < I_KV) { conv_item(LDP(const float*, 13), DM, 1024, W16P(W16_KV), MAP_ROT, 512, r, lane); continue; } r -= I_KV;
            if (r < I_SQ) { conv_item(LDP(const float*, 14), DM, DM, W16P(W16_Q), MAP_ROT, DM, r, lane); continue; } r -= I_SQ;
            conv_item(LDP(const float*, 15), DM, DM, W16P(W16_O), MAP_NAT, 0, r, lane);
        }
    }
    PH_END
    PH_BEGIN
    {
        float* mods = WSP(float*, WS_MODS);
        NormArgs a{}; a.x_in = LDP(const float*, 0); a.h = WSP(f16*, WS_H); a.pre = LDP(const float*, 4); a.shift = mods; a.scale = mods + DM; a.has_h = 1;
        norm_rows(a, vcu * NWAVES + wave, G * NWAVES, lane);
    }
    PH_END
    sub_body<0>(lds, G, bx, vcu, wave, lo, hi, bar, pc);
    sub_body<1>(lds, G, bx, vcu, wave, lo, hi, bar, pc);
    sub_body<2>(lds, G, bx, vcu, wave, lo, hi, bar, pc);
    sub_body<3>(lds, G, bx, vcu, wave, lo, hi, bar, pc);
}

#define FAST_SCAN 1
#define FAST_ATTN 1
#ifndef N_LAUNCH_MODE
#define N_LAUNCH_MODE 1
#endif
extern "C" void kernel_launch(void* const* d_in, const int* in_sizes, int n_in, void* d_out, int out_size, void* d_ws, size_t ws_size, hipStream_t stream) {
    static int grid = 0;
    if (grid == 0) {
        if (n_in != 16 || out_size != M * DM || ws_size < WS_END) { fprintf(stderr, "kernel_launch: unexpected shapes (n_in %d out %d ws %zu)\n", n_in, out_size, ws_size); grid = -1; return; }
        int dev = 0, cus = 0, per_cu = 0;
        if (hipGetDevice(&dev) != hipSuccess || hipDeviceGetAttribute(&cus, hipDeviceAttributeMultiprocessorCount, dev) != hipSuccess) { grid = -1; return; }
        if (hipFuncSetAttribute((const void*)mega, hipFuncAttributeMaxDynamicSharedMemorySize, LDS_BYTES) != hipSuccess) { fprintf(stderr, "kernel_launch: hipFuncSetAttribute failed\n"); grid = -1; return; }
        if (hipOccupancyMaxActiveBlocksPerMultiprocessor(&per_cu, (const void*)mega, NWAVES * 64, LDS_BYTES) != hipSuccess || per_cu < 1) fprintf(stderr, "kernel_launch: occupancy query says %d\n", per_cu);
        (void)hipGetLastError();
        grid = cus;
    }
    if (grid < 0) return;
    unsigned char* ws = (unsigned char*)d_ws;
    (void)hipMemsetAsync(ws + WS_CTL, 0, 1 * MiB, stream);
    MegaArgs a{};
    for (int i = 0; i < 16; ++i) a.in[i] = (const float*)d_in[i];
    a.out = (float*)d_out; a.ws = ws;
#if N_LAUNCH_MODE == 1
    a.lo = 0; a.hi = PC_END;
    hipLaunchKernelGGL(mega, dim3(grid), dim3(NWAVES * 64), LDS_BYTES, stream, a);
#else
    f16* Kb = (f16*)(ws + WS_K); f16* Vb = (f16*)(ws + WS_V); float* kmean = (float*)(ws + WS_KMEAN);
    f16* QH = (f16*)(ws + WS_QH); f16* KH = (f16*)(ws + WS_KH); u16* VH = (u16*)(ws + WS_VH); f16* GH = (f16*)(ws + WS_GH); float* LF = (float*)(ws + WS_LF); f16* OG = (f16*)(ws + WS_OG);
    f16* Qb = (f16*)(ws + WS_Q); f16* Ob = (f16*)(ws + WS_O);
    for (int pc = 0; pc < PC_END; ++pc) {
#ifndef FAST_SCAN
        if (pc == PC_SA) { hipLaunchKernelGGL(k_naive_scan, dim3(BATCH * NH), dim3(128), 0, stream, QH, KH, VH, GH, LF, (const float*)d_in[10], OG); continue; }
        if (pc == PC_SB || pc == PC_SC) continue;
#endif
#ifndef FAST_ATTN
        if (pc == PC_AT) { hipLaunchKernelGGL(k_naive_attn, dim3(BATCH * NH * SEQ / 4), dim3(256), 0, stream, Qb, Kb, Vb, kmean, Ob); continue; }
#endif
        a.lo = pc; a.hi = pc + 1;
        hipLaunchKernelGGL(mega, dim3(grid), dim3(NWAVES * 64), LDS_BYTES, stream, a);
    }
#endif
}
```

```cpp
#include <hip/hip_runtime.h>
#include <cstdio>
#include <cstdint>

#define LAS __attribute__((address_space(3)))
typedef _Float16 f16;
typedef unsigned short u16;
typedef float f32x4 __attribute__((ext_vector_type(4)));
typedef float f32x2 __attribute__((ext_vector_type(2)));
typedef _Float16 f16x2 __attribute__((ext_vector_type(2)));
typedef _Float16 f16x4 __attribute__((ext_vector_type(4)));
typedef _Float16 f16x8 __attribute__((ext_vector_type(8)));
typedef unsigned u32x4 __attribute__((ext_vector_type(4)));

constexpr int DM = 2048, BATCH = 2, SEQ = 4096, M = BATCH * SEQ, FF = 5632, MODW = 9 * DM;
constexpr int HD = 128, NH = 16, NKV = 4, MBLK = 256, NBLK = SEQ / MBLK;
constexpr float EPS = 1e-6f;
constexpr float ATT_SCALE = 0.08838834764831845f;

constexpr size_t MiB = 1u << 20;
constexpr size_t WS_CTL = 0;
constexpr size_t WS_MODS = 1 * MiB;
constexpr size_t WS_LBT = 1 * MiB + 512 * 1024;
constexpr size_t WS_ROPE = 2 * MiB;
constexpr size_t WS_KMEAN = 4 * MiB;
constexpr size_t WS_H = 8 * MiB;
constexpr size_t WS_HKV = 40 * MiB;
constexpr size_t WS_Y = 72 * MiB;
constexpr size_t WS_K = 136 * MiB;
constexpr size_t WS_V = 144 * MiB;
constexpr size_t WS_ST = 152 * MiB;
constexpr size_t WS_RA = 176 * MiB;
constexpr size_t WS_QH = WS_RA, WS_KH = WS_RA + 32 * MiB, WS_VH = WS_RA + 64 * MiB, WS_GH = WS_RA + 96 * MiB, WS_LF = WS_RA + 128 * MiB, WS_OG = WS_RA + 192 * MiB;
constexpr size_t WS_ACT = WS_RA;
constexpr size_t WS_Q = WS_RA, WS_O = WS_RA + 32 * MiB;
constexpr size_t WS_C = 400 * MiB;
constexpr size_t WS_W16 = 752 * MiB;
constexpr size_t WS_END = 1100 * MiB;

__device__ __forceinline__ float silu_f(float x) { return x / (1.f + __expf(-x)); }
__device__ __forceinline__ float wave_sum(float v) {
#pragma unroll
    for (int o = 1; o < 64; o <<= 1) v += __shfl_xor(v, o);
    return v;
}

__device__ __forceinline__ u16 f2bf(float f) { unsigned u = __builtin_bit_cast(unsigned, f); return (u16)((u + 0x7fffu + ((u >> 16) & 1u)) >> 16); }
__device__ __forceinline__ float bf2f(u16 b) { return __builtin_bit_cast(float, (unsigned)b << 16); }
__device__ __forceinline__ int lane_id_opaque() { int l; asm volatile("v_mbcnt_lo_u32_b32 %0, -1, 0\n\tv_mbcnt_hi_u32_b32 %0, -1, %0" : "=v"(l)); return l; }

__global__ __launch_bounds__(512) void k_mods(const float* __restrict__ c, const float* __restrict__ ada_w, const float* __restrict__ ada_b, float* __restrict__ mods) {
    __shared__ float sc[2][DM];
    __shared__ float red[8][2][64];
    const int tid = threadIdx.x, lane = tid & 63, w = tid >> 6;
    for (int i = tid; i < 2 * DM; i += 512) sc[i / DM][i % DM] = silu_f(c[i]);
    __syncthreads();
    const int nchunk = MODW / 64;
    for (int u = blockIdx.x; u < 2 * nchunk; u += gridDim.x) {
        const int l = u / nchunk, c0 = (u % nchunk) * 64;
        const float* W = ada_w + (size_t)l * DM * MODW + c0 + lane;
        float a0 = 0.f, a1 = 0.f;
        const int k0 = w * 256;
#pragma unroll 8
        for (int k = 0; k < 256; ++k) { const float wv = W[(size_t)(k0 + k) * MODW]; a0 += sc[0][k0 + k] * wv; a1 += sc[1][k0 + k] * wv; }
        red[w][0][lane] = a0; red[w][1][lane] = a1;
        __syncthreads();
        if (tid < 128) { const int b = tid >> 6; float s = 0.f;
#pragma unroll
            for (int ww = 0; ww < 8; ++ww) s += red[ww][b][lane];
            mods[(size_t)(l * 2 + b) * MODW + c0 + lane] = s + ada_b[(size_t)l * MODW + c0 + lane]; }
        __syncthreads();
    }
}
__global__ void k_rope(float* __restrict__ rope) {
    const int i = blockIdx.x * blockDim.x + threadIdx.x;
    if (i >= SEQ * 64) return;
    const int t = i / 64, d = i % 64;
    const float inv = powf(10000.0f, -(float)d / 64.0f);
    const float ang = (float)t * inv;
    float s, c; sincosf(ang, &s, &c);
    rope[i] = c; rope[SEQ * 64 + i] = s;
}

struct NormArgs {
    const float* x_in; const float* y; float* x_out; f16* h; f16* h2;
    const float* gate; const float* post; const float* pre; const float* scale; const float* shift; const float* kvn;
    float w; int has_y, has_h, has_kv, pad;
};
__device__ __forceinline__ void norm_rows(const NormArgs& a, int gw, int ngw, int lane) {
    for (int row = gw; row < M; row += ngw) {
        const int b = row / SEQ;
        const f32x4* xr = (const f32x4*)(a.x_in + (size_t)row * DM) + lane;
        f32x4 v[8];
#pragma unroll
        for (int j = 0; j < 8; ++j) v[j] = xr[64 * j];
        if (a.has_y) {
            const f32x4* yr = (const f32x4*)(a.y + (size_t)row * DM) + lane;
            f32x4 yv[8]; float s = 0.f;
#pragma unroll
            for (int j = 0; j < 8; ++j) { yv[j] = yr[64 * j]; s += (yv[j].x * yv[j].x + yv[j].y * yv[j].y) + (yv[j].z * yv[j].z + yv[j].w * yv[j].w); }
            const float r1 = rsqrtf(wave_sum(s) * (1.f / DM) + EPS) * a.w;
            const f32x4* gp = (const f32x4*)(a.gate + (size_t)b * MODW) + lane; const f32x4* pp = (const f32x4*)a.post + lane;
#pragma unroll
            for (int j = 0; j < 8; ++j) { const f32x4 g = gp[64 * j], p = pp[64 * j]; v[j] = v[j] + (yv[j] * r1) * p * g; }
            f32x4* xo = (f32x4*)(a.x_out + (size_t)row * DM) + lane;
#pragma unroll
            for (int j = 0; j < 8; ++j) xo[64 * j] = v[j];
        }
        if (a.has_h || a.has_kv) {
            float s = 0.f;
#pragma unroll
            for (int j = 0; j < 8; ++j) s += (v[j].x * v[j].x + v[j].y * v[j].y) + (v[j].z * v[j].z + v[j].w * v[j].w);
            const float r2 = rsqrtf(wave_sum(s) * (1.f / DM) + EPS);
            if (a.has_h) {
                const f32x4* pp = (const f32x4*)a.pre + lane; const f32x4* sp = (const f32x4*)(a.scale + (size_t)b * MODW) + lane; const f32x4* hp = (const f32x4*)(a.shift + (size_t)b * MODW) + lane;
                f16x4* ho = (f16x4*)(a.h + (size_t)row * DM) + lane;
#pragma unroll
                for (int j = 0; j < 8; ++j) { const f32x4 p = pp[64 * j], sc = sp[64 * j], sh = hp[64 * j]; const f32x4 o = (v[j] * r2) * p * (sc + 1.f) + sh;
                    ho[64 * j] = __builtin_convertvector(o, f16x4); }
            }
            if (a.has_kv) {
                const f32x4* pp = (const f32x4*)a.kvn + lane; f16x4* ho = (f16x4*)(a.h2 + (size_t)row * DM) + lane;
#pragma unroll
                for (int j = 0; j < 8; ++j) { const f32x4 o = (v[j] * r2) * pp[64 * j]; ho[64 * j] = __builtin_convertvector(o, f16x4); }
            }
        }
    }
}
__device__ __forceinline__ void norm_rows_lds(const NormArgs& a, LAS unsigned char* lds, const int vcu, const int G, const int wave, const int lane) {
    const int rows_per_wg = M / G, row0 = vcu * rows_per_wg, b = row0 / SEQ, tid = wave * 64 + lane;
    LAS f32x4* LA = (LAS f32x4*)lds; LAS f32x4* LB = LA + 512; LAS f32x4* LC = LA + 1024; LAS f32x4* LK = LA + 1536;
    { const int i = tid;
      if (a.has_y) { const f32x4 g = ((const f32x4*)(a.gate + (size_t)b * MODW))[i], p = ((const f32x4*)a.post)[i]; LA[i] = g * p * a.w; }
      if (a.has_h) { const f32x4 p = ((const f32x4*)a.pre)[i], sc = ((const f32x4*)(a.scale + (size_t)b * MODW))[i]; LB[i] = p * (sc + 1.f); LC[i] = ((const f32x4*)(a.shift + (size_t)b * MODW))[i]; }
      if (a.has_kv) LK[i] = ((const f32x4*)a.kvn)[i]; }
    __syncthreads();
    for (int rr = wave * 2; rr < rows_per_wg; rr += 16) {
        const int row = row0 + rr;
        f32x4 v[2][8], yv[2][8];
#pragma unroll
        for (int q = 0; q < 2; ++q) { const f32x4* xr = (const f32x4*)(a.x_in + (size_t)(row + q) * DM) + lane;
#pragma unroll
            for (int j = 0; j < 8; ++j) v[q][j] = xr[64 * j]; }
        if (a.has_y) {
#pragma unroll
            for (int q = 0; q < 2; ++q) { const f32x4* yr = (const f32x4*)(a.y + (size_t)(row + q) * DM) + lane;
#pragma unroll
                for (int j = 0; j < 8; ++j) yv[q][j] = yr[64 * j]; }
#pragma unroll
            for (int q = 0; q < 2; ++q) { float s = 0.f;
#pragma unroll
                for (int j = 0; j < 8; ++j) s += (yv[q][j].x * yv[q][j].x + yv[q][j].y * yv[q][j].y) + (yv[q][j].z * yv[q][j].z + yv[q][j].w * yv[q][j].w);
                const float r1 = rsqrtf(wave_sum(s) * (1.f / DM) + EPS);
                f32x4* xo = (f32x4*)(a.x_out + (size_t)(row + q) * DM) + lane;
#pragma unroll
                for (int j = 0; j < 8; ++j) { v[q][j] = v[q][j] + (yv[q][j] * r1) * LA[lane + 64 * j]; xo[64 * j] = v[q][j]; } }
        }
        if (a.has_h || a.has_kv) {
#pragma unroll
            for (int q = 0; q < 2; ++q) { float s = 0.f;
#pragma unroll
                for (int j = 0; j < 8; ++j) s += (v[q][j].x * v[q][j].x + v[q][j].y * v[q][j].y) + (v[q][j].z * v[q][j].z + v[q][j].w * v[q][j].w);
                const float r2 = rsqrtf(wave_sum(s) * (1.f / DM) + EPS);
                if (a.has_h) { f16x4* ho = (f16x4*)(a.h + (size_t)(row + q) * DM) + lane;
#pragma unroll
                    for (int j = 0; j < 8; ++j) { const f32x4 o = (v[q][j] * r2) * LB[lane + 64 * j] + LC[lane + 64 * j]; ho[64 * j] = __builtin_convertvector(o, f16x4); } }
                if (a.has_kv) { f16x4* ho = (f16x4*)(a.h2 + (size_t)(row + q) * DM) + lane;
#pragma unroll
                    for (int j = 0; j < 8; ++j) { const f32x4 o = (v[q][j] * r2) * LK[lane + 64 * j]; ho[64 * j] = __builtin_convertvector(o, f16x4); } }
            }
        }
    }
    __syncthreads();
}
__global__ __launch_bounds__(512) void k_norm(NormArgs a) {
    const int lane = threadIdx.x & 63, w = threadIdx.x >> 6;
    norm_rows(a, blockIdx.x * 8 + w, gridDim.x * 8, lane);
}


namespace pg8 {
#define PG8_LAS __attribute__((address_space(3)))
typedef unsigned short bf16_t;
typedef _Float16 bf16x8 __attribute__((ext_vector_type(8)));
typedef float f32x4 __attribute__((ext_vector_type(4)));
typedef unsigned u32x4 __attribute__((ext_vector_type(4)));
constexpr int BM = 256, BK = 64, HALF = 128, HTB = HALF * BK * 2  , STAGE_BYTES = 8 * HTB, NXCD = 8, WGM = 8;

__host__ __device__ __forceinline__ int lds_byte(int r, int c) { const int st = (r >> 4) * 2 + (c >> 5), rr = r & 15, cc = c & 31, ob = rr * 64 + cc * 2; return st * 1024 + (ob ^ (((ob >> 9) & 1) << 5)); }
__host__ __device__ __forceinline__ void stage_rc(int b, int& R, int& C) { const int st = b / 1024, sb = b % 1024, swz = sb ^ (((sb >> 9) & 1) << 5); R = (st >> 1) * 16 + swz / 64; C = (st & 1) * 32 + (swz % 64) / 2; }
__host__ __device__ __forceinline__ int perm32(int rho) { const int n = rho >> 4, i = rho & 15; return 8 * (i >> 2) + 4 * n + (i & 3); }

struct Unit { int pm, pn; };
struct Gemm { const bf16_t* A; const bf16_t* Bt; int M, N, K; };

struct StaticOrder {
    int nM, nN, nwg, G, c;
    __host__ __device__ void init(int M, int N, int G_, int c_) { nM = M / BM; nN = N / BM; nwg = nM * nN; G = G_; c = c_; }
    __host__ __device__ bool next(int i, Unit& u) const {
        const long L = (long)i * G + c; if (L >= nwg) return false;
        int wgid = (int)L; { const int q = nwg / NXCD, r = nwg % NXCD, xcd = wgid % NXCD, off = wgid / NXCD; wgid = (xcd < r ? xcd * (q + 1) : r * (q + 1) + (xcd - r) * q) + off; }
        const int nig = WGM * nN, gid = wgid / nig, fm = gid * WGM, gsz = (nM - fm) < WGM ? (nM - fm) : WGM;
        u.pm = fm + ((wgid % nig) % gsz); u.pn = (wgid % nig) / gsz; return true;
    }
    __device__ __forceinline__ void a_ready(const Unit&) const {}
    __device__ __forceinline__ void done(const Unit&) const {}
};
template <class Epi, class Sched, bool ALIGN_EPI = false, bool SP2 = false>
__device__ __forceinline__ void gemm_phase(PG8_LAS unsigned char* lds, const Gemm g, const Sched& S, const Epi& E, const int wid  ) {
    const int lane = lane_id_opaque(), tid = wid * 64 + lane, wr = wid >> 2, wc = wid & 3, fr = lane & 15, fq = lane >> 4;
    const int K = g.K, nt = K / BK;
    unsigned voffA[2], voffB[2];
#pragma unroll
    for (int i = 0; i < 2; ++i) { int R, C; stage_rc(tid * 16 + i * 8192, R, C); const int Rb = Epi::PERM ? ((R & ~31) + perm32(R & 31)) : R;
        voffA[i] = (unsigned)(R * K + C) * 2u; voffB[i] = (unsigned)(Rb * K + C) * 2u; }
    const size_t kstep = (size_t)(BK * 2);
    const size_t hstep = (size_t)HALF * K * 2;
    const size_t tstep = 2 * hstep;
    const unsigned ldsw = (unsigned)wid * 1024u;
    const int aoff = lds_byte(wr * 64 + fr, fq * 8), boff = lds_byte(wc * 32 + fr, fq * 8);
#define PG8_SA(b, h) (((b) * 2 + (h)) * HTB)
#define PG8_SB(b, h) ((4 + (b) * 2 + (h)) * HTB)
#define PG8_STAGE(bufoff, gbase, voff) do { _Pragma("unroll") for (int _i = 0; _i < 2; ++_i) \
        __builtin_amdgcn_global_load_lds((const unsigned*)((const char*)(gbase) + (voff)[_i]), (PG8_LAS unsigned*)(lds + (bufoff) + ldsw + _i * 8192), 16, 0, 0); } while (0)
#define PG8_LDA(dst, b, h) do { _Pragma("unroll") for (int m = 0; m < 4; ++m) _Pragma("unroll") for (int k = 0; k < 2; ++k) dst[m][k] = *(const PG8_LAS bf16x8*)(lds + PG8_SA(b, h) + aoff + m * 2048 + k * 1024); } while (0)
#define PG8_LDB(dst, b, h) do { _Pragma("unroll") for (int n = 0; n < 2; ++n) _Pragma("unroll") for (int k = 0; k < 2; ++k) dst[n][k] = *(const PG8_LAS bf16x8*)(lds + PG8_SB(b, h) + boff + n * 2048 + k * 1024); } while (0)
#define PG8_MMA(ai, bj, At, Bt) do { __builtin_amdgcn_s_setprio(1); _Pragma("unroll") for (int m = 0; m < 4; ++m) _Pragma("unroll") for (int n = 0; n < 2; ++n) _Pragma("unroll") for (int k = 0; k < 2; ++k) \
        acc[ai][bj][m][n] = __builtin_amdgcn_mfma_f32_16x16x32_f16(Bt[n][k], At[m][k], acc[ai][bj][m][n], 0, 0, 0); __builtin_amdgcn_s_setprio(0); } while (0)
#define PG8_WAIT_V(n) asm volatile("s_waitcnt vmcnt(" #n ")" ::: "memory")
#define PG8_WAIT_L(n) asm volatile("s_waitcnt lgkmcnt(" #n ")" ::: "memory")
#define PG8_BAR __builtin_amdgcn_s_barrier()
#define PG8_SCHED __builtin_amdgcn_sched_barrier(0)
    Unit cur, nxt; int ui = 0;
    if (!S.next(0, cur)) return;
    f32x4 acc[2][2][4][2];
#pragma unroll
    for (int a = 0; a < 2; ++a)
#pragma unroll
        for (int b = 0; b < 2; ++b)
#pragma unroll
            for (int m = 0; m < 4; ++m)
#pragma unroll
                for (int n = 0; n < 2; ++n) acc[a][b][m][n] = (f32x4){0.f, 0.f, 0.f, 0.f};
    bf16x8 At[4][2], B0[2][2], B1[2][2];
    const char* cA = (const char*)g.A + (size_t)cur.pm * tstep; const char* cB = (const char*)g.Bt + (size_t)cur.pn * tstep;
    S.a_ready(cur);
    if constexpr (SP2) {
        PG8_STAGE(PG8_SB(0, 0), cB, voffB); PG8_STAGE(PG8_SB(0, 1), cB + hstep, voffB); PG8_STAGE(PG8_SA(0, 0), cA, voffA); PG8_STAGE(PG8_SA(0, 1), cA + hstep, voffA);
        if (wr == 1) PG8_BAR;
        PG8_WAIT_V(2); PG8_BAR;
        PG8_STAGE(PG8_SB(1, 0), cB + kstep, voffB); PG8_STAGE(PG8_SA(1, 0), cA + kstep, voffA); PG8_STAGE(PG8_SB(1, 1), cB + hstep + kstep, voffB);
        PG8_WAIT_V(6); PG8_BAR;
    } else {
        PG8_STAGE(PG8_SB(0, 0), cB, voffB); PG8_STAGE(PG8_SA(0, 0), cA, voffA); PG8_STAGE(PG8_SB(0, 1), cB + hstep, voffB); PG8_STAGE(PG8_SA(0, 1), cA + hstep, voffA);
        if (wr == 1) PG8_BAR;
        PG8_WAIT_V(4); PG8_BAR;
        PG8_STAGE(PG8_SB(1, 0), cB + kstep, voffB); PG8_STAGE(PG8_SA(1, 0), cA + kstep, voffA); PG8_STAGE(PG8_SB(1, 1), cB + hstep + kstep, voffB);
        PG8_WAIT_V(6); PG8_BAR;
    }
    for (;;) {
        const bool has_next = S.next(ui + 1, nxt);
        const char* nA = has_next ? (const char*)g.A + (size_t)nxt.pm * tstep : cA; const char* nB = has_next ? (const char*)g.Bt + (size_t)nxt.pn * tstep : cB;
        for (int t = 0; t < nt; t += 2) {
            const bool last = (t == nt - 2);
            const char* a1 = cA + (size_t)(t + 1) * kstep;
            const char* a2 = last ? nA : cA + (size_t)(t + 2) * kstep; const char* b2 = last ? nB : cB + (size_t)(t + 2) * kstep;
            const char* a3 = a2 + kstep; const char* b3 = b2 + kstep;
            if (last && has_next) S.a_ready(nxt);
            if constexpr (SP2) {
            PG8_LDB(B0, 0, 0); PG8_LDB(B1, 0, 1); PG8_SCHED; PG8_LDA(At, 0, 0); PG8_STAGE(PG8_SA(1, 1), a1 + hstep, voffA);
            PG8_WAIT_V(8); PG8_WAIT_L(0); PG8_BAR; PG8_MMA(0, 0, At, B0); PG8_MMA(0, 1, At, B1); PG8_BAR; PG8_SCHED;
            PG8_LDA(At, 0, 1); PG8_STAGE(PG8_SB(0, 0), b2, voffB); PG8_STAGE(PG8_SB(0, 1), b2 + hstep, voffB); PG8_STAGE(PG8_SA(0, 0), a2, voffA);
            PG8_WAIT_V(8); PG8_WAIT_L(0); PG8_BAR; PG8_MMA(1, 0, At, B0); PG8_MMA(1, 1, At, B1); PG8_BAR; PG8_SCHED;
            PG8_LDB(B0, 1, 0); PG8_LDB(B1, 1, 1); PG8_SCHED; PG8_LDA(At, 1, 0); PG8_STAGE(PG8_SA(0, 1), a2 + hstep, voffA);
            PG8_WAIT_V(8); PG8_WAIT_L(0); PG8_BAR; PG8_MMA(0, 0, At, B0); PG8_MMA(0, 1, At, B1); PG8_BAR; PG8_SCHED;
            PG8_LDA(At, 1, 1); PG8_STAGE(PG8_SB(1, 0), b3, voffB); PG8_STAGE(PG8_SB(1, 1), b3 + hstep, voffB); PG8_STAGE(PG8_SA(1, 0), a3, voffA);
            PG8_WAIT_V(8); PG8_WAIT_L(0); PG8_BAR; PG8_MMA(1, 0, At, B0); PG8_MMA(1, 1, At, B1); PG8_BAR; PG8_SCHED;
            } else {
            PG8_LDB(B0, 0, 0); PG8_SCHED; PG8_LDA(At, 0, 0); PG8_STAGE(PG8_SA(1, 1), a1 + hstep, voffA);
            PG8_WAIT_L(8); PG8_BAR; PG8_WAIT_L(0); PG8_MMA(0, 0, At, B0); PG8_BAR; PG8_SCHED;
            PG8_LDB(B1, 0, 1); PG8_STAGE(PG8_SB(0, 0), b2, voffB);
            PG8_BAR; PG8_WAIT_L(0); PG8_MMA(0, 1, At, B1); PG8_BAR;
            PG8_LDA(At, 0, 1); PG8_STAGE(PG8_SA(0, 0), a2, voffA);
            PG8_BAR; PG8_WAIT_L(0); PG8_MMA(1, 0, At, B0); PG8_BAR; PG8_SCHED;
            PG8_STAGE(PG8_SB(0, 1), b2 + hstep, voffB);
            PG8_WAIT_V(6); PG8_BAR; PG8_MMA(1, 1, At, B1); PG8_BAR;
            PG8_LDB(B0, 1, 0); PG8_SCHED; PG8_LDA(At, 1, 0); PG8_STAGE(PG8_SA(0, 1), a2 + hstep, voffA);
            PG8_WAIT_L(8); PG8_BAR; PG8_WAIT_L(0); PG8_MMA(0, 0, At, B0); PG8_BAR; PG8_SCHED;
            PG8_LDB(B1, 1, 1); PG8_STAGE(PG8_SB(1, 0), b3, voffB);
            PG8_BAR; PG8_WAIT_L(0); PG8_MMA(0, 1, At, B1); PG8_BAR;
            PG8_LDA(At, 1, 1); PG8_STAGE(PG8_SA(1, 0), a3, voffA);
            PG8_BAR; PG8_WAIT_L(0); PG8_MMA(1, 0, At, B0); PG8_BAR; PG8_SCHED;
            PG8_STAGE(PG8_SB(1, 1), b3 + hstep, voffB);
            PG8_WAIT_V(6); PG8_BAR; PG8_MMA(1, 1, At, B1); PG8_BAR;
            }
        }
        if constexpr (ALIGN_EPI) { if (wr == 0) PG8_BAR; }
        if constexpr (!Epi::AFTER_DRAIN) { E(acc, cur, wr, wc, fr, fq); S.done(cur); }
        if (!has_next) break;
#pragma unroll
        for (int a = 0; a < 2; ++a)
#pragma unroll
            for (int b = 0; b < 2; ++b)
#pragma unroll
                for (int m = 0; m < 4; ++m)
#pragma unroll
                    for (int n = 0; n < 2; ++n) acc[a][b][m][n] = (f32x4){0.f, 0.f, 0.f, 0.f};
        cur = nxt; cA = nA; cB = nB; ++ui;
        if constexpr (ALIGN_EPI) { if (wr == 1) PG8_BAR; }
    }
    PG8_WAIT_V(0);
    if constexpr (!ALIGN_EPI) { if (wr == 0) PG8_BAR; }
    PG8_BAR;
    if constexpr (Epi::AFTER_DRAIN) { E.fused(acc, cur, wr, wc, fr, fq, lds, wid, lane); S.done(cur); }
#undef PG8_SA
#undef PG8_SB
#undef PG8_STAGE
#undef PG8_LDA
#undef PG8_LDB
#undef PG8_MMA
#undef PG8_WAIT_V
#undef PG8_WAIT_L
#undef PG8_BAR
#undef PG8_SCHED
}
}

namespace pg8 {
typedef _Float16 h16x8 __attribute__((ext_vector_type(8)));
typedef float f32x8 __attribute__((ext_vector_type(8)));
__device__ __forceinline__ h16x8 cvt8(f32x4 a, f32x4 b) { const f32x8 v = {a[0], a[1], a[2], a[3], b[0], b[1], b[2], b[3]}; return __builtin_convertvector(v, h16x8); }
__device__ __forceinline__ float silu1(float x) { return x * __builtin_amdgcn_rcpf(1.f + __expf(-x)); }
__device__ __forceinline__ f32x4 silu4(f32x4 x) { return (f32x4){silu1(x[0]), silu1(x[1]), silu1(x[2]), silu1(x[3])}; }

struct EpiF32 {
    static constexpr bool PERM = false, AFTER_DRAIN = false;
    float* C; int ldc;
    __device__ __forceinline__ void operator()(const f32x4 (&acc)[2][2][4][2], const Unit& u, int wr, int wc, int, int) const {
        const int lane_ = lane_id_opaque(); const int fr = lane_ & 15, fq = lane_ >> 4;
        const int row0 = u.pm * BM + wr * 64 + fr, col0 = u.pn * BM + wc * 32 + 4 * fq;
#pragma unroll
        for (int ai = 0; ai < 2; ++ai)
#pragma unroll
            for (int m = 0; m < 4; ++m) { float* rowp = C + (size_t)(row0 + ai * HALF + m * 16) * ldc + col0;
#pragma unroll
                for (int bj = 0; bj < 2; ++bj)
#pragma unroll
                    for (int n = 0; n < 2; ++n) *(f32x4*)(rowp + bj * HALF + n * 16) = acc[ai][bj][m][n]; }
    }
};
struct EpiSwiGLU {
    static constexpr bool PERM = true, AFTER_DRAIN = false;
    f16* act;
    __device__ __forceinline__ void operator()(const f32x4 (&acc)[2][2][4][2], const Unit& u, int wr, int wc, int, int) const {
        const int lane_ = lane_id_opaque(); const int fr = lane_ & 15, fq = lane_ >> 4;
        const int row0 = u.pm * BM + wr * 64 + fr, col0 = u.pn * 128 + wc * 32 + 8 * fq;
#pragma unroll
        for (int ai = 0; ai < 2; ++ai)
#pragma unroll
            for (int m = 0; m < 4; ++m) {
                const f32x4 o0 = silu4(acc[ai][0][m][0]) * acc[ai][1][m][0], o1 = silu4(acc[ai][0][m][1]) * acc[ai][1][m][1];
                *(h16x8*)(act + (size_t)(row0 + ai * HALF + m * 16) * FF + col0) = cvt8(o0, o1); }
    }
};
struct EpiHgrn {
    static constexpr bool PERM = true, AFTER_DRAIN = false;
    f16* qh; f16* kh; u16* vh; f16* gh; float* lf; const float* lb;
    __device__ __forceinline__ void operator()(const f32x4 (&acc)[2][2][4][2], const Unit& u, int wr, int wc, int, int) const {
        const int lane_ = lane_id_opaque(); const int fr = lane_ & 15, fq = lane_ >> 4;
        const int grp = u.pn >> 3, row0 = u.pm * BM + wr * 64 + fr, col0 = (u.pn & 7) * BM + wc * 32 + 8 * fq;
        if (grp == 1) {
#pragma unroll
            for (int bj = 0; bj < 2; ++bj) {
                const f32x4 lba = *(const f32x4*)(lb + col0 + bj * HALF), lbb = *(const f32x4*)(lb + col0 + bj * HALF + 4);
#pragma unroll
                for (int ai = 0; ai < 2; ++ai)
#pragma unroll
                    for (int m = 0; m < 4; ++m) { const size_t ro = (size_t)(row0 + ai * HALF + m * 16) * DM + col0 + bj * HALF; f32x4 kk[2], lg[2];
#pragma unroll
                        for (int n = 0; n < 2; ++n)
#pragma unroll
                            for (int j = 0; j < 4; ++j) { const float l = n ? lbb[j] : lba[j]; const float sg = __builtin_amdgcn_rcpf(1.f + __expf(-acc[ai][bj][m][n][j])); const float fg = l + (1.f - l) * sg;
                                kk[n][j] = 1.f - fg; lg[n][j] = __logf(fg); }
                        *(h16x8*)(kh + ro) = cvt8(kk[0], kk[1]);
                        *(f32x4*)(lf + ro) = lg[0]; *(f32x4*)(lf + ro + 4) = lg[1];
                        asm volatile("" ::: "memory"); }
            }
        } else if (grp == 2) {
#pragma unroll
            for (int ai = 0; ai < 2; ++ai)
#pragma unroll
                for (int m = 0; m < 4; ++m) { const size_t ro = (size_t)(row0 + ai * HALF + m * 16) * DM + col0;
#pragma unroll
                    for (int bj = 0; bj < 2; ++bj) { const f32x4 a = acc[ai][bj][m][0], b = acc[ai][bj][m][1];
                        u32x4 w; w.x = f2bf(a[0]) | ((unsigned)f2bf(a[1]) << 16); w.y = f2bf(a[2]) | ((unsigned)f2bf(a[3]) << 16); w.z = f2bf(b[0]) | ((unsigned)f2bf(b[1]) << 16); w.w = f2bf(b[2]) | ((unsigned)f2bf(b[3]) << 16);
                        *(u32x4*)(vh + ro + bj * HALF) = w; } }
        } else {
            f16* dst = grp == 0 ? qh : gh;
#pragma unroll
            for (int ai = 0; ai < 2; ++ai)
#pragma unroll
                for (int m = 0; m < 4; ++m) { const size_t ro = (size_t)(row0 + ai * HALF + m * 16) * DM + col0;
#pragma unroll
                    for (int bj = 0; bj < 2; ++bj) *(h16x8*)(dst + ro + bj * HALF) = cvt8(silu4(acc[ai][bj][m][0]), silu4(acc[ai][bj][m][1])); }
        }
    }
};
struct EpiRot {
    static constexpr bool PERM = true, AFTER_DRAIN = false;
    f16* dst; int nheads; const float* rope; float* kmean; f16* vdst; int nrot;
    __device__ __forceinline__ void operator()(const f32x4 (&acc)[2][2][4][2], const Unit& u, int wr, int wc, int, int) const {
        const int lane_ = lane_id_opaque(); const int fr = lane_ & 15, fq = lane_ >> 4;
        const int b = u.pm >> 4, t0 = (u.pm & 15) * BM + wr * 64 + fr;
        if (u.pn < nrot) {
            const int head = 2 * u.pn + (wc >> 1), dd0 = 32 * (wc & 1) + 8 * fq;
            f16* base = dst + ((size_t)(b * nheads + head) * SEQ) * 128 + dd0;
            f32x4 s1a = {0.f, 0.f, 0.f, 0.f}, s1b = s1a, s2a = s1a, s2b = s1a;
#pragma unroll
            for (int ai = 0; ai < 2; ++ai)
#pragma unroll
                for (int m = 0; m < 4; ++m) { const int t = t0 + ai * HALF + m * 16;
                    const f32x4 c0 = *(const f32x4*)(rope + t * 64 + dd0), c1 = *(const f32x4*)(rope + t * 64 + dd0 + 4), s0 = *(const f32x4*)(rope + SEQ * 64 + t * 64 + dd0), s1 = *(const f32x4*)(rope + SEQ * 64 + t * 64 + dd0 + 4);
                    const f32x4 xa = acc[ai][0][m][0], xb = acc[ai][0][m][1], ya = acc[ai][1][m][0], yb = acc[ai][1][m][1];
                    const f32x4 o1a = xa * c0 - ya * s0, o1b = xb * c1 - yb * s1, o2a = ya * c0 + xa * s0, o2b = yb * c1 + xb * s1;
                    *(h16x8*)(base + (size_t)t * 128) = cvt8(o1a, o1b); *(h16x8*)(base + (size_t)t * 128 + 64) = cvt8(o2a, o2b);
                    s1a += o1a; s1b += o1b; s2a += o2a; s2b += o2b; }
            if (kmean) {
#pragma unroll
                for (int j = 0; j < 4; ++j) {
#pragma unroll
                    for (int o = 1; o < 16; o <<= 1) { s1a[j] += __shfl_xor(s1a[j], o); s1b[j] += __shfl_xor(s1b[j], o); s2a[j] += __shfl_xor(s2a[j], o); s2b[j] += __shfl_xor(s2b[j], o); } }
                if (fr == 0) { float* km = kmean + ((size_t)(b * nheads + head) * NBLK + (u.pm & 15)) * 128 + dd0;
#pragma unroll
                    for (int j = 0; j < 4; ++j) { atomicAdd(km + j, s1a[j] * (1.f / MBLK)); atomicAdd(km + 4 + j, s1b[j] * (1.f / MBLK)); atomicAdd(km + 64 + j, s2a[j] * (1.f / MBLK)); atomicAdd(km + 68 + j, s2b[j] * (1.f / MBLK)); } }
            }
        } else {
            const int d0 = 32 * wc + 8 * fq;
#pragma unroll
            for (int bj = 0; bj < 2; ++bj) { f16* base = vdst + ((size_t)(b * nheads + 2 * (u.pn - nrot) + bj) * SEQ) * 128 + d0;
#pragma unroll
                for (int ai = 0; ai < 2; ++ai)
#pragma unroll
                    for (int m = 0; m < 4; ++m) *(h16x8*)(base + (size_t)(t0 + ai * HALF + m * 16) * 128) = cvt8(acc[ai][bj][m][0], acc[ai][bj][m][1]); }
        }
    }
};
}

__global__ __launch_bounds__(256) void k_naive_gemm(const f16* __restrict__ A, const float* __restrict__ W, float* __restrict__ C, int N, int K) {
    __shared__ float As[16][132];
    __shared__ float Bs[16][132];
    const int tid = threadIdx.x, tx = tid & 15, ty = tid >> 4;
    const int bm = blockIdx.y * 128, bn = blockIdx.x * 128;
    float acc[8][8];
#pragma unroll
    for (int i = 0; i < 8; ++i)
#pragma unroll
        for (int j = 0; j < 8; ++j) acc[i][j] = 0.f;
    const int ar = tid >> 1, ac = (tid & 1) * 8;
    const int br = tid >> 4, bc = (tid & 15) * 8;
    for (int k0 = 0; k0 < K; k0 += 16) {
        const f16x8 av = *(const f16x8*)(A + (size_t)(bm + ar) * K + k0 + ac);
        const f32x4 b0 = *(const f32x4*)(W + (size_t)(k0 + br) * N + bn + bc), b1 = *(const f32x4*)(W + (size_t)(k0 + br) * N + bn + bc + 4);
        __syncthreads();
#pragma unroll
        for (int i = 0; i < 8; ++i) As[ac + i][ar] = (float)av[i];
        *(f32x4*)&Bs[br][bc] = b0; *(f32x4*)&Bs[br][bc + 4] = b1;
        __syncthreads();
#pragma unroll
        for (int kk = 0; kk < 16; ++kk) {
            float a[8], b[8];
            const f32x4 a0 = *(const f32x4*)&As[kk][ty * 8], a1 = *(const f32x4*)&As[kk][ty * 8 + 4];
            const f32x4 bb0 = *(const f32x4*)&Bs[kk][tx * 8], bb1 = *(const f32x4*)&Bs[kk][tx * 8 + 4];
            a[0] = a0.x; a[1] = a0.y; a[2] = a0.z; a[3] = a0.w; a[4] = a1.x; a[5] = a1.y; a[6] = a1.z; a[7] = a1.w;
            b[0] = bb0.x; b[1] = bb0.y; b[2] = bb0.z; b[3] = bb0.w; b[4] = bb1.x; b[5] = bb1.y; b[6] = bb1.z; b[7] = bb1.w;
#pragma unroll
            for (int i = 0; i < 8; ++i)
#pragma unroll
                for (int j = 0; j < 8; ++j) acc[i][j] += a[i] * b[j];
        }
    }
#pragma unroll
    for (int i = 0; i < 8; ++i) {
        float* cp = C + (size_t)(bm + ty * 8 + i) * N + bn + tx * 8;
        *(f32x4*)cp = (f32x4){acc[i][0], acc[i][1], acc[i][2], acc[i][3]}; *(f32x4*)(cp + 4) = (f32x4){acc[i][4], acc[i][5], acc[i][6], acc[i][7]};
    }
}
__global__ void k_naive_ffn_act(const float* __restrict__ C, f16* __restrict__ act) {
    const size_t i = (size_t)blockIdx.x * blockDim.x + threadIdx.x;
    if (i >= (size_t)M * FF) return;
    const size_t m = i / FF, j = i % FF;
    act[i] = (f16)(silu_f(C[m * (2 * FF) + j]) * C[m * (2 * FF) + FF + j]);
}
__global__ void k_naive_hgrn_split(const float* __restrict__ C, const float* __restrict__ hgrn_lb, f16* __restrict__ qh, f16* __restrict__ kh, u16* __restrict__ vh, f16* __restrict__ gh, float* __restrict__ lf) {
    const size_t i = (size_t)blockIdx.x * blockDim.x + threadIdx.x;
    if (i >= (size_t)M * DM) return;
    const size_t m = i / DM, j = i % DM;
    const float* c = C + m * (4 * DM);
    const float l0 = hgrn_lb[j], l1 = hgrn_lb[DM + j];
    const float lb = 1.f / (1.f + expf(l1 - l0));
    const float sg = 1.f / (1.f + expf(-c[DM + j]));
    const float forget = lb + (1.f - lb) * sg;
    qh[i] = (f16)silu_f(c[j]);
    kh[i] = (f16)(1.f - forget);
    lf[i] = logf(forget);
    vh[i] = f2bf(c[2 * DM + j]);
    gh[i] = (f16)silu_f(c[3 * DM + j]);
}
__global__ __launch_bounds__(128) void k_naive_scan(const f16* __restrict__ qh, const f16* __restrict__ kh, const u16* __restrict__ vh, const f16* __restrict__ gh, const float* __restrict__ lf,
                                                   const float* __restrict__ gnorm, f16* __restrict__ og) {
    __shared__ float qs[8][128], ks[8][128], fs[8][128];
    __shared__ float red[2];
    const int b = blockIdx.x / NH, h = blockIdx.x % NH, e = threadIdx.x;
    float S[128];
#pragma unroll
    for (int d = 0; d < 128; ++d) S[d] = 0.f;
    const float gn = gnorm[e];
    for (int t0 = 0; t0 < SEQ; t0 += 8) {
        __syncthreads();
#pragma unroll
        for (int i = 0; i < 8; ++i) { const size_t o = (size_t)(b * SEQ + t0 + i) * DM + h * 128 + e; qs[i][e] = (float)qh[o]; ks[i][e] = (float)kh[o]; fs[i][e] = __expf(lf[o]); }
        __syncthreads();
        for (int i = 0; i < 8; ++i) {
            const size_t o = (size_t)(b * SEQ + t0 + i) * DM + h * 128 + e;
            const float v = bf2f(vh[o]);
            float acc = 0.f;
#pragma unroll
            for (int d = 0; d < 128; d += 4) {
                const f32x4 f = *(const f32x4*)&fs[i][d], k = *(const f32x4*)&ks[i][d], q = *(const f32x4*)&qs[i][d];
                S[d] = f.x * S[d] + k.x * v; S[d + 1] = f.y * S[d + 1] + k.y * v; S[d + 2] = f.z * S[d + 2] + k.z * v; S[d + 3] = f.w * S[d + 3] + k.w * v;
                acc += S[d] * q.x + S[d + 1] * q.y + S[d + 2] * q.z + S[d + 3] * q.w;
            }
            const float ss = wave_sum(acc * acc);
            __syncthreads();
            if ((e & 63) == 0) red[e >> 6] = ss;
            __syncthreads();
            const float rstd = rsqrtf((red[0] + red[1]) * (1.f / 128.f) + EPS);
            og[o] = (f16)(acc * rstd * gn * (float)gh[o]);
        }
    }
}
__global__ void k_naive_kv_split(const float* __restrict__ C, const float* __restrict__ rope, f16* __restrict__ K, f16* __restrict__ V) {
    const size_t i = (size_t)blockIdx.x * blockDim.x + threadIdx.x;
    if (i >= (size_t)M * 512) return;
    const int m = (int)(i / 512), j = (int)(i % 512), hh = j / 128, d = j % 128, b = m / SEQ, t = m % SEQ;
    const float* c = C + (size_t)m * 1024;
    const int dd = d & 63; const float cs = rope[t * 64 + dd], sn = rope[SEQ * 64 + t * 64 + dd];
    const float x1 = c[hh * 128 + dd], x2 = c[hh * 128 + dd + 64];
    const float r = d < 64 ? x1 * cs - x2 * sn : x2 * cs + x1 * sn;
    const size_t o = ((size_t)(b * NKV + hh) * SEQ + t) * 128 + d;
    K[o] = (f16)r; V[o] = (f16)c[512 + j];
}
__global__ void k_naive_kmean(const float* __restrict__ C, const float* __restrict__ rope, float* __restrict__ kmean) {
    const int i = blockIdx.x * blockDim.x + threadIdx.x;
    if (i >= BATCH * NKV * NBLK * 128) return;
    const int d = i % 128, blk = (i / 128) % NBLK, hh = (i / (128 * NBLK)) % NKV, b = i / (128 * NBLK * NKV);
    const int dd = d & 63; float s = 0.f;
    for (int tt = 0; tt < MBLK; ++tt) { const int t = blk * MBLK + tt; const float* c = C + (size_t)(b * SEQ + t) * 1024;
        const float cs = rope[t * 64 + dd], sn = rope[SEQ * 64 + t * 64 + dd], x1 = c[hh * 128 + dd], x2 = c[hh * 128 + dd + 64];
        s += d < 64 ? x1 * cs - x2 * sn : x2 * cs + x1 * sn; }
    kmean[i] = s * (1.f / MBLK);
}
__global__ void k_naive_q_split(const float* __restrict__ C, const float* __restrict__ rope, f16* __restrict__ Q) {
    const size_t i = (size_t)blockIdx.x * blockDim.x + threadIdx.x;
    if (i >= (size_t)M * DM) return;
    const int m = (int)(i / DM), j = (int)(i % DM), hh = j / 128, d = j % 128, b = m / SEQ, t = m % SEQ;
    const float* c = C + (size_t)m * DM;
    const int dd = d & 63; const float cs = rope[t * 64 + dd], sn = rope[SEQ * 64 + t * 64 + dd];
    const float x1 = c[hh * 128 + dd], x2 = c[hh * 128 + dd + 64];
    const float r = d < 64 ? x1 * cs - x2 * sn : x2 * cs + x1 * sn;
    Q[((size_t)(b * NH + hh) * SEQ + t) * 128 + d] = (f16)r;
}
__global__ __launch_bounds__(256) void k_naive_attn(const f16* __restrict__ Q, const f16* __restrict__ K, const f16* __restrict__ V, const float* __restrict__ kmean, f16* __restrict__ O) {
    __shared__ float qs[4][128];
    __shared__ float sc[4][4 * MBLK];
    const int w = threadIdx.x >> 6, lane = threadIdx.x & 63;
    const int qi = blockIdx.x * 4 + w;
    const int t = qi % SEQ, bh = qi / SEQ, h = bh % NH, b = bh / NH, kvh = h / (NH / NKV), own = t / MBLK;
    const f16* q = Q + (size_t)qi * 128;
    qs[w][lane] = (float)q[lane]; qs[w][lane + 64] = (float)q[lane + 64];
    __syncthreads();
    float g = -__builtin_inff();
    if (lane < own) { const float* km = kmean + ((size_t)(b * NKV + kvh) * NBLK + lane) * 128; float s = 0.f; for (int d = 0; d < 128; ++d) s += qs[w][d] * km[d]; g = s; }
    int b0 = 0, b1 = 0, b2 = 0, b3 = 0; const int nsel = own < 3 ? own : 3;
    for (int s = 0; s < 3; ++s) {
        float best = g; int bi = lane;
#pragma unroll
        for (int o = 1; o < 64; o <<= 1) { const float ob = __shfl_xor(best, o); const int oi = __shfl_xor(bi, o); if (ob > best || (ob == best && oi < bi)) { best = ob; bi = oi; } }
        if (s == 0) b0 = bi; else if (s == 1) b1 = bi; else b2 = bi;
        if (lane == bi) g = -__builtin_inff();
    }
    if (nsel == 0) b0 = own; else if (nsel == 1) b1 = own; else if (nsel == 2) b2 = own; else b3 = own;
    const int nb = nsel + 1;
#define BLK_OF(s) ((s) == 0 ? b0 : (s) == 1 ? b1 : (s) == 2 ? b2 : b3)
    const f16* Kb = K + (size_t)(b * NKV + kvh) * SEQ * 128; const f16* Vb = V + (size_t)(b * NKV + kvh) * SEQ * 128;
    float mx = -__builtin_inff();
    for (int s = 0; s < nb; ++s) {
        const int blk = BLK_OF(s);
        for (int kk = lane; kk < MBLK; kk += 64) {
            const int key = blk * MBLK + kk; float a = -__builtin_inff();
            if (key <= t) { const f16x8* kr = (const f16x8*)(Kb + (size_t)key * 128); float acc = 0.f;
                for (int d8 = 0; d8 < 16; ++d8) { const f16x8 kv = kr[d8];
#pragma unroll
                    for (int j = 0; j < 8; ++j) acc += qs[w][d8 * 8 + j] * (float)kv[j]; }
                a = acc * ATT_SCALE; }
            sc[w][s * MBLK + kk] = a; mx = fmaxf(mx, a);
        }
    }
#pragma unroll
    for (int o = 1; o < 64; o <<= 1) mx = fmaxf(mx, __shfl_xor(mx, o));
    float sum = 0.f;
    for (int i = lane; i < nb * MBLK; i += 64) { const float p = __expf(sc[w][i] - mx); sc[w][i] = p; sum += p; }
    sum = wave_sum(sum);
    __syncthreads();
    float o0 = 0.f, o1 = 0.f;
    for (int s = 0; s < nb; ++s) { const int blk = BLK_OF(s);
        for (int kk = 0; kk < MBLK; ++kk) { const float p = sc[w][s * MBLK + kk]; if (p != 0.f) { const f16x2 vv = *(const f16x2*)(Vb + (size_t)(blk * MBLK + kk) * 128 + 2 * lane); o0 += p * (float)vv[0]; o1 += p * (float)vv[1]; } } }
    const float inv = 1.f / sum;
    f16x2 ov; ov[0] = (f16)(o0 * inv); ov[1] = (f16)(o1 * inv);
    *(f16x2*)(O + (size_t)(b * SEQ + t) * DM + h * 128 + 2 * lane) = ov;
}


#define XB_TMO      128
#define XB_XCNT(j)  (256  + 64 * (j))
#define XB_XSUB(j)  (1280 + 64 * (j))
#define XB_XGEN(j)  (2304 + 64 * (j))
#define XB_TOP      3328
#define XB_TOPGEN   3392
#define XCD_BAR_WORDS 3456
#define XB_SPIN_CAP (1u << 18)

__device__ __forceinline__ unsigned xb_ld(unsigned* p)              { return __hip_atomic_load(p, __ATOMIC_RELAXED, __HIP_MEMORY_SCOPE_AGENT); }
__device__ __forceinline__ unsigned xb_add(unsigned* p, unsigned v) { return __hip_atomic_fetch_add(p, v, __ATOMIC_RELAXED, __HIP_MEMORY_SCOPE_AGENT); }
__device__ __forceinline__ unsigned xb_xcc_id() { return (unsigned)__builtin_amdgcn_s_getreg((3 << 11) | 20) & 0xFu; }
#define XB_SPIN(cond, bar) do { unsigned _sp = 0; while (cond) { __builtin_amdgcn_s_sleep(1); \
    if ((++_sp & 255u) == 0u) { if (xb_ld(&(bar)[XB_TMO])) break; if (_sp > XB_SPIN_CAP) { atomicAdd(&(bar)[XB_TMO], 1u); break; } } } } while (0)

struct XcdBarrier {
    unsigned* bar; unsigned x;
    volatile LAS unsigned* st;
};

__device__ __forceinline__ XcdBarrier xcd_barrier_post(unsigned* bar, volatile LAS unsigned* st) {
    XcdBarrier b; b.bar = bar; b.x = xb_xcc_id(); b.st = st;
    if (threadIdx.x == 0) (void)xb_add(&bar[XB_XCNT(b.x)], 1u);
    return b;
}
__device__ __forceinline__ void xcd_barrier_complete(unsigned* bar, unsigned x, unsigned& nloc, unsigned& nx) {
    const unsigned G = gridDim.x * gridDim.y * gridDim.z;
    unsigned sum, cnt, mine, sp = 0u;
    for (;;) {
        sum = 0u; cnt = 0u; mine = 0u;
#pragma unroll
        for (unsigned j = 0; j < 16; ++j) { const unsigned c = xb_ld(&bar[XB_XCNT(j)]); sum += c; cnt += (c > 0u) ? 1u : 0u; mine = (j == x) ? c : mine; }
        if (sum == G) break;
        __builtin_amdgcn_s_sleep(1);
        if ((++sp & 255u) == 0u) { if (xb_ld(&bar[XB_TMO])) break; if (sp > XB_SPIN_CAP) { atomicAdd(&bar[XB_TMO], 1u); break; } }
    }
    nloc = mine > 0u ? mine : 1u; nx = cnt > 0u ? cnt : 1u;
}

__device__ __forceinline__ void xcd_barrier(const XcdBarrier& b, const int wave  ) {
    asm volatile("s_waitcnt vmcnt(0)" ::: "memory");
    __syncthreads();
    if (wave == 0 && lane_id_opaque() == 0) {
        unsigned* bar = b.bar;
        __builtin_amdgcn_s_waitcnt(0);
        unsigned nloc = b.st[0], nx = b.st[1];
        if (nloc == 0u) { xcd_barrier_complete(bar, b.x, nloc, nx); b.st[0] = nloc; b.st[1] = nx; }
        const unsigned old = xb_add(&bar[XB_XSUB(b.x)], 1u);
        const unsigned gen = old / nloc;
        if (old + 1u == (gen + 1u) * nloc) {
            __builtin_amdgcn_fence(__ATOMIC_RELEASE, "agent");
            asm volatile("s_waitcnt vmcnt(0)" ::: "memory");
            const unsigned og = xb_add(&bar[XB_TOP], 1u);
            const unsigned tg = og / nx;
            if (og + 1u == (tg + 1u) * nx) xb_add(&bar[XB_TOPGEN], 1u);
            else XB_SPIN(xb_ld(&bar[XB_TOPGEN]) == tg, bar);
            __builtin_amdgcn_fence(__ATOMIC_ACQUIRE, "agent");
            xb_add(&bar[XB_XGEN(b.x)], 1u);
            asm volatile("s_waitcnt vmcnt(0)" ::: "memory");
        } else {
            XB_SPIN(xb_ld(&bar[XB_XGEN(b.x)]) == gen, bar);
            __builtin_amdgcn_fence(__ATOMIC_ACQUIRE, "agent");
            asm volatile("s_waitcnt vmcnt(0)" ::: "memory");
        }
    }
    __syncthreads();
}

namespace scan {
typedef short bf16x8 __attribute__((ext_vector_type(8)));
typedef short bf16x4 __attribute__((ext_vector_type(4)));
typedef unsigned u32x2 __attribute__((ext_vector_type(2)));
constexpr int QT_STRIDE = 272, KT_STRIDE = 144, OB_STRIDE = 132;
constexpr int SC_QT = 0, SC_KH = 17408, SC_KTT = 34816, SC_VT = 53248, SC_P = 71680, SC_AL = 80896, SC_TW = 81408, SC_OB = 85504, SC_END = SC_OB + 64 * OB_STRIDE * 4;
static_assert(SC_END <= 131072, "scan LDS map");
constexpr size_t ST_ATOT = (size_t)256 * 16384;
__device__ __forceinline__ unsigned pkbf(float lo, float hi) { unsigned r; asm volatile("v_cvt_pk_bf16_f32 %0, %1, %2" : "=v"(r) : "v"(lo), "v"(hi)); return r; }
#define MFMA16(a, b, c) __builtin_amdgcn_mfma_f32_16x16x32_bf16((a), (b), (c), 0, 0, 0)

template <bool PHASE_A>
__device__ __forceinline__ void scan_unit(LAS unsigned char* lds, const int u, const int w, const int lane, const f16* __restrict__ QH, const f16* __restrict__ KH, const u16* __restrict__ VH,
                                          const f16* __restrict__ GH, const float* __restrict__ LF, const float* __restrict__ gnorm, float* __restrict__ ST, f16* __restrict__ OG) {
    const int bh = u >> 3, sc = u & 7, b = bh >> 4, h = bh & 15, fl = lane & 15, g = lane >> 4, tid = w * 64 + lane;
    const size_t tok0 = (size_t)b * SEQ + (size_t)sc * 512;
    const size_t eoff = (size_t)h * 128 + 2 * lane;
    LAS unsigned char* Qt = lds + SC_QT; LAS unsigned char* Kh = lds + SC_KH; LAS unsigned char* KtT = lds + SC_KTT; LAS unsigned char* VT = lds + SC_VT; LAS unsigned char* P = lds + SC_P;
    LAS float* AL = (LAS float*)(lds + SC_AL); LAS float* TW = (LAS float*)(lds + SC_TW); LAS float* OB = (LAS float*)(lds + SC_OB);
    f32x4 X[8];
    float* STu = ST + (size_t)u * 16384;
    if (PHASE_A) {
#pragma unroll
        for (int i = 0; i < 8; ++i) X[i] = (f32x4){0.f, 0.f, 0.f, 0.f};
    } else {
#pragma unroll
        for (int i = 0; i < 8; ++i)
#pragma unroll
            for (int r = 0; r < 4; ++r) X[i][r] = STu[(16 * i + 4 * g + r) * 128 + 16 * w + fl];
    }
    float cs0 = 0.f, cs1 = 0.f;
    unsigned rq[8], rk[8], rv[8]; f32x2 rl[8];
#define SCAN_LOAD(c) do { _Pragma("unroll") for (int i = 0; i < 8; ++i) { const size_t o = (tok0 + (size_t)(c) * 64 + 8 * w + i) * DM + eoff; \
        if (!PHASE_A) rq[i] = *(const unsigned*)(QH + o); rk[i] = *(const unsigned*)(KH + o); rv[i] = *(const unsigned*)(VH + o); rl[i] = *(const f32x2*)(LF + o); } } while (0)
    SCAN_LOAD(0);
    for (int c = 0; c < 8; ++c) {
        float c0[8], c1[8]; { float r0 = 0.f, r1 = 0.f;
#pragma unroll
            for (int i = 0; i < 8; ++i) { r0 += rl[i].x; r1 += rl[i].y; c0[i] = r0; c1[i] = r1; }
            *(LAS f32x2*)(TW + w * 128 + 2 * lane) = (f32x2){r0, r1}; }
        __syncthreads();
        float off0 = 0.f, off1 = 0.f, tot0 = 0.f, tot1 = 0.f;
#pragma unroll
        for (int ww = 0; ww < 8; ++ww) { const f32x2 t = *(const LAS f32x2*)(TW + ww * 128 + 2 * lane); if (ww < w) { off0 += t.x; off1 += t.y; } tot0 += t.x; tot1 += t.y; }
        unsigned kt0[4], kt1[4], vt0[4], vt1[4];
#pragma unroll
        for (int i = 0; i < 8; ++i) {
            const float cu0 = off0 + c0[i], cu1 = off1 + c1[i];
            const f16x2 kk = __builtin_bit_cast(f16x2, rk[i]); const float k0 = (float)kk[0], k1 = (float)kk[1];
            const float t0 = k0 * __expf(tot0 - cu0), t1 = k1 * __expf(tot1 - cu1);
            if (!PHASE_A) {
                const f16x2 qq = __builtin_bit_cast(f16x2, rq[i]);
                *(LAS unsigned*)(Qt + (8 * w + i) * QT_STRIDE + 4 * lane) = pkbf((float)qq[0] * __expf(cu0), (float)qq[1] * __expf(cu1));
                *(LAS unsigned*)(Kh + (8 * w + i) * QT_STRIDE + 4 * lane) = pkbf(k0 * __expf(-cu0), k1 * __expf(-cu1));
            }
            if (i & 1) { kt0[i >> 1] |= (pkbf(t0, 0.f) << 16); kt1[i >> 1] |= (pkbf(t1, 0.f) << 16); vt0[i >> 1] |= (rv[i] << 16); vt1[i >> 1] |= (rv[i] & 0xffff0000u); }
            else { kt0[i >> 1] = pkbf(t0, 0.f) & 0xffffu; kt1[i >> 1] = pkbf(t1, 0.f) & 0xffffu; vt0[i >> 1] = rv[i] & 0xffffu; vt1[i >> 1] = rv[i] >> 16; }
        }
        *(LAS u32x4*)(KtT + (2 * lane) * KT_STRIDE + 16 * w) = (u32x4){kt0[0], kt0[1], kt0[2], kt0[3]};
        *(LAS u32x4*)(KtT + (2 * lane + 1) * KT_STRIDE + 16 * w) = (u32x4){kt1[0], kt1[1], kt1[2], kt1[3]};
        *(LAS u32x4*)(VT + (2 * lane) * KT_STRIDE + 16 * w) = (u32x4){vt0[0], vt0[1], vt0[2], vt0[3]};
        *(LAS u32x4*)(VT + (2 * lane + 1) * KT_STRIDE + 16 * w) = (u32x4){vt1[0], vt1[1], vt1[2], vt1[3]};
        if (w == 0) *(LAS f32x2*)(AL + 2 * lane) = (f32x2){__expf(tot0), __expf(tot1)};
        cs0 += tot0; cs1 += tot1;
        if (c + 1 < 8) SCAN_LOAD(c + 1);
        __syncthreads();
        f32x4 Y[4];
        if (!PHASE_A) {
            const int ti = w >> 1;
#pragma unroll
            for (int sx = 0; sx < 2; ++sx) { const int si = 2 * (w & 1) + sx; f32x4 z = {0.f, 0.f, 0.f, 0.f};
                if (si <= ti) {
#pragma unroll
                    for (int kd = 0; kd < 4; ++kd) { const bf16x8 a = *(const LAS bf16x8*)(Kh + (16 * si + fl) * QT_STRIDE + (32 * kd + 8 * g) * 2), bq = *(const LAS bf16x8*)(Qt + (16 * ti + fl) * QT_STRIDE + (32 * kd + 8 * g) * 2);
                        z = MFMA16(a, bq, z); }
                    const int t = 16 * ti + fl, s0 = 16 * si + 4 * g;
#pragma unroll
                    for (int r = 0; r < 4; ++r) z[r] = (s0 + r <= t) ? z[r] : 0.f;
                }
                *(LAS u32x2*)(P + (16 * ti + fl) * KT_STRIDE + (16 * si + 4 * g) * 2) = (u32x2){pkbf(z[0], z[1]), pkbf(z[2], z[3])}; }
#pragma unroll
            for (int jt = 0; jt < 4; ++jt) Y[jt] = (f32x4){0.f, 0.f, 0.f, 0.f};
#pragma unroll
            for (int i = 0; i < 4; ++i) { const u32x4 aw = {pkbf(X[2 * i][0], X[2 * i][1]), pkbf(X[2 * i][2], X[2 * i][3]), pkbf(X[2 * i + 1][0], X[2 * i + 1][1]), pkbf(X[2 * i + 1][2], X[2 * i + 1][3])};
                const bf16x8 af = __builtin_bit_cast(bf16x8, aw);
#pragma unroll
                for (int jt = 0; jt < 4; ++jt) { const u32x2 lo = *(const LAS u32x2*)(Qt + (16 * jt + fl) * QT_STRIDE + (32 * i + 4 * g) * 2), hi = *(const LAS u32x2*)(Qt + (16 * jt + fl) * QT_STRIDE + (32 * i + 16 + 4 * g) * 2);
                    const u32x4 bw = {lo.x, lo.y, hi.x, hi.y}; Y[jt] = MFMA16(af, __builtin_bit_cast(bf16x8, bw), Y[jt]); } }
            __syncthreads();
        }
        bf16x8 vf[2];
#pragma unroll
        for (int ks = 0; ks < 2; ++ks) vf[ks] = *(const LAS bf16x8*)(VT + (16 * w + fl) * KT_STRIDE + (32 * ks + 8 * g) * 2);
        if (!PHASE_A) {
#pragma unroll
            for (int jt = 0; jt < 4; ++jt)
#pragma unroll
                for (int ks = 0; ks < 2; ++ks) if (32 * ks <= 16 * jt + 15) { const bf16x8 pf = *(const LAS bf16x8*)(P + (16 * jt + fl) * KT_STRIDE + (32 * ks + 8 * g) * 2); Y[jt] = MFMA16(vf[ks], pf, Y[jt]); }
#pragma unroll
            for (int jt = 0; jt < 4; ++jt) *(LAS f32x4*)(OB + (16 * jt + fl) * OB_STRIDE + 16 * w + 4 * g) = Y[jt];
        }
#pragma unroll
        for (int i = 0; i < 8; ++i) { X[i] = X[i] * *(const LAS f32x4*)(AL + 16 * i + 4 * g);
#pragma unroll
            for (int ks = 0; ks < 2; ++ks) { const bf16x8 a = *(const LAS bf16x8*)(KtT + (16 * i + fl) * KT_STRIDE + (32 * ks + 8 * g) * 2); X[i] = MFMA16(a, vf[ks], X[i]); } }
        __syncthreads();
        if (!PHASE_A) {
            const int t = tid >> 3, es = (tid & 7) * 16; f32x4 o[4]; float ss = 0.f;
#pragma unroll
            for (int q = 0; q < 4; ++q) { o[q] = *(const LAS f32x4*)(OB + t * OB_STRIDE + es + 4 * q); ss += (o[q][0] * o[q][0] + o[q][1] * o[q][1]) + (o[q][2] * o[q][2] + o[q][3] * o[q][3]); }
            ss += __shfl_xor(ss, 1); ss += __shfl_xor(ss, 2); ss += __shfl_xor(ss, 4);
            const float rstd = rsqrtf(ss * (1.f / 128.f) + EPS);
            const size_t ro = (tok0 + (size_t)c * 64 + t) * DM + (size_t)h * 128 + es;
            const f16x8 g0 = *(const f16x8*)(GH + ro), g1 = *(const f16x8*)(GH + ro + 8);
            pg8::f32x8 r0, r1;
#pragma unroll
            for (int q = 0; q < 2; ++q) { const f32x4 gn = *(const f32x4*)(gnorm + es + 4 * q);
#pragma unroll
                for (int j = 0; j < 4; ++j) r0[4 * q + j] = o[q][j] * rstd * gn[j] * (float)g0[4 * q + j]; }
#pragma unroll
            for (int q = 0; q < 2; ++q) { const f32x4 gn = *(const f32x4*)(gnorm + es + 8 + 4 * q);
#pragma unroll
                for (int j = 0; j < 4; ++j) r1[4 * q + j] = o[2 + q][j] * rstd * gn[j] * (float)g1[4 * q + j]; }
            *(f16x8*)(OG + ro) = __builtin_convertvector(r0, f16x8); *(f16x8*)(OG + ro + 8) = __builtin_convertvector(r1, f16x8);
        }
    }
#undef SCAN_LOAD
    if (PHASE_A) {
#pragma unroll
        for (int i = 0; i < 8; ++i)
#pragma unroll
            for (int r = 0; r < 4; ++r) STu[(16 * i + 4 * g + r) * 128 + 16 * w + fl] = X[i][r];
        if (w == 0) *(f32x2*)(ST + ST_ATOT + (size_t)u * 128 + 2 * lane) = (f32x2){__expf(cs0), __expf(cs1)};
    }
    __syncthreads();
}
__device__ __forceinline__ void scan_carry(float* __restrict__ ST, const int gtid, const int nthreads) {
    for (int i = gtid; i < 32 * 4096; i += nthreads) {
        const int bh = i >> 12, q = i & 4095, d = q >> 5;
        f32x4 s = {0.f, 0.f, 0.f, 0.f};
#pragma unroll
        for (int sc = 0; sc < 8; ++sc) { f32x4* p = (f32x4*)(ST + (size_t)(bh * 8 + sc) * 16384) + q;
            if (sc < 7) { const f32x4 l = *p; const float a = ST[ST_ATOT + (size_t)(bh * 8 + sc) * 128 + d]; *p = s; s = s * a + l; } else *p = s; }
    }
}
#undef MFMA16
}

namespace attn {
constexpr int D = 128;
constexpr float THR = 8.f;
constexpr bool WSKIP = false;
constexpr int OSTRIDE = DM;
constexpr float SCALE = 0.08838834764831845f;
constexpr int NW = 8, QBLK = 32, KVBLK = 64, QB = NW * QBLK;
constexpr int SHM_V = KVBLK * D * 2, SHM_K = KVBLK * D * 2;
constexpr int LDS_BYTES = 2 * SHM_V + 2 * SHM_K + NW * 96 * 4;
using bf16 = _Float16;
typedef short s16x8 __attribute__((ext_vector_type(8)));
typedef _Float16 bf16x8 __attribute__((ext_vector_type(8)));
typedef short s16x4 __attribute__((ext_vector_type(4)));
typedef float f32x16 __attribute__((ext_vector_type(16)));
template <class A, class Bt> struct same_t { static constexpr bool v = false; };
template <class A> struct same_t<A, A> { static constexpr bool v = true; };

#define KSWZ(row, colB) ((row) * 256 + ((colB) ^ (((row) & 7) << 4)))
#define SBAR() __builtin_amdgcn_sched_barrier(0)
__device__ __forceinline__ int v_st(int k, int c) { const int kk = (k & ~0xC) | ((k & 4) << 1) | ((k & 8) >> 1); return ((kk >> 3) * 4 + (c >> 5)) * 512 + ((kk & 7) * 32 + (c & 31)) * 2; }
__device__ __forceinline__ int v_rd_base(int lane) { return ((lane & 3) << 3) | (((lane >> 2) & 3) << 6) | (((lane >> 4) & 1) << 5) | (((lane >> 5) & 1) << 8); }
constexpr int v_rd_off(int d0, int ks, int half) { return d0 * 512 + ks * 4096 + half * 2048; }
__device__ __forceinline__ int crow(int r, int hi) { return (r & 3) + 8 * (r >> 2) + 4 * hi; }
__device__ __forceinline__ unsigned cvtpk(float lo, float hi) {
    unsigned r; asm volatile("v_cvt_pk_f16_f32 %0, %1, %2" : "=v"(r) : "v"(lo), "v"(hi)); return r;
}
__device__ __forceinline__ bf16x8 pack8(f32x4 a, f32x4 b) {
    u32x4 w = {cvtpk(a[0], a[1]), cvtpk(a[2], a[3]), cvtpk(b[0], b[1]), cvtpk(b[2], b[3])};
    return *reinterpret_cast<bf16x8*>(&w);
}
template <class T> __device__ __forceinline__ bf16x8 load8(const T* p) {
    if constexpr (same_t<T, float>::v) { return pack8(*(const f32x4*)p, *(const f32x4*)(p + 4)); }
    else { return *reinterpret_cast<const bf16x8*>(p); }
}
__device__ __forceinline__ void mask_tile(f32x16& p0, f32x16& p1, int dq, unsigned W) {
    const float NEG = -__builtin_inff();
#pragma unroll
    for (int r = 0; r < 16; ++r) {
        const int c = (r & 3) + 8 * (r >> 2);
        if ((unsigned)(dq - c) >= W) p0[r] = NEG;
        if ((unsigned)(dq - c - 32) >= W) p1[r] = NEG;
    }
}
__device__ __forceinline__ void partialSM(f32x16& p0, f32x16& p1, float& m_reg, float& mn, float& alpha) {
    float pmax = p0[0]; for (int r = 1; r < 16; ++r) pmax = fmaxf(pmax, p0[r]); for (int r = 0; r < 16; ++r) pmax = fmaxf(pmax, p1[r]);
    { auto rr = __builtin_amdgcn_permlane32_swap(__float_as_uint(pmax), __float_as_uint(pmax), false, false);
      pmax = fmaxf(__uint_as_float(rr[0]), __uint_as_float(rr[1])); }
    constexpr float C2 = 1.4426950408889634f * SCALE;
    if (__builtin_expect(__all((pmax - m_reg) * SCALE <= THR), 1)) { mn = m_reg; alpha = 1.f; }
    else { mn = fmaxf(m_reg, pmax); alpha = __builtin_amdgcn_exp2f((m_reg - mn) * C2); m_reg = mn; }
    const float mnL = -mn * C2;
    for (int r = 0; r < 16; ++r) p0[r] = fmaf(p0[r], C2, mnL); for (int r = 0; r < 16; ++r) p1[r] = fmaf(p1[r], C2, mnL);
    for (int r = 0; r < 16; ++r) p0[r] = __builtin_amdgcn_exp2f(p0[r]);
}
__device__ __forceinline__ void finishSM(f32x16& p0, f32x16& p1, float alpha, float& l_reg, bf16x8& pa0, bf16x8& pa1, bf16x8& pa2, bf16x8& pa3) {
    for (int r = 0; r < 16; ++r) p1[r] = __builtin_amdgcn_exp2f(p1[r]);
    float ps = 0; for (int r = 0; r < 16; ++r) ps += p0[r]; for (int r = 0; r < 16; ++r) ps += p1[r];
    { auto rr = __builtin_amdgcn_permlane32_swap(__float_as_uint(ps), __float_as_uint(ps), false, false);
      ps = __uint_as_float(rr[0]) + __uint_as_float(rr[1]); }
    l_reg = l_reg * alpha + ps;
#define PK4(P, B_, OUT) do { unsigned a0 = cvtpk(P[B_+0], P[B_+1]), a1 = cvtpk(P[B_+2], P[B_+3]);                          \
        unsigned b0 = cvtpk(P[B_+4], P[B_+5]), b1 = cvtpk(P[B_+6], P[B_+7]);                                             \
        auto r0 = __builtin_amdgcn_permlane32_swap(a0, b0, false, false); auto r1 = __builtin_amdgcn_permlane32_swap(a1, b1, false, false); \
        u32x4 w = {r0[0], r1[0], r0[1], r1[1]}; OUT = *reinterpret_cast<bf16x8*>(&w); } while (0)
    PK4(p0, 0, pa0); PK4(p0, 8, pa1); PK4(p1, 0, pa2); PK4(p1, 8, pa3);
#undef PK4
}
template <int KB, bool SK>
__device__ __forceinline__ void qkt(f32x16& p0, f32x16& p1, const char* K_lds, int r32, int hi, const bf16x8* qr, bool act) {
    if (SK && !act) { const float NEG = -__builtin_inff();
#pragma unroll
        for (int r = 0; r < 16; ++r) { p0[r] = NEG; p1[r] = NEG; } return; }
    p0 = f32x16{}; p1 = f32x16{};
    const char* kb[4];
#pragma unroll
    for (int dd = 0; dd < 4; ++dd) kb[dd] = K_lds + KB * SHM_K + KSWZ(r32, (dd * 16 + hi * 8) * 2);
#pragma unroll
    for (int d0 = 0; d0 < 8; ++d0) { const char* a = kb[d0 & 3] + (d0 >> 2) * 128;
        bf16x8 b0 = *reinterpret_cast<const bf16x8*>(a);
        bf16x8 b1 = *reinterpret_cast<const bf16x8*>(a + 32 * 256);
        p0 = __builtin_amdgcn_mfma_f32_32x32x16_f16(b0, qr[d0], p0, 0, 0, 0);
        p1 = __builtin_amdgcn_mfma_f32_32x32x16_f16(b1, qr[d0], p1, 0, 0, 0); }
}
template <int VB, bool SK>
__device__ __forceinline__ void pv_tile(f32x16* o, int vb0, bf16x8 pa0, bf16x8 pa1, bf16x8 pa2, bf16x8 pa3, bool act) {
    if (SK && !act) return;
#define TRRD(dst, off) asm volatile("ds_read_b64_tr_b16 %0, %1 offset:%2" : "=&v"(dst) : "v"(vb0), "i"(off) : "memory")
#define PV_D0(d0) do { s16x4 l0, l1, l2, l3, h0, h1, h2, h3; constexpr int b_ = VB * SHM_V + v_rd_off(d0, 0, 0);     \
        TRRD(l0, b_); TRRD(h0, b_ + 2048); TRRD(l1, b_ + 4096); TRRD(h1, b_ + 6144); TRRD(l2, b_ + 8192); TRRD(h2, b_ + 10240); TRRD(l3, b_ + 12288); TRRD(h3, b_ + 14336); \
        asm volatile("s_waitcnt lgkmcnt(0)" ::: "memory"); SBAR();                 \
        o[d0] = __builtin_amdgcn_mfma_f32_32x32x16_f16(pa0, __builtin_bit_cast(bf16x8, (s16x8){l0[0], l0[1], l0[2], l0[3], h0[0], h0[1], h0[2], h0[3]}), o[d0], 0, 0, 0);   \
        o[d0] = __builtin_amdgcn_mfma_f32_32x32x16_f16(pa1, __builtin_bit_cast(bf16x8, (s16x8){l1[0], l1[1], l1[2], l1[3], h1[0], h1[1], h1[2], h1[3]}), o[d0], 0, 0, 0);   \
        o[d0] = __builtin_amdgcn_mfma_f32_32x32x16_f16(pa2, __builtin_bit_cast(bf16x8, (s16x8){l2[0], l2[1], l2[2], l2[3], h2[0], h2[1], h2[2], h2[3]}), o[d0], 0, 0, 0);   \
        o[d0] = __builtin_amdgcn_mfma_f32_32x32x16_f16(pa3, __builtin_bit_cast(bf16x8, (s16x8){l3[0], l3[1], l3[2], l3[3], h3[0], h3[1], h3[2], h3[3]}), o[d0], 0, 0, 0); } while (0)
    PV_D0(0); PV_D0(1); PV_D0(2); PV_D0(3);
#undef PV_D0
#undef TRRD
}

template <class TIn, class TOut> struct BlockRef { const TIn* Q; const TIn* K; const TIn* V; TOut* O; int P0; const float* KM; int own; };
template <class TIn> struct Seam {
    bf16x8 qr[8];
    bf16x8 st_v0, st_v1, st_k0, st_k1; f32x4 sf0, sf1, sf2, sf3;
    f32x4 tq[16];
};
__device__ __forceinline__ int swa_jlo(int P0, int W) { const int lowk = P0 - W + 1; return lowk > 0 ? lowk / KVBLK : 0; }
#define ROW(p, k0, rr) ((p) + (size_t)((k0) + (rr)) * D + sc)
#define VMW() asm volatile("s_waitcnt vmcnt(0)" ::: "memory")
#define VMWN(n) asm volatile("s_waitcnt vmcnt(%0)" :: "i"(n) : "memory")
#define SLOAD_H(Kp, Vp, k0) do { S.st_v0 = load8<TIn>(ROW(Vp, k0, sr)); S.st_v1 = load8<TIn>(ROW(Vp, k0, 32 + sr));              \
                         S.st_k0 = load8<TIn>(ROW(Kp, k0, sr)); S.st_k1 = load8<TIn>(ROW(Kp, k0, 32 + sr)); } while (0)
#define SWRITE_HK(bf) do { *(bf16x8*)(K_lds + (bf) * SHM_K + kws) = S.st_k0; *(bf16x8*)(K_lds + (bf) * SHM_K + kws + 32 * 256) = S.st_k1; } while (0)
#define SWRITE_HV(bf) do { *(bf16x8*)(V_lds + (bf) * SHM_V + vst0) = S.st_v0; *(bf16x8*)(V_lds + (bf) * SHM_V + vst1) = S.st_v1; } while (0)
#define SWRITE_H(bf) do { SWRITE_HV(bf); SWRITE_HK(bf); } while (0)
#define SLOAD_F(p, k0) do { S.sf0 = *(const f32x4*)ROW(p, k0, sr); S.sf1 = *(const f32x4*)(ROW(p, k0, sr) + 4);                \
                            S.sf2 = *(const f32x4*)ROW(p, k0, 32 + sr); S.sf3 = *(const f32x4*)(ROW(p, k0, 32 + sr) + 4); } while (0)
#define SWRITE_KF(bf) do { *(bf16x8*)(K_lds + (bf) * SHM_K + kws) = pack8(S.sf0, S.sf1); *(bf16x8*)(K_lds + (bf) * SHM_K + kws + 32 * 256) = pack8(S.sf2, S.sf3); } while (0)
#define SWRITE_VF(bf) do { *(bf16x8*)(V_lds + (bf) * SHM_V + vst0) = pack8(S.sf0, S.sf1); *(bf16x8*)(V_lds + (bf) * SHM_V + vst1) = pack8(S.sf2, S.sf3); } while (0)
template <class TIn, class TOut>
__device__ __forceinline__ void causal_swa_prime(const BlockRef<TIn, TOut>& cur, char* lds, Seam<TIn>& S, const int wid) {
    constexpr bool F32 = same_t<TIn, float>::v;
    const int lane = lane_id_opaque(), tid = wid * 64 + lane, r32 = lane & 31, hi = lane >> 5;
    const int sr = tid >> 4, sc = (tid & 15) * 8, kws = KSWZ(sr, sc * 2); char* K_lds = lds + 2 * SHM_V;
    const int kb0 = 0;
    for (int d0 = 0; d0 < 8; ++d0) S.qr[d0] = load8<TIn>(cur.Q + (size_t)(wid * QBLK + r32) * D + d0 * 16 + hi * 8);
    if constexpr (F32) { SLOAD_F((const float*)cur.K, kb0); VMW(); SWRITE_KF(0); SBAR(); SLOAD_F((const float*)cur.V, kb0); }
    else { SLOAD_H(cur.K, cur.V, kb0); VMW(); SWRITE_HK(0); }
    __syncthreads();
}
template <class TIn, class TOut>
__device__ __forceinline__ void causal_swa_block(const BlockRef<TIn, TOut>& cur, const BlockRef<TIn, TOut>& nxt, int skv, char* lds, Seam<TIn>& S, const int wid) {
    constexpr bool F32 = same_t<TIn, float>::v;
    const int lane = lane_id_opaque(), tid = wid * 64 + lane, r32 = lane & 31, hi = lane >> 5;
    const int j_lo = 0, own = cur.own; constexpr int W = 0x7fffffff;
    int j_hi = (cur.P0 + QB - 1) / KVBLK + 1; if (j_hi > skv / KVBLK) j_hi = skv / KVBLK;
    const int NT = j_hi - j_lo;
    const int kbn = 0;
    const int qlo = cur.P0 + wid * QBLK, qm = qlo + r32 - 4 * hi;
    char* V_lds = lds; char* K_lds = lds + 2 * SHM_V;
    float* ws = (float*)(lds + 2 * SHM_V + 2 * SHM_K) + wid * 96; float* li_l = ws, * al_l = ws + 32; unsigned* sel_l = (unsigned*)(ws + 64);
    float m_reg = -1e30f, l_reg = 0; f32x16 o[4] = {};
    const int sr = tid >> 4, sc = (tid & 15) * 8, vst0 = v_st(sr, sc), vst1 = v_st(32 + sr, sc), kws = KSWZ(sr, sc * 2);
    const int vb0 = (int)(uintptr_t)V_lds + v_rd_base(lane);
    const TIn* Kh = cur.K; const TIn* Vh = cur.V;
#define RESC(a) do { if (__any((a) < 1.f)) { if (hi == 0) al_l[r32] = (a); asm volatile("s_waitcnt lgkmcnt(0)" ::: "memory");              \
                     for (int d_ = 0; d_ < 4; ++d_) for (int r = 0; r < 16; ++r) o[d_][r] *= al_l[crow(r, hi)]; } } while (0)
#define KBASE(t) ((j_lo + (t)) * KVBLK)
#define ACT(t) (KBASE(t) <= qlo + QBLK - 1 && KBASE(t) + KVBLK - 1 >= qlo - W + 1)
#define MASKT(P0_, P1_, t) do { const int kb_ = KBASE(t), jb_ = (t) >> 2; \
        if (jb_ == own) { if (kb_ + KVBLK - 1 > qlo) mask_tile(P0_, P1_, qm - kb_, (unsigned)W); }                          \
        else { const unsigned sw_ = sel_l[r32]; if (!((sw_ >> jb_) & 1u)) { const float NEG_ = -__builtin_inff();            \
            _Pragma("unroll") for (int r_ = 0; r_ < 16; ++r_) { P0_[r_] = NEG_; P1_[r_] = NEG_; } } } } while (0)
    constexpr int NQL = F32 ? 16 : 8;
    constexpr bool SK = WSKIP && !F32;
#define SEAM_K0() do { VMWN(NQL); if constexpr (F32) { SWRITE_KF(0); SBAR(); SLOAD_F((const float*)nxt.V, kbn); } else { SWRITE_HK(0); } SBAR(); } while (0)
    f32x16 pA0, pA1, pB0, pB1; float mnA, mnB, alA, alB; bf16x8 pa0, pa1, pa2, pa3;
    { f32x16 pg = {};
      const int jg = (r32 & 3) + 4 * (r32 >> 3); const bool live = (r32 & 4) == 0;
#pragma unroll
      for (int d0 = 0; d0 < 8; ++d0) { f32x4 a = {0.f, 0.f, 0.f, 0.f}, b2 = a;
          if (live) { a = *(const f32x4*)(cur.KM + jg * 128 + d0 * 16 + hi * 8); b2 = *(const f32x4*)(cur.KM + jg * 128 + d0 * 16 + hi * 8 + 4); }
          pg = __builtin_amdgcn_mfma_f32_32x32x16_f16(pack8(a, b2), S.qr[d0], pg, 0, 0, 0); }
      unsigned sel = 0u;
#pragma unroll
      for (int rep_ = 0; rep_ < 3; ++rep_) { float best = -__builtin_inff(); int bi = -1;
#pragma unroll
          for (int j = 0; j < 16; ++j) { const bool ok = (j < own) && !((sel >> j) & 1u) && (pg[j] > best); best = ok ? pg[j] : best; bi = ok ? j : bi; }
          if (bi >= 0) sel |= 1u << bi; }
      if (hi == 0) sel_l[r32] = sel;
      asm volatile("s_waitcnt lgkmcnt(0)" ::: "memory"); }
    if constexpr (F32) { VMW(); SWRITE_VF(0); SBAR(); } else { SWRITE_HV(0); SBAR(); }
    if (NT > 1) { if constexpr (F32) SLOAD_F((const float*)Kh, KBASE(1)); else SLOAD_H(Kh, Vh, KBASE(1)); }
    SBAR(); qkt<0, SK>(pA0, pA1, K_lds, r32, hi, S.qr, ACT(0));
    if constexpr (F32) { if (NT > 1) { VMW(); SWRITE_KF(1); SBAR(); SLOAD_F((const float*)Vh, KBASE(1)); } }
    MASKT(pA0, pA1, 0); partialSM(pA0, pA1, m_reg, mnA, alA);
    if (NT > 1) { VMW(); if constexpr (F32) { SWRITE_VF(1); SBAR(); if (NT > 2) SLOAD_F((const float*)Kh, KBASE(2)); } else SWRITE_H(1); }
    __syncthreads();
#define HALF_STEP(PX0, PX1, mnX, alX, PY0, PY1, alY, t, KB, VB, SB) do {                                                      \
        SBAR(); qkt<KB, SK>(PX0, PX1, K_lds, r32, hi, S.qr, ACT(t));                                             \
        finishSM(PY0, PY1, alY, l_reg, pa0, pa1, pa2, pa3); SBAR();                                                           \
        if ((t) + 1 < NT) { if constexpr (F32) { VMW(); SWRITE_KF(SB); SBAR(); SLOAD_F((const float*)Vh, KBASE((t) + 1)); }  \
                            else { SLOAD_H(Kh, Vh, KBASE((t) + 1)); } SBAR(); }                                               \
        pv_tile<VB, SK>(o, vb0, pa0, pa1, pa2, pa3, ACT((t) - 1)); MASKT(PX0, PX1, (t)); partialSM(PX0, PX1, m_reg, mnX, alX);                                        \
        __syncthreads();                                                                                                      \
        if ((t) + 1 < NT) { VMW(); if constexpr (F32) { SWRITE_VF(SB); SBAR(); if ((t) + 2 < NT) SLOAD_F((const float*)Kh, KBASE((t) + 2)); } \
                            else { SWRITE_H(SB); } }                                                                          \
        RESC(alX); __syncthreads(); } while (0)
    for (int t = 1; t + 1 < NT; t += 2) {
        HALF_STEP(pB0, pB1, mnB, alB, pA0, pA1, alA, t, 1, 0, 0);
        HALF_STEP(pA0, pA1, mnA, alA, pB0, pB1, alB, t + 1, 0, 1, 1);
    }
    const bool even = (NT & 1) == 0;
    if (even) { SBAR(); qkt<1, SK>(pB0, pB1, K_lds, r32, hi, S.qr, ACT(NT - 1)); SBAR(); }
#define QROW(e) (nxt.Q + (size_t)(wid * QBLK + r32) * D + ((e) >> 1) * 16 + hi * 8 + ((e) & 1) * 4)
    if constexpr (F32) { SLOAD_F((const float*)nxt.K, kbn); SBAR();
#pragma unroll
        for (int e = 0; e < 8; ++e) S.tq[e] = *(const f32x4*)QROW(e); }
    else { SLOAD_H(nxt.K, nxt.V, kbn); SBAR();
#pragma unroll
        for (int d0 = 0; d0 < 8; ++d0) S.qr[d0] = load8<TIn>(nxt.Q + (size_t)(wid * QBLK + r32) * D + d0 * 16 + hi * 8); }
    SBAR();
    finishSM(pA0, pA1, alA, l_reg, pa0, pa1, pa2, pa3); SBAR();
    if constexpr (F32) {
#pragma unroll
        for (int e = 8; e < 16; ++e) S.tq[e] = *(const f32x4*)QROW(e); SBAR(); }
#undef QROW
    pv_tile<0, SK>(o, vb0, pa0, pa1, pa2, pa3, ACT(even ? NT - 2 : NT - 1));
    if (even) { MASKT(pB0, pB1, NT - 1); partialSM(pB0, pB1, m_reg, mnB, alB); __syncthreads(); RESC(alB);
        finishSM(pB0, pB1, alB, l_reg, pa0, pa1, pa2, pa3); SBAR(); pv_tile<1, SK>(o, vb0, pa0, pa1, pa2, pa3, ACT(NT - 1)); }
    SBAR(); SEAM_K0();
    if (hi == 0) li_l[r32] = l_reg; asm volatile("s_waitcnt lgkmcnt(0)" ::: "memory");
    float rli[16];
#pragma unroll
    for (int r = 0; r < 16; ++r) rli[r] = __builtin_amdgcn_rcpf(li_l[crow(r, hi)]);
    TOut* Ow = cur.O + (size_t)(wid * QBLK) * OSTRIDE;
#pragma unroll
    for (int r = 0; r < 16; ++r) { const int orow = crow(r, hi);
#pragma unroll
        for (int d0 = 0; d0 < 4; ++d0) { const float v = o[d0][r] * rli[r];
            if constexpr (same_t<TOut, float>::v) { Ow[(size_t)orow * OSTRIDE + d0 * 32 + r32] = v; }
            else { const float vn = __shfl_xor(v, 1);
                   if ((r32 & 1) == 0) *(unsigned*)(Ow + (size_t)orow * OSTRIDE + d0 * 32 + r32) = cvtpk(v, vn); } } }
    if constexpr (F32) {
#pragma unroll
        for (int d0 = 0; d0 < 8; ++d0) S.qr[d0] = pack8(S.tq[2 * d0], S.tq[2 * d0 + 1]); }
    __syncthreads();
#undef RESC
#undef KBASE
#undef ACT
#undef MASKT
#undef SEAM_K0
#undef HALF_STEP
}
#undef ROW
#undef VMW
#undef VMWN
#undef SLOAD_H
#undef SWRITE_HK
#undef SWRITE_HV
#undef SWRITE_H
#undef SLOAD_F
#undef SWRITE_KF
#undef SWRITE_VF
__device__ __forceinline__ BlockRef<f16, f16> moba_ref(const int L, const int pass, const f16* Q, const f16* K, const f16* V, const float* KM, f16* O) {
    const int grp = L >> 5, hq = (L >> 3) & 3, y = L & 7, b = grp >> 2, kvh = grp & 3, h = kvh * 4 + hq, qb = pass ? 15 - y : y;
    BlockRef<f16, f16> r;
    r.Q = Q + ((size_t)(b * NH + h) * SEQ + (size_t)qb * QB) * D; r.K = K + (size_t)(b * NKV + kvh) * SEQ * D; r.V = V + (size_t)(b * NKV + kvh) * SEQ * D;
    r.O = O + ((size_t)b * SEQ + (size_t)qb * QB) * OSTRIDE + h * D; r.P0 = qb * QB; r.KM = KM + (size_t)(b * NKV + kvh) * NBLK * D; r.own = qb;
    return r;
}
__device__ __forceinline__ void moba_phase(char* lds, const int wid, const int vcu, const int G, const f16* Q, const f16* K, const f16* V, const float* KM, f16* O) {
    constexpr int total = BATCH * NH * (NBLK / 2);
    int L = vcu; if (L >= total) return;
    int pass = 0;
    BlockRef<f16, f16> cur = moba_ref(L, 0, Q, K, V, KM, O);
    Seam<f16> S;
    causal_swa_prime<f16, f16>(cur, lds, S, wid);
    for (;;) {
        const bool more_pass = pass == 0, more_item = L + G < total, last = !more_pass && !more_item;
        int passn = pass + 1, Ln = L;
        if (!more_pass) { passn = 0; Ln = more_item ? L + G : L; }
        const BlockRef<f16, f16> nxt = last ? cur : moba_ref(Ln, passn, Q, K, V, KM, O);
        causal_swa_block<f16, f16>(cur, nxt, SEQ, lds, S, wid);
        if (last) break;
        cur = nxt; pass = passn; L = Ln;
    }
}
}

constexpr int NWAVES = 8;
constexpr int RING_BYTES = 131072, LDSCTL_OFF = RING_BYTES, MISC_OFF = LDSCTL_OFF + 320, LDS_BYTES = 147456;
constexpr size_t W16_GU = 0, W16_GU_SZ = (size_t)2 * FF * DM, W16_DN = 4 * W16_GU_SZ, W16_DN_SZ = (size_t)DM * FF, W16_IN = W16_DN + 4 * W16_DN_SZ, W16_OUT = W16_IN + (size_t)4 * DM * DM,
                 W16_KV = W16_OUT + (size_t)DM * DM, W16_Q = W16_KV + (size_t)1024 * DM, W16_O = W16_Q + (size_t)DM * DM, W16_END = W16_O + (size_t)DM * DM;
static_assert(WS_W16 + W16_END * 2 <= WS_END, "fp16 weights fit");
enum { PC_PRO = 0, PC_NORM0 = 1, PC_S0_FA = 2, PC_S0_FB = 3, PC_S0_NF = 4, PC_HG = 5, PC_SA = 6, PC_SB = 7, PC_SC = 8, PC_HO = 9, PC_NM0 = 10, PC_S1_FA = 11, PC_S1_FB = 12, PC_S1_NF = 13,
       PC_KV = 14, PC_S2_FA = 15, PC_S2_FB = 16, PC_S2_NF = 17, PC_QP = 18, PC_AT = 19, PC_OP = 20, PC_NM1 = 21, PC_S3_FA = 22, PC_S3_FB = 23, PC_S3_NF = 24, PC_END = 25 };

struct MegaArgs { const float* in[16]; float* out; unsigned char* ws; int lo, hi; };

enum { MAP_NAT = 0, MAP_SWIGLU = 1, MAP_ROT = 2 };
__device__ __forceinline__ int map_col(int kind, int nrot_rows, int n) {
    if (kind == MAP_SWIGLU) return ((n >> 7) & 1) * FF + (n >> 8) * 128 + (n & 127);
    if (kind == MAP_ROT && n < nrot_rows) return (2 * (n >> 8) + ((n >> 6) & 1)) * 128 + ((n >> 7) & 1) * 64 + (n & 63);
    return n;
}
constexpr int PTAB_OFF = LDSCTL_OFF + 1024;
__device__ __forceinline__ unsigned long long ldptr(LAS unsigned char* lds, int i) {
    const volatile LAS unsigned* t = (const volatile LAS unsigned*)(lds + PTAB_OFF) + 2 * i;
    const unsigned a = __builtin_amdgcn_readfirstlane(t[0]), b = __builtin_amdgcn_readfirstlane(t[1]);
    return ((unsigned long long)b << 32) | a;
}
struct ConvItem { const float* src; f16* dst; int N, K; };
__device__ __forceinline__ ConvItem conv_decode(const float* W, int K, int N, f16* WT, int kind, int nrot_rows, int item, int lane) {
    const int nblk = N >> 5, kb = item / nblk, nb = item - kb * nblk, k0 = kb * 64, n0 = nb * 32, ns0 = map_col(kind, nrot_rows, n0);
    const int r = lane >> 3, q = lane & 7;
    ConvItem c; c.src = W + (size_t)(k0 + 8 * r) * N + ns0 + 4 * q; c.dst = WT + (size_t)(n0 + 4 * q) * K + k0 + 8 * r; c.N = N; c.K = K; return c;
}
__device__ __forceinline__ void conv_load(const ConvItem& c, f32x4 (&v)[8]) {
#pragma unroll
    for (int i = 0; i < 8; ++i) v[i] = __builtin_nontemporal_load((const f32x4*)(c.src + (size_t)i * c.N));
}
__device__ __forceinline__ void conv_store(const ConvItem& c, const f32x4 (&v)[8]) {
#pragma unroll
    for (int nn = 0; nn < 4; ++nn) { const pg8::f32x8 o = {v[0][nn], v[1][nn], v[2][nn], v[3][nn], v[4][nn], v[5][nn], v[6][nn], v[7][nn]};
        *(pg8::h16x8*)(c.dst + (size_t)nn * c.K) = __builtin_convertvector(o, pg8::h16x8); }
}
constexpr int CI_GU = (DM / 64) * (2 * FF / 32), CI_DN = (FF / 64) * (DM / 32), CI_IN = (DM / 64) * (4 * DM / 32), CI_SQ = (DM / 64) * (DM / 32), CI_KV = (DM / 64) * (1024 / 32);
constexpr int CONV_NITEMS = 4 * CI_GU + 4 * CI_DN + CI_IN + CI_SQ + CI_KV + CI_SQ + CI_SQ;
constexpr int CR_GU0 = 0, CR_DN0 = 4 * CI_GU, CR_IN = CR_DN0 + 4 * CI_DN, CR_OUT = CR_IN + CI_IN, CR_KV = CR_OUT + CI_SQ, CR_Q = CR_KV + CI_KV, CR_O = CR_Q + CI_SQ;
static_assert(CR_O + CI_SQ == CONV_NITEMS, "conversion item ranges");
#define W16P_(wsb, off) ((f16*)((wsb) + WS_W16) + (off))
__device__ __forceinline__ ConvItem conv_item_of(LAS unsigned char* lds, unsigned char* ws, int it, int lane) {
    int r = it;
    if (r < 4 * CI_GU) { const int s = r / CI_GU; return conv_decode((const float*)ldptr(lds, 6) + (size_t)s * DM * 2 * FF, DM, 2 * FF, W16P_(ws, W16_GU + s * W16_GU_SZ), MAP_SWIGLU, 0, r - s * CI_GU, lane); } r -= 4 * CI_GU;
    if (r < 4 * CI_DN) { const int s = r / CI_DN; return conv_decode((const float*)ldptr(lds, 7) + (size_t)s * FF * DM, FF, DM, W16P_(ws, W16_DN + s * W16_DN_SZ), MAP_NAT, 0, r - s * CI_DN, lane); } r -= 4 * CI_DN;
    if (r < CI_IN) return conv_decode((const float*)ldptr(lds, 8), DM, 4 * DM, W16P_(ws, W16_IN), MAP_NAT, 0, r, lane); r -= CI_IN;
    if (r < CI_SQ) return conv_decode((const float*)ldptr(lds, 11), DM, DM, W16P_(ws, W16_OUT), MAP_NAT, 0, r, lane); r -= CI_SQ;
    if (r < CI_KV) return conv_decode((const float*)ldptr(lds, 13), DM, 1024, W16P_(ws, W16_KV), MAP_ROT, 512, r, lane); r -= CI_KV;
    if (r < CI_SQ) return conv_decode((const float*)ldptr(lds, 14), DM, DM, W16P_(ws, W16_Q), MAP_ROT, DM, r, lane); r -= CI_SQ;
    return conv_decode((const float*)ldptr(lds, 15), DM, DM, W16P_(ws, W16_O), MAP_NAT, 0, r, lane);
}
__device__ __forceinline__ void conv_range(LAS unsigned char* lds, unsigned char* ws, int it0, int it1, int gw, int nw, int lane) {
    for (int it = it0 + gw; it < it1; it += 2 * nw) {
        const ConvItem a = conv_item_of(lds, ws, it, lane); f32x4 va[8], vb[8]; conv_load(a, va);
        const bool two = it + nw < it1;
        if (two) { const ConvItem b = conv_item_of(lds, ws, it + nw, lane); conv_load(b, vb); conv_store(a, va); conv_store(b, vb); }
        else conv_store(a, va);
    }
}

#define WSP(T, off) ((T)(ws + (off)))
#define PHASE_LANE() const int lane = lane_id_opaque(); const int tid = wave * 64 + lane; (void)tid
#define LDP(T, i) ((T)ldptr(lds, (i)))
#define PH_BEGIN if (pc >= lo && pc < hi) { unsigned char* const ws = LDP(unsigned char*, 17); PHASE_LANE();
#define PH_END if (pc + 1 < hi) xcd_barrier(bar, wave); } ++pc;
#define GEMM_CALL(EpiT, Aptr, Btptr, Nn, Kk, Eobj) do { pg8::Gemm g_{(const pg8::bf16_t*)(Aptr), (const pg8::bf16_t*)(Btptr), M, (Nn), (Kk)}; pg8::StaticOrder S_; S_.init(M, (Nn), G, bx); \
        pg8::gemm_phase<EpiT, pg8::StaticOrder, true, true>(lds, g_, S_, (Eobj), wave); } while (0)
#define W16P(off) (WSP(f16*, WS_W16) + (off))
#define SIDE_CONV(i0, i1) do { if (G == 256 && bx >= 128) conv_range(lds, ws, (i0), (i1), (bx - 128) * NWAVES + wave, 128 * NWAVES, lane); } while (0)


template <int s>
__device__ __forceinline__ void sub_body(LAS unsigned char* lds, const int G, const int bx, const int vcu, const int wave, const int lo, const int hi, const XcdBarrier bar, int& pc) {
    constexpr int l = s >> 1, half = s & 1;

        if (half == 1) {
            if (l == 0) {
                PH_BEGIN { pg8::EpiHgrn E{WSP(f16*, WS_QH), WSP(f16*, WS_KH), WSP(u16*, WS_VH), WSP(f16*, WS_GH), WSP(float*, WS_LF), WSP(const float*, WS_LBT)}; GEMM_CALL(pg8::EpiHgrn, WSP(f16*, WS_H), W16P(W16_IN), 4 * DM, DM, E); } PH_END
                PH_BEGIN { for (int u = vcu; u < 256; u += G) if ((u & 7) != 7) scan::scan_unit<true>(lds, u, wave, lane, WSP(const f16*, WS_QH), WSP(const f16*, WS_KH), WSP(const u16*, WS_VH), WSP(const f16*, WS_GH), WSP(const float*, WS_LF), LDP(const float*, 10), WSP(float*, WS_ST), WSP(f16*, WS_OG)); } PH_END
                PH_BEGIN { scan::scan_carry(WSP(float*, WS_ST), vcu * 512 + tid, G * 512); } PH_END
                PH_BEGIN { for (int u = vcu; u < 256; u += G) scan::scan_unit<false>(lds, u, wave, lane, WSP(const f16*, WS_QH), WSP(const f16*, WS_KH), WSP(const u16*, WS_VH), WSP(const f16*, WS_GH), WSP(const float*, WS_LF), LDP(const float*, 10), WSP(float*, WS_ST), WSP(f16*, WS_OG)); } PH_END
                PH_BEGIN { pg8::EpiF32 E{WSP(float*, WS_Y), DM}; GEMM_CALL(pg8::EpiF32, WSP(f16*, WS_OG), W16P(W16_OUT), DM, DM, E); } PH_END
            } else {
                PH_BEGIN { pg8::EpiRot E{WSP(f16*, WS_Q), NH, WSP(const float*, WS_ROPE), nullptr, nullptr, DM / 256}; GEMM_CALL(pg8::EpiRot, WSP(f16*, WS_H), W16P(W16_Q), DM, DM, E); } PH_END
                PH_BEGIN { attn::moba_phase((char*)lds, wave, vcu, G, WSP(const f16*, WS_Q), WSP(const f16*, WS_K), WSP(const f16*, WS_V), WSP(const float*, WS_KMEAN), WSP(f16*, WS_O)); } PH_END
                PH_BEGIN { pg8::EpiF32 E{WSP(float*, WS_Y), DM}; GEMM_CALL(pg8::EpiF32, WSP(f16*, WS_O), W16P(W16_O), DM, DM, E); } PH_END
            }
            PH_BEGIN
            {
                float* mods = WSP(float*, WS_MODS); float* out = LDP(float*, 16); const float* norm_pre = LDP(const float*, 4); const float* norm_post = LDP(const float*, 5);
                NormArgs a{}; a.x_in = out; a.y = WSP(const float*, WS_Y); a.x_out = out; a.h = WSP(f16*, WS_H); a.gate = mods + (size_t)(l * 2) * MODW + 1 * 3 * DM + 2 * DM; a.post = norm_post + (l * 3 + 1) * DM;
                a.pre = norm_pre + (l * 3 + 2) * DM; a.shift = mods + (size_t)(l * 2) * MODW + 2 * 3 * DM; a.scale = a.shift + DM; a.w = 1.0f; a.has_y = 1; a.has_h = 1;
                if (M % G == 0 && (M / G) % 16 == 0 && SEQ % (M / G) == 0) norm_rows_lds(a, lds, vcu, G, wave, lane); else norm_rows(a, vcu * NWAVES + wave, G * NWAVES, lane);
            }
            PH_END
        }
        if (s == 2) {
            PH_BEGIN { pg8::EpiRot E{WSP(f16*, WS_K), NKV, WSP(const float*, WS_ROPE), WSP(float*, WS_KMEAN), WSP(f16*, WS_V), 2}; GEMM_CALL(pg8::EpiRot, WSP(f16*, WS_HKV), W16P(W16_KV), 1024, DM, E);
                SIDE_CONV(CR_DN0 + 2 * CI_DN, CR_DN0 + 3 * CI_DN); SIDE_CONV(CR_Q, CONV_NITEMS); } PH_END
        }
        PH_BEGIN { pg8::EpiSwiGLU E{WSP(f16*, WS_ACT)}; GEMM_CALL(pg8::EpiSwiGLU, WSP(f16*, WS_H), W16P(W16_GU + s * W16_GU_SZ), 2 * FF, DM, E);
            if (s == 0) { SIDE_CONV(CR_DN0, CR_DN0 + CI_DN); SIDE_CONV(CR_IN, CR_KV); }
            if (s == 1) { SIDE_CONV(CR_DN0 + CI_DN, CR_DN0 + 2 * CI_DN); SIDE_CONV(CR_KV, CR_Q); SIDE_CONV(CR_GU0 + 2 * CI_GU, CR_GU0 + 3 * CI_GU); }
            if (s == 2) { SIDE_CONV(CR_GU0 + 3 * CI_GU, CR_GU0 + 4 * CI_GU); SIDE_CONV(CR_DN0 + 3 * CI_DN, CR_DN0 + 4 * CI_DN); }
        } PH_END
        PH_BEGIN { pg8::EpiF32 E{WSP(float*, WS_Y), DM}; GEMM_CALL(pg8::EpiF32, WSP(f16*, WS_ACT), W16P(W16_DN + s * W16_DN_SZ), DM, FF, E); } PH_END
        PH_BEGIN
        {
            float* mods = WSP(float*, WS_MODS); float* out = LDP(float*, 16); const float* norm_pre = LDP(const float*, 4); const float* norm_post = LDP(const float*, 5);
            NormArgs a{}; a.x_in = (s == 0) ? LDP(const float*, 0) : out; a.y = WSP(const float*, WS_Y); a.x_out = out; a.h = WSP(f16*, WS_H); a.h2 = WSP(f16*, WS_HKV); a.kvn = LDP(const float*, 12);
            a.gate = mods + (size_t)(l * 2) * MODW + (half * 2) * 3 * DM + 2 * DM; a.post = norm_post + (l * 3 + half * 2) * DM; a.w = 0.5f; a.has_y = 1;
            if (half == 0) { a.pre = norm_pre + (l * 3 + 1) * DM; a.shift = mods + (size_t)(l * 2) * MODW + 1 * 3 * DM; a.scale = a.shift + DM; a.has_h = 1; }
            else if (l == 0) { a.pre = norm_pre + 3 * DM; a.shift = mods + (size_t)2 * MODW; a.scale = a.shift + DM; a.has_h = 1; a.has_kv = 1; }
            else { a.pre = norm_pre; a.shift = mods; a.scale = mods; }
            if (M % G == 0 && (M / G) % 16 == 0 && SEQ % (M / G) == 0) norm_rows_lds(a, lds, vcu, G, wave, lane); else norm_rows(a, vcu * NWAVES + wave, G * NWAVES, lane);
        }
        PH_END
    }

__global__ void __launch_bounds__(NWAVES * 64, 2) mega(MegaArgs args) {
    extern __shared__ __attribute__((aligned(16))) unsigned char lds_raw[];
    LAS unsigned char* lds = (LAS unsigned char*)lds_raw;
    volatile LAS unsigned* MISC = (volatile LAS unsigned*)(lds + MISC_OFF);
    const int wave = __builtin_amdgcn_readfirstlane(threadIdx.x >> 6);
    const int G = gridDim.x, bx = blockIdx.x, vcu = (G % 8 == 0) ? (bx % 8) * (G / 8) + bx / 8 : bx;
    const int lo = args.lo, hi = args.hi;
    { const int tid = threadIdx.x;
    if (tid < 18) ((LAS unsigned long long*)(lds + PTAB_OFF))[tid] = (tid < 16) ? (unsigned long long)args.in[tid] : (tid == 16 ? (unsigned long long)args.out : (unsigned long long)args.ws);
    for (int u = tid; u < 64; u += NWAVES * 64) ((LAS unsigned*)(lds + LDSCTL_OFF))[u + 80] = 0u; }
    __syncthreads();
    XcdBarrier bar; bar.bar = (unsigned*)(args.ws + WS_CTL) + 4096; bar.x = 0; bar.st = nullptr;
    if (hi - lo > 1) bar = xcd_barrier_post((unsigned*)(args.ws + WS_CTL) + 4096, MISC + 8);

    int pc = 0;
    PH_BEGIN
    {
        const float* cvec = LDP(const float*, 1); const float* ada_w = LDP(const float*, 2); const float* ada_b = LDP(const float*, 3);
        float* mods = WSP(float*, WS_MODS); float* rope = WSP(float*, WS_ROPE); float* kmean = WSP(float*, WS_KMEAN);
        LAS float* sc = (LAS float*)lds; LAS float* red = (LAS float*)(lds + 16384);
        for (int i = tid; i < 2 * DM; i += 512) sc[i] = silu_f(cvec[i]);
        __syncthreads();
        constexpr int nchunk = MODW / 64;
        for (int u = vcu; u < 2 * nchunk; u += G) {
            const int l = u / nchunk, c0 = (u % nchunk) * 64;
            const float* W = ada_w + (size_t)l * DM * MODW + c0 + lane;
            float a0 = 0.f, a1 = 0.f; const int k0 = wave * 256;
#pragma unroll 16
            for (int k = 0; k < 256; ++k) { const float wv = W[(size_t)(k0 + k) * MODW]; a0 += sc[k0 + k] * wv; a1 += sc[DM + k0 + k] * wv; }
            red[(wave * 2 + 0) * 64 + lane] = a0; red[(wave * 2 + 1) * 64 + lane] = a1;
            __syncthreads();
            if (tid < 128) { const int b = tid >> 6; float s = 0.f;
#pragma unroll
                for (int ww = 0; ww < 8; ++ww) s += red[(ww * 2 + b) * 64 + lane];
                mods[(size_t)(l * 2 + b) * MODW + c0 + lane] = s + ada_b[(size_t)l * MODW + c0 + lane]; }
            __syncthreads();
        }
        for (int i = vcu * 512 + tid; i < SEQ * 64; i += G * 512) { const int t = i >> 6, d = i & 63; const float inv = powf(10000.0f, -(float)d / 64.0f); const float ang = (float)t * inv; float s, c; sincosf(ang, &s, &c); rope[i] = c; rope[SEQ * 64 + i] = s; }
        for (int i = vcu * 512 + tid; i < BATCH * NKV * NBLK * 128; i += G * 512) kmean[i] = 0.f;
        { const float* hl = LDP(const float*, 9); float* lbt = WSP(float*, WS_LBT); for (int i = vcu * 512 + tid; i < DM; i += G * 512) lbt[i] = 1.f / (1.f + expf(hl[DM + i] - hl[i])); }
        if (G == 256) conv_range(lds, ws, CR_GU0, CR_GU0 + 2 * CI_GU, vcu * NWAVES + wave, G * NWAVES, lane);
        else conv_range(lds, ws, 0, CONV_NITEMS, vcu * NWAVES + wave, G * NWAVES, lane);
    }
    PH_END
    PH_BEGIN
    {
        float* mods = WSP(float*, WS_MODS);
        NormArgs a{}; a.x_in = LDP(const float*, 0); a.h = WSP(f16*, WS_H); a.pre = LDP(const float*, 4); a.shift = mods; a.scale = mods + DM; a.has_h = 1;
        if (M % G == 0 && (M / G) % 16 == 0 && SEQ % (M / G) == 0) norm_rows_lds(a, lds, vcu, G, wave, lane); else norm_rows(a, vcu * NWAVES + wave, G * NWAVES, lane);
    }
    PH_END
    sub_body<0>(lds, G, bx, vcu, wave, lo, hi, bar, pc);
    sub_body<1>(lds, G, bx, vcu, wave, lo, hi, bar, pc);
    sub_body<2>(lds, G, bx, vcu, wave, lo, hi, bar, pc);
    sub_body<3>(lds, G, bx, vcu, wave, lo, hi, bar, pc);
}

#define FAST_SCAN 1
#define FAST_ATTN 1
#ifndef N_LAUNCH_MODE
#define N_LAUNCH_MODE 1
#endif
extern "C" void kernel_launch(void* const* d_in, const int* in_sizes, int n_in, void* d_out, int out_size, void* d_ws, size_t ws_size, hipStream_t stream) {
    static int grid = 0;
    if (grid == 0) {
        if (n_in != 16 || out_size != M * DM || ws_size < WS_END) { fprintf(stderr, "kernel_launch: unexpected shapes (n_in %d out %d ws %zu)\n", n_in, out_size, ws_size); grid = -1; return; }
        int dev = 0, cus = 0, per_cu = 0;
        if (hipGetDevice(&dev) != hipSuccess || hipDeviceGetAttribute(&cus, hipDeviceAttributeMultiprocessorCount, dev) != hipSuccess) { grid = -1; return; }
        if (hipFuncSetAttribute((const void*)mega, hipFuncAttributeMaxDynamicSharedMemorySize, LDS_BYTES) != hipSuccess) { fprintf(stderr, "kernel_launch: hipFuncSetAttribute failed\n"); grid = -1; return; }
        if (hipOccupancyMaxActiveBlocksPerMultiprocessor(&per_cu, (const void*)mega, NWAVES * 64, LDS_BYTES) != hipSuccess || per_cu < 1) fprintf(stderr, "kernel_launch: occupancy query says %d\n", per_cu);
        (void)hipGetLastError();
        grid = cus;
    }
    if (grid < 0) return;
    unsigned char* ws = (unsigned char*)d_ws;
    (void)hipMemsetAsync(ws + WS_CTL, 0, 1 * MiB, stream);
    MegaArgs a{};
    for (int i = 0; i < 16; ++i) a.in[i] = (const float*)d_in[i];
    a.out = (float*)d_out; a.ws = ws;
#if N_LAUNCH_MODE == 1
    a.lo = 0; a.hi = PC_END;
    hipLaunchKernelGGL(mega, dim3(grid), dim3(NWAVES * 64), LDS_BYTES, stream, a);
#else
    f16* Kb = (f16*)(ws + WS_K); f16* Vb = (f16*)(ws + WS_V); float* kmean = (float*)(ws + WS_KMEAN);
    f16* QH = (f16*)(ws + WS_QH); f16* KH = (f16*)(ws + WS_KH); u16* VH = (u16*)(ws + WS_VH); f16* GH = (f16*)(ws + WS_GH); float* LF = (float*)(ws + WS_LF); f16* OG = (f16*)(ws + WS_OG);
    f16* Qb = (f16*)(ws + WS_Q); f16* Ob = (f16*)(ws + WS_O);
    for (int pc = 0; pc < PC_END; ++pc) {
#ifndef FAST_SCAN
        if (pc == PC_SA) { hipLaunchKernelGGL(k_naive_scan, dim3(BATCH * NH), dim3(128), 0, stream, QH, KH, VH, GH, LF, (const float*)d_in[10], OG); continue; }
        if (pc == PC_SB || pc == PC_SC) continue;
#endif
#ifndef FAST_ATTN
        if (pc == PC_AT) { hipLaunchKernelGGL(k_naive_attn, dim3(BATCH * NH * SEQ / 4), dim3(256), 0, stream, Qb, Kb, Vb, kmean, Ob); continue; }
#endif
        a.lo = pc; a.hi = pc + 1;
        int nrep = 1;
#ifdef PROBE_DUP
        { const int dup[][2] = PROBE_DUP; for (unsigned q = 0; q < sizeof(dup) / sizeof(dup[0]); ++q) if (dup[q][0] == pc) nrep += dup[q][1]; }
#endif
        for (int r = 0; r < nrep; ++r) hipLaunchKernelGGL(mega, dim3(grid), dim3(NWAVES * 64), LDS_BYTES, stream, a);
    }
#endif
}
```

```cpp
#include <hip/hip_runtime.h>
#include <cstdio>
#include <cstdint>

#define LAS __attribute__((address_space(3)))
typedef _Float16 f16;
typedef unsigned short u16;
typedef float f32x4 __attribute__((ext_vector_type(4)));
typedef float f32x2 __attribute__((ext_vector_type(2)));
typedef _Float16 f16x2 __attribute__((ext_vector_type(2)));
typedef _Float16 f16x4 __attribute__((ext_vector_type(4)));
typedef _Float16 f16x8 __attribute__((ext_vector_type(8)));
typedef unsigned u32x4 __attribute__((ext_vector_type(4)));

constexpr int DM = 2048, BATCH = 2, SEQ = 4096, M = BATCH * SEQ, FF = 5632, MODW = 9 * DM;
constexpr int HD = 128, NH = 16, NKV = 4, MBLK = 256, NBLK = SEQ / MBLK;
constexpr float EPS = 1e-6f;
constexpr float ATT_SCALE = 0.08838834764831845f;

constexpr size_t MiB = 1u << 20;
constexpr size_t WS_CTL = 0;
constexpr size_t WS_MODS = 1 * MiB;
constexpr size_t WS_LBT = 1 * MiB + 512 * 1024;
constexpr size_t WS_ROPE = 2 * MiB;
constexpr size_t WS_KMEAN = 4 * MiB;
constexpr size_t WS_H = 8 * MiB;
constexpr size_t WS_HKV = 40 * MiB;
constexpr size_t WS_Y = 72 * MiB;
constexpr size_t WS_K = 136 * MiB;
constexpr size_t WS_V = 144 * MiB;
constexpr size_t WS_ST = 152 * MiB;
constexpr size_t WS_RA = 176 * MiB;
constexpr size_t WS_QH = WS_RA, WS_KH = WS_RA + 32 * MiB, WS_VH = WS_RA + 64 * MiB, WS_GH = WS_RA + 96 * MiB, WS_LF = WS_RA + 128 * MiB, WS_OG = WS_RA + 192 * MiB;
constexpr size_t WS_ACT = WS_RA;
constexpr size_t WS_Q = WS_RA, WS_O = WS_RA + 32 * MiB;
constexpr size_t WS_X16 = 400 * MiB;
constexpr size_t WS_C = 400 * MiB;
constexpr size_t WS_W16 = 752 * MiB;
constexpr size_t WS_END = 1100 * MiB;

__device__ __forceinline__ float silu_f(float x) { return x / (1.f + __expf(-x)); }
__device__ __forceinline__ float wave_sum(float v) {
#pragma unroll
    for (int o = 1; o < 64; o <<= 1) v += __shfl_xor(v, o);
    return v;
}

__device__ __forceinline__ u16 f2bf(float f) { unsigned u = __builtin_bit_cast(unsigned, f); return (u16)((u + 0x7fffu + ((u >> 16) & 1u)) >> 16); }
__device__ __forceinline__ float bf2f(u16 b) { return __builtin_bit_cast(float, (unsigned)b << 16); }
__device__ __forceinline__ int lane_id_opaque() { int l; asm volatile("v_mbcnt_lo_u32_b32 %0, -1, 0\n\tv_mbcnt_hi_u32_b32 %0, -1, %0" : "=v"(l)); return l; }
#ifndef OPBF16
#define OPBF16 1
#endif
typedef unsigned u32x2_t __attribute__((ext_vector_type(2)));
__device__ __forceinline__ unsigned op_pk2(float lo, float hi) {
#if OPBF16
    unsigned r; asm volatile("v_cvt_pk_bf16_f32 %0, %1, %2" : "=v"(r) : "v"(lo), "v"(hi)); return r;
#else
    const f32x2 v = {lo, hi}; return __builtin_bit_cast(unsigned, __builtin_convertvector(v, f16x2));
#endif
}
__device__ __forceinline__ u32x4 op_pk8(f32x4 a, f32x4 b) { return (u32x4){op_pk2(a[0], a[1]), op_pk2(a[2], a[3]), op_pk2(b[0], b[1]), op_pk2(b[2], b[3])}; }
__device__ __forceinline__ u32x2_t op_pk4(f32x4 a) { return (u32x2_t){op_pk2(a[0], a[1]), op_pk2(a[2], a[3])}; }

__global__ __launch_bounds__(512) void k_mods(const float* __restrict__ c, const float* __restrict__ ada_w, const float* __restrict__ ada_b, float* __restrict__ mods) {
    __shared__ float sc[2][DM];
    __shared__ float red[8][2][64];
    const int tid = threadIdx.x, lane = tid & 63, w = tid >> 6;
    for (int i = tid; i < 2 * DM; i += 512) sc[i / DM][i % DM] = silu_f(c[i]);
    __syncthreads();
    const int nchunk = MODW / 64;
    for (int u = blockIdx.x; u < 2 * nchunk; u += gridDim.x) {
        const int l = u / nchunk, c0 = (u % nchunk) * 64;
        const float* W = ada_w + (size_t)l * DM * MODW + c0 + lane;
        float a0 = 0.f, a1 = 0.f;
        const int k0 = w * 256;
#pragma unroll 8
        for (int k = 0; k < 256; ++k) { const float wv = W[(size_t)(k0 + k) * MODW]; a0 += sc[0][k0 + k] * wv; a1 += sc[1][k0 + k] * wv; }
        red[w][0][lane] = a0; red[w][1][lane] = a1;
        __syncthreads();
        if (tid < 128) { const int b = tid >> 6; float s = 0.f;
#pragma unroll
            for (int ww = 0; ww < 8; ++ww) s += red[ww][b][lane];
            mods[(size_t)(l * 2 + b) * MODW + c0 + lane] = s + ada_b[(size_t)l * MODW + c0 + lane]; }
        __syncthreads();
    }
}
__global__ void k_rope(float* __restrict__ rope) {
    const int i = blockIdx.x * blockDim.x + threadIdx.x;
    if (i >= SEQ * 64) return;
    const int t = i / 64, d = i % 64;
    const float inv = powf(10000.0f, -(float)d / 64.0f);
    const float ang = (float)t * inv;
    float s, c; sincosf(ang, &s, &c);
    rope[i] = c; rope[SEQ * 64 + i] = s;
}

struct NormArgs {
    const float* x_in; const float* y; float* x_out; f16* h; f16* h2;
    const float* gate; const float* post; const float* pre; const float* scale; const float* shift; const float* kvn;
    float w; int has_y, has_h, has_kv, pad;
};
__device__ __forceinline__ void norm_rows(const NormArgs& a, int gw, int ngw, int lane) {
    for (int row = gw; row < M; row += ngw) {
        const int b = row / SEQ;
        const f32x4* xr = (const f32x4*)(a.x_in + (size_t)row * DM) + lane;
        f32x4 v[8];
#pragma unroll
        for (int j = 0; j < 8; ++j) v[j] = xr[64 * j];
        if (a.has_y) {
            const f32x4* yr = (const f32x4*)(a.y + (size_t)row * DM) + lane;
            f32x4 yv[8]; float s = 0.f;
#pragma unroll
            for (int j = 0; j < 8; ++j) { yv[j] = yr[64 * j]; s += (yv[j].x * yv[j].x + yv[j].y * yv[j].y) + (yv[j].z * yv[j].z + yv[j].w * yv[j].w); }
            const float r1 = rsqrtf(wave_sum(s) * (1.f / DM) + EPS) * a.w;
            const f32x4* gp = (const f32x4*)(a.gate + (size_t)b * MODW) + lane; const f32x4* pp = (const f32x4*)a.post + lane;
#pragma unroll
            for (int j = 0; j < 8; ++j) { const f32x4 g = gp[64 * j], p = pp[64 * j]; v[j] = v[j] + (yv[j] * r1) * p * g; }
            f32x4* xo = (f32x4*)(a.x_out + (size_t)row * DM) + lane;
#pragma unroll
            for (int j = 0; j < 8; ++j) xo[64 * j] = v[j];
        }
        if (a.has_h || a.has_kv) {
            float s = 0.f;
#pragma unroll
            for (int j = 0; j < 8; ++j) s += (v[j].x * v[j].x + v[j].y * v[j].y) + (v[j].z * v[j].z + v[j].w * v[j].w);
            const float r2 = rsqrtf(wave_sum(s) * (1.f / DM) + EPS);
            if (a.has_h) {
                const f32x4* pp = (const f32x4*)a.pre + lane; const f32x4* sp = (const f32x4*)(a.scale + (size_t)b * MODW) + lane; const f32x4* hp = (const f32x4*)(a.shift + (size_t)b * MODW) + lane;
                f16x4* ho = (f16x4*)(a.h + (size_t)row * DM) + lane;
#pragma unroll
                for (int j = 0; j < 8; ++j) { const f32x4 p = pp[64 * j], sc = sp[64 * j], sh = hp[64 * j]; const f32x4 o = (v[j] * r2) * p * (sc + 1.f) + sh;
                    ho[64 * j] = __builtin_convertvector(o, f16x4); }
            }
            if (a.has_kv) {
                const f32x4* pp = (const f32x4*)a.kvn + lane; f16x4* ho = (f16x4*)(a.h2 + (size_t)row * DM) + lane;
#pragma unroll
                for (int j = 0; j < 8; ++j) { const f32x4 o = (v[j] * r2) * pp[64 * j]; ho[64 * j] = __builtin_convertvector(o, f16x4); }
            }
        }
    }
}
struct NormArgs2 {
    const void* x_in; const f16* y; void* x_out; f16* h; f16* h2;
    const float* gate; const float* post; const float* pre; const float* scale; const float* shift; const float* kvn;
    float w; int has_y, has_h, has_kv;
};
template <bool XIN16, bool XOUT16>
__device__ __forceinline__ void norm_rows_lds(const NormArgs2& a, LAS unsigned char* lds, const int vcu, const int G, const int wave, const int lane) {
    const int rows_per_wg = M / G, row0 = vcu * rows_per_wg, b = row0 / SEQ, tid = wave * 64 + lane;
    LAS f32x4* LA = (LAS f32x4*)lds; LAS f32x4* LB = LA + 512; LAS f32x4* LC = LA + 1024; LAS f32x4* LK = LA + 1536;
    { const int i = tid;
      if (a.has_y) { const f32x4 g = ((const f32x4*)(a.gate + (size_t)b * MODW))[i], p = ((const f32x4*)a.post)[i]; LA[i] = g * p * a.w; }
      if (a.has_h) { const f32x4 p = ((const f32x4*)a.pre)[i], sc = ((const f32x4*)(a.scale + (size_t)b * MODW))[i]; LB[i] = p * (sc + 1.f); LC[i] = ((const f32x4*)(a.shift + (size_t)b * MODW))[i]; }
      if (a.has_kv) LK[i] = ((const f32x4*)a.kvn)[i]; }
    __syncthreads();
    for (int rr = wave * 2; rr < rows_per_wg; rr += 16) {
        const int row = row0 + rr;
        f32x4 v[2][8]; f16x4 yv[2][8];
#pragma unroll
        for (int q = 0; q < 2; ++q) {
            if (XIN16) { const f16x4* xr = (const f16x4*)((const f16*)a.x_in + (size_t)(row + q) * DM) + lane;
#pragma unroll
                for (int j = 0; j < 8; ++j) v[q][j] = __builtin_convertvector(xr[64 * j], f32x4); }
            else { const f32x4* xr = (const f32x4*)((const float*)a.x_in + (size_t)(row + q) * DM) + lane;
#pragma unroll
                for (int j = 0; j < 8; ++j) v[q][j] = xr[64 * j]; } }
        if (a.has_y) {
#pragma unroll
            for (int q = 0; q < 2; ++q) { const f16x4* yr = (const f16x4*)(a.y + (size_t)(row + q) * DM) + lane;
#pragma unroll
                for (int j = 0; j < 8; ++j) yv[q][j] = yr[64 * j]; }
#pragma unroll
            for (int q = 0; q < 2; ++q) { float s = 0.f; f32x4 yf[8];
#pragma unroll
                for (int j = 0; j < 8; ++j) { yf[j] = __builtin_convertvector(yv[q][j], f32x4); s += (yf[j].x * yf[j].x + yf[j].y * yf[j].y) + (yf[j].z * yf[j].z + yf[j].w * yf[j].w); }
                const float r1 = rsqrtf(wave_sum(s) * (1.f / DM) + EPS);
#pragma unroll
                for (int j = 0; j < 8; ++j) v[q][j] = v[q][j] + (yf[j] * r1) * LA[lane + 64 * j];
                if (XOUT16) { f16x4* xo = (f16x4*)((f16*)a.x_out + (size_t)(row + q) * DM) + lane;
#pragma unroll
                    for (int j = 0; j < 8; ++j) xo[64 * j] = __builtin_convertvector(v[q][j], f16x4); }
                else { f32x4* xo = (f32x4*)((float*)a.x_out + (size_t)(row + q) * DM) + lane;
#pragma unroll
                    for (int j = 0; j < 8; ++j) xo[64 * j] = v[q][j]; } }
        }
        if (a.has_h || a.has_kv) {
#pragma unroll
            for (int q = 0; q < 2; ++q) { float s = 0.f;
#pragma unroll
                for (int j = 0; j < 8; ++j) s += (v[q][j].x * v[q][j].x + v[q][j].y * v[q][j].y) + (v[q][j].z * v[q][j].z + v[q][j].w * v[q][j].w);
                const float r2 = rsqrtf(wave_sum(s) * (1.f / DM) + EPS);
                if (a.has_h) { u32x2_t* ho = (u32x2_t*)(a.h + (size_t)(row + q) * DM) + lane;
#pragma unroll
                    for (int j = 0; j < 8; ++j) { const f32x4 o = (v[q][j] * r2) * LB[lane + 64 * j] + LC[lane + 64 * j]; ho[64 * j] = op_pk4(o); } }
                if (a.has_kv) { u32x2_t* ho = (u32x2_t*)(a.h2 + (size_t)(row + q) * DM) + lane;
#pragma unroll
                    for (int j = 0; j < 8; ++j) { const f32x4 o = (v[q][j] * r2) * LK[lane + 64 * j]; ho[64 * j] = op_pk4(o); } }
            }
        }
    }
    __syncthreads();
}
__global__ __launch_bounds__(512) void k_norm(NormArgs a) {
    const int lane = threadIdx.x & 63, w = threadIdx.x >> 6;
    norm_rows(a, blockIdx.x * 8 + w, gridDim.x * 8, lane);
}


namespace pg8 {
#define PG8_LAS __attribute__((address_space(3)))
typedef unsigned short bf16_t;
#if OPBF16
typedef short bf16x8 __attribute__((ext_vector_type(8)));
#define PG8_MFMA16 __builtin_amdgcn_mfma_f32_16x16x32_bf16
#else
typedef _Float16 bf16x8 __attribute__((ext_vector_type(8)));
#define PG8_MFMA16 __builtin_amdgcn_mfma_f32_16x16x32_f16
#endif
typedef float f32x4 __attribute__((ext_vector_type(4)));
typedef unsigned u32x4 __attribute__((ext_vector_type(4)));
constexpr int BM = 256, BK = 64, HALF = 128, HTB = HALF * BK * 2  , STAGE_BYTES = 8 * HTB, NXCD = 8, WGM = 8;

__host__ __device__ __forceinline__ int lds_byte(int r, int c) { const int st = (r >> 4) * 2 + (c >> 5), rr = r & 15, cc = c & 31, ob = rr * 64 + cc * 2; return st * 1024 + (ob ^ (((ob >> 9) & 1) << 5)); }
__host__ __device__ __forceinline__ void stage_rc(int b, int& R, int& C) { const int st = b / 1024, sb = b % 1024, swz = sb ^ (((sb >> 9) & 1) << 5); R = (st >> 1) * 16 + swz / 64; C = (st & 1) * 32 + (swz % 64) / 2; }
__host__ __device__ __forceinline__ int perm32(int rho) { const int n = rho >> 4, i = rho & 15; return 8 * (i >> 2) + 4 * n + (i & 3); }

struct Unit { int pm, pn; };
struct Gemm { const bf16_t* A; const bf16_t* Bt; int M, N, K; };

struct StaticOrder {
    int nM, nN, nwg, G, c;
    __host__ __device__ void init(int M, int N, int G_, int c_) { nM = M / BM; nN = N / BM; nwg = nM * nN; G = G_; c = c_; }
    __host__ __device__ bool next(int i, Unit& u) const {
        const long L = (long)i * G + c; if (L >= nwg) return false;
        int wgid = (int)L; { const int q = nwg / NXCD, r = nwg % NXCD, xcd = wgid % NXCD, off = wgid / NXCD; wgid = (xcd < r ? xcd * (q + 1) : r * (q + 1) + (xcd - r) * q) + off; }
        const int nig = WGM * nN, gid = wgid / nig, fm = gid * WGM, gsz = (nM - fm) < WGM ? (nM - fm) : WGM;
        u.pm = fm + ((wgid % nig) % gsz); u.pn = (wgid % nig) / gsz; return true;
    }
    __device__ __forceinline__ void a_ready(const Unit&) const {}
    __device__ __forceinline__ void done(const Unit&) const {}
};
template <class Epi, class Sched, bool ALIGN_EPI = false, bool SP2 = false>
__device__ __forceinline__ void gemm_phase(PG8_LAS unsigned char* lds, const Gemm g, const Sched& S, const Epi& E, const int wid  ) {
    const int lane = lane_id_opaque(), tid = wid * 64 + lane, wr = wid >> 2, wc = wid & 3, fr = lane & 15, fq = lane >> 4;
    const int K = g.K, nt = K / BK;
    unsigned voffA[2], voffB[2];
#pragma unroll
    for (int i = 0; i < 2; ++i) { int R, C; stage_rc(tid * 16 + i * 8192, R, C); const int Rb = Epi::PERM ? ((R & ~31) + perm32(R & 31)) : R;
        voffA[i] = (unsigned)(R * K + C) * 2u; voffB[i] = (unsigned)(Rb * K + C) * 2u; }
    const size_t kstep = (size_t)(BK * 2);
    const size_t hstep = (size_t)HALF * K * 2;
    const size_t tstep = 2 * hstep;
    const unsigned ldsw = (unsigned)wid * 1024u;
    const int aoff = lds_byte(wr * 64 + fr, fq * 8), boff = lds_byte(wc * 32 + fr, fq * 8);
#define PG8_SA(b, h) (((b) * 2 + (h)) * HTB)
#define PG8_SB(b, h) ((4 + (b) * 2 + (h)) * HTB)
#define PG8_STAGE(bufoff, gbase, voff) do { _Pragma("unroll") for (int _i = 0; _i < 2; ++_i) \
        __builtin_amdgcn_global_load_lds((const unsigned*)((const char*)(gbase) + (voff)[_i]), (PG8_LAS unsigned*)(lds + (bufoff) + ldsw + _i * 8192), 16, 0, 0); } while (0)
#define PG8_LDA(dst, b, h) do { _Pragma("unroll") for (int m = 0; m < 4; ++m) _Pragma("unroll") for (int k = 0; k < 2; ++k) dst[m][k] = *(const PG8_LAS bf16x8*)(lds + PG8_SA(b, h) + aoff + m * 2048 + k * 1024); } while (0)
#define PG8_LDB(dst, b, h) do { _Pragma("unroll") for (int n = 0; n < 2; ++n) _Pragma("unroll") for (int k = 0; k < 2; ++k) dst[n][k] = *(const PG8_LAS bf16x8*)(lds + PG8_SB(b, h) + boff + n * 2048 + k * 1024); } while (0)
#define PG8_MMA(ai, bj, At, Bt) do { __builtin_amdgcn_s_setprio(1); _Pragma("unroll") for (int m = 0; m < 4; ++m) _Pragma("unroll") for (int n = 0; n < 2; ++n) _Pragma("unroll") for (int k = 0; k < 2; ++k) \
        acc[ai][bj][m][n] = PG8_MFMA16(Bt[n][k], At[m][k], acc[ai][bj][m][n], 0, 0, 0); __builtin_amdgcn_s_setprio(0); } while (0)
#define PG8_WAIT_V(n) asm volatile("s_waitcnt vmcnt(" #n ")" ::: "memory")
#define PG8_WAIT_L(n) asm volatile("s_waitcnt lgkmcnt(" #n ")" ::: "memory")
#define PG8_BAR __builtin_amdgcn_s_barrier()
#define PG8_SCHED __builtin_amdgcn_sched_barrier(0)
    Unit cur, nxt; int ui = 0;
    if (!S.next(0, cur)) return;
    f32x4 acc[2][2][4][2];
#pragma unroll
    for (int a = 0; a < 2; ++a)
#pragma unroll
        for (int b = 0; b < 2; ++b)
#pragma unroll
            for (int m = 0; m < 4; ++m)
#pragma unroll
                for (int n = 0; n < 2; ++n) acc[a][b][m][n] = (f32x4){0.f, 0.f, 0.f, 0.f};
    bf16x8 At[4][2], B0[2][2], B1[2][2];
    const char* cA = (const char*)g.A + (size_t)cur.pm * tstep; const char* cB = (const char*)g.Bt + (size_t)cur.pn * tstep;
    S.a_ready(cur);
    if constexpr (SP2) {
        PG8_STAGE(PG8_SB(0, 0), cB, voffB); PG8_STAGE(PG8_SB(0, 1), cB + hstep, voffB); PG8_STAGE(PG8_SA(0, 0), cA, voffA); PG8_STAGE(PG8_SA(0, 1), cA + hstep, voffA);
        if (wr == 1) PG8_BAR;
        PG8_WAIT_V(2); PG8_BAR;
        PG8_STAGE(PG8_SB(1, 0), cB + kstep, voffB); PG8_STAGE(PG8_SA(1, 0), cA + kstep, voffA); PG8_STAGE(PG8_SB(1, 1), cB + hstep + kstep, voffB);
        PG8_WAIT_V(6); PG8_BAR;
    } else {
        PG8_STAGE(PG8_SB(0, 0), cB, voffB); PG8_STAGE(PG8_SA(0, 0), cA, voffA); PG8_STAGE(PG8_SB(0, 1), cB + hstep, voffB); PG8_STAGE(PG8_SA(0, 1), cA + hstep, voffA);
        if (wr == 1) PG8_BAR;
        PG8_WAIT_V(4); PG8_BAR;
        PG8_STAGE(PG8_SB(1, 0), cB + kstep, voffB); PG8_STAGE(PG8_SA(1, 0), cA + kstep, voffA); PG8_STAGE(PG8_SB(1, 1), cB + hstep + kstep, voffB);
        PG8_WAIT_V(6); PG8_BAR;
    }
    for (;;) {
        const bool has_next = S.next(ui + 1, nxt);
        const char* nA = has_next ? (const char*)g.A + (size_t)nxt.pm * tstep : cA; const char* nB = has_next ? (const char*)g.Bt + (size_t)nxt.pn * tstep : cB;
        for (int t = 0; t < nt; t += 2) {
            const bool last = (t == nt - 2);
            const char* a1 = cA + (size_t)(t + 1) * kstep;
            const char* a2 = last ? nA : cA + (size_t)(t + 2) * kstep; const char* b2 = last ? nB : cB + (size_t)(t + 2) * kstep;
            const char* a3 = a2 + kstep; const char* b3 = b2 + kstep;
            if (last && has_next) S.a_ready(nxt);
            if constexpr (SP2) {
            PG8_LDB(B0, 0, 0); PG8_LDB(B1, 0, 1); PG8_SCHED; PG8_LDA(At, 0, 0); PG8_STAGE(PG8_SA(1, 1), a1 + hstep, voffA);
            PG8_WAIT_V(8); PG8_WAIT_L(0); PG8_BAR; PG8_MMA(0, 0, At, B0); PG8_MMA(0, 1, At, B1); PG8_BAR; PG8_SCHED;
            PG8_LDA(At, 0, 1); PG8_STAGE(PG8_SB(0, 0), b2, voffB); PG8_STAGE(PG8_SB(0, 1), b2 + hstep, voffB); PG8_STAGE(PG8_SA(0, 0), a2, voffA);
            PG8_WAIT_V(8); PG8_WAIT_L(0); PG8_BAR; PG8_MMA(1, 0, At, B0); PG8_MMA(1, 1, At, B1); PG8_BAR; PG8_SCHED;
            PG8_LDB(B0, 1, 0); PG8_LDB(B1, 1, 1); PG8_SCHED; PG8_LDA(At, 1, 0); PG8_STAGE(PG8_SA(0, 1), a2 + hstep, voffA);
            PG8_WAIT_V(8); PG8_WAIT_L(0); PG8_BAR; PG8_MMA(0, 0, At, B0); PG8_MMA(0, 1, At, B1); PG8_BAR; PG8_SCHED;
            PG8_LDA(At, 1, 1); PG8_STAGE(PG8_SB(1, 0), b3, voffB); PG8_STAGE(PG8_SB(1, 1), b3 + hstep, voffB); PG8_STAGE(PG8_SA(1, 0), a3, voffA);
            PG8_WAIT_V(8); PG8_WAIT_L(0); PG8_BAR; PG8_MMA(1, 0, At, B0); PG8_MMA(1, 1, At, B1); PG8_BAR; PG8_SCHED;
            } else {
            PG8_LDB(B0, 0, 0); PG8_SCHED; PG8_LDA(At, 0, 0); PG8_STAGE(PG8_SA(1, 1), a1 + hstep, voffA);
            PG8_WAIT_L(8); PG8_BAR; PG8_WAIT_L(0); PG8_MMA(0, 0, At, B0); PG8_BAR; PG8_SCHED;
            PG8_LDB(B1, 0, 1); PG8_STAGE(PG8_SB(0, 0), b2, voffB);
            PG8_BAR; PG8_WAIT_L(0); PG8_MMA(0, 1, At, B1); PG8_BAR;
            PG8_LDA(At, 0, 1); PG8_STAGE(PG8_SA(0, 0), a2, voffA);
            PG8_BAR; PG8_WAIT_L(0); PG8_MMA(1, 0, At, B0); PG8_BAR; PG8_SCHED;
            PG8_STAGE(PG8_SB(0, 1), b2 + hstep, voffB);
            PG8_WAIT_V(6); PG8_BAR; PG8_MMA(1, 1, At, B1); PG8_BAR;
            PG8_LDB(B0, 1, 0); PG8_SCHED; PG8_LDA(At, 1, 0); PG8_STAGE(PG8_SA(0, 1), a2 + hstep, voffA);
            PG8_WAIT_L(8); PG8_BAR; PG8_WAIT_L(0); PG8_MMA(0, 0, At, B0); PG8_BAR; PG8_SCHED;
            PG8_LDB(B1, 1, 1); PG8_STAGE(PG8_SB(1, 0), b3, voffB);
            PG8_BAR; PG8_WAIT_L(0); PG8_MMA(0, 1, At, B1); PG8_BAR;
            PG8_LDA(At, 1, 1); PG8_STAGE(PG8_SA(1, 0), a3, voffA);
            PG8_BAR; PG8_WAIT_L(0); PG8_MMA(1, 0, At, B0); PG8_BAR; PG8_SCHED;
            PG8_STAGE(PG8_SB(1, 1), b3 + hstep, voffB);
            PG8_WAIT_V(6); PG8_BAR; PG8_MMA(1, 1, At, B1); PG8_BAR;
            }
        }
        if constexpr (ALIGN_EPI) { if (wr == 0) PG8_BAR; }
        if constexpr (!Epi::AFTER_DRAIN) { E(acc, cur, wr, wc, fr, fq); S.done(cur); }
        if (!has_next) break;
#pragma unroll
        for (int a = 0; a < 2; ++a)
#pragma unroll
            for (int b = 0; b < 2; ++b)
#pragma unroll
                for (int m = 0; m < 4; ++m)
#pragma unroll
                    for (int n = 0; n < 2; ++n) acc[a][b][m][n] = (f32x4){0.f, 0.f, 0.f, 0.f};
        cur = nxt; cA = nA; cB = nB; ++ui;
        if constexpr (ALIGN_EPI) { if (wr == 1) PG8_BAR; }
    }
    PG8_WAIT_V(0);
    if constexpr (!ALIGN_EPI) { if (wr == 0) PG8_BAR; }
    PG8_BAR;
    if constexpr (Epi::AFTER_DRAIN) { E.fused(acc, cur, wr, wc, fr, fq, lds, wid, lane); S.done(cur); }
#undef PG8_SA
#undef PG8_SB
#undef PG8_STAGE
#undef PG8_LDA
#undef PG8_LDB
#undef PG8_MMA
#undef PG8_WAIT_V
#undef PG8_WAIT_L
#undef PG8_BAR
#undef PG8_SCHED
}
}

namespace pg8 {
typedef _Float16 h16x8 __attribute__((ext_vector_type(8)));
typedef float f32x8 __attribute__((ext_vector_type(8)));
__device__ __forceinline__ h16x8 cvt8(f32x4 a, f32x4 b) { const f32x8 v = {a[0], a[1], a[2], a[3], b[0], b[1], b[2], b[3]}; return __builtin_convertvector(v, h16x8); }
__device__ __forceinline__ float silu1(float x) { return x * __builtin_amdgcn_rcpf(1.f + __expf(-x)); }
__device__ __forceinline__ f32x4 silu4(f32x4 x) { return (f32x4){silu1(x[0]), silu1(x[1]), silu1(x[2]), silu1(x[3])}; }

struct EpiF32 {
    static constexpr bool PERM = false, AFTER_DRAIN = false;
    float* C; int ldc;
    __device__ __forceinline__ void operator()(const f32x4 (&acc)[2][2][4][2], const Unit& u, int wr, int wc, int, int) const {
        const int lane_ = lane_id_opaque(); const int fr = lane_ & 15, fq = lane_ >> 4;
        const int row0 = u.pm * BM + wr * 64 + fr, col0 = u.pn * BM + wc * 32 + 4 * fq;
#pragma unroll
        for (int ai = 0; ai < 2; ++ai)
#pragma unroll
            for (int m = 0; m < 4; ++m) { float* rowp = C + (size_t)(row0 + ai * HALF + m * 16) * ldc + col0;
#pragma unroll
                for (int bj = 0; bj < 2; ++bj)
#pragma unroll
                    for (int n = 0; n < 2; ++n) *(f32x4*)(rowp + bj * HALF + n * 16) = acc[ai][bj][m][n]; }
    }
};
struct EpiF16 {
    static constexpr bool PERM = true, AFTER_DRAIN = false;
    f16* C; int ldc;
    __device__ __forceinline__ void operator()(const f32x4 (&acc)[2][2][4][2], const Unit& u, int wr, int wc, int, int) const {
        const int lane_ = lane_id_opaque(); const int fr = lane_ & 15, fq = lane_ >> 4;
        const int row0 = u.pm * BM + wr * 64 + fr, col0 = u.pn * BM + wc * 32 + 8 * fq;
#pragma unroll
        for (int ai = 0; ai < 2; ++ai)
#pragma unroll
            for (int m = 0; m < 4; ++m) { f16* rowp = C + (size_t)(row0 + ai * HALF + m * 16) * ldc + col0;
#pragma unroll
                for (int bj = 0; bj < 2; ++bj) *(h16x8*)(rowp + bj * HALF) = cvt8(acc[ai][bj][m][0], acc[ai][bj][m][1]); }
    }
};
struct EpiSwiGLU {
    static constexpr bool PERM = true, AFTER_DRAIN = false;
    f16* act;
    __device__ __forceinline__ void operator()(const f32x4 (&acc)[2][2][4][2], const Unit& u, int wr, int wc, int, int) const {
        const int lane_ = lane_id_opaque(); const int fr = lane_ & 15, fq = lane_ >> 4;
        const int row0 = u.pm * BM + wr * 64 + fr, col0 = u.pn * 128 + wc * 32 + 8 * fq;
#pragma unroll
        for (int ai = 0; ai < 2; ++ai)
#pragma unroll
            for (int m = 0; m < 4; ++m) {
                const f32x4 o0 = silu4(acc[ai][0][m][0]) * acc[ai][1][m][0], o1 = silu4(acc[ai][0][m][1]) * acc[ai][1][m][1];
                *(u32x4*)(act + (size_t)(row0 + ai * HALF + m * 16) * FF + col0) = op_pk8(o0, o1); }
    }
};
struct EpiHgrn {
    static constexpr bool PERM = true, AFTER_DRAIN = false;
    f16* qh; f16* kh; u16* vh; f16* gh; float* lf; const float* lb;
    __device__ __forceinline__ void operator()(const f32x4 (&acc)[2][2][4][2], const Unit& u, int wr, int wc, int, int) const {
        const int lane_ = lane_id_opaque(); const int fr = lane_ & 15, fq = lane_ >> 4;
        const int grp = u.pn >> 3, row0 = u.pm * BM + wr * 64 + fr, col0 = (u.pn & 7) * BM + wc * 32 + 8 * fq;
        if (grp == 1) {
#pragma unroll
            for (int bj = 0; bj < 2; ++bj) {
                const f32x4 lba = *(const f32x4*)(lb + col0 + bj * HALF), lbb = *(const f32x4*)(lb + col0 + bj * HALF + 4);
#pragma unroll
                for (int ai = 0; ai < 2; ++ai)
#pragma unroll
                    for (int m = 0; m < 4; ++m) { const size_t ro = (size_t)(row0 + ai * HALF + m * 16) * DM + col0 + bj * HALF; f32x4 kk[2], lg[2];
#pragma unroll
                        for (int n = 0; n < 2; ++n)
#pragma unroll
                            for (int j = 0; j < 4; ++j) { const float l = n ? lbb[j] : lba[j]; const float sg = __builtin_amdgcn_rcpf(1.f + __expf(-acc[ai][bj][m][n][j])); const float fg = l + (1.f - l) * sg;
                                kk[n][j] = 1.f - fg; lg[n][j] = __logf(fg); }
                        *(h16x8*)(kh + ro) = cvt8(kk[0], kk[1]);
                        *(f32x4*)(lf + ro) = lg[0]; *(f32x4*)(lf + ro + 4) = lg[1];
                        asm volatile("" ::: "memory"); }
            }
        } else if (grp == 2) {
#pragma unroll
            for (int ai = 0; ai < 2; ++ai)
#pragma unroll
                for (int m = 0; m < 4; ++m) { const size_t ro = (size_t)(row0 + ai * HALF + m * 16) * DM + col0;
#pragma unroll
                    for (int bj = 0; bj < 2; ++bj) { const f32x4 a = acc[ai][bj][m][0], b = acc[ai][bj][m][1];
                        u32x4 w; w.x = f2bf(a[0]) | ((unsigned)f2bf(a[1]) << 16); w.y = f2bf(a[2]) | ((unsigned)f2bf(a[3]) << 16); w.z = f2bf(b[0]) | ((unsigned)f2bf(b[1]) << 16); w.w = f2bf(b[2]) | ((unsigned)f2bf(b[3]) << 16);
                        *(u32x4*)(vh + ro + bj * HALF) = w; } }
        } else {
            f16* dst = grp == 0 ? qh : gh;
#pragma unroll
            for (int ai = 0; ai < 2; ++ai)
#pragma unroll
                for (int m = 0; m < 4; ++m) { const size_t ro = (size_t)(row0 + ai * HALF + m * 16) * DM + col0;
#pragma unroll
                    for (int bj = 0; bj < 2; ++bj) *(h16x8*)(dst + ro + bj * HALF) = cvt8(silu4(acc[ai][bj][m][0]), silu4(acc[ai][bj][m][1])); }
        }
    }
};
struct EpiRot {
    static constexpr bool PERM = true, AFTER_DRAIN = false;
    f16* dst; int nheads; const float* rope; float* kmean; f16* vdst; int nrot;
    __device__ __forceinline__ void operator()(const f32x4 (&acc)[2][2][4][2], const Unit& u, int wr, int wc, int, int) const {
        const int lane_ = lane_id_opaque(); const int fr = lane_ & 15, fq = lane_ >> 4;
        const int b = u.pm >> 4, t0 = (u.pm & 15) * BM + wr * 64 + fr;
        if (u.pn < nrot) {
            const int head = 2 * u.pn + (wc >> 1), dd0 = 32 * (wc & 1) + 8 * fq;
            f16* base = dst + ((size_t)(b * nheads + head) * SEQ) * 128 + dd0;
            f32x4 s1a = {0.f, 0.f, 0.f, 0.f}, s1b = s1a, s2a = s1a, s2b = s1a;
#pragma unroll
            for (int ai = 0; ai < 2; ++ai)
#pragma unroll
                for (int m = 0; m < 4; ++m) { const int t = t0 + ai * HALF + m * 16;
                    const f32x4 c0 = *(const f32x4*)(rope + t * 64 + dd0), c1 = *(const f32x4*)(rope + t * 64 + dd0 + 4), s0 = *(const f32x4*)(rope + SEQ * 64 + t * 64 + dd0), s1 = *(const f32x4*)(rope + SEQ * 64 + t * 64 + dd0 + 4);
                    const f32x4 xa = acc[ai][0][m][0], xb = acc[ai][0][m][1], ya = acc[ai][1][m][0], yb = acc[ai][1][m][1];
                    const f32x4 o1a = xa * c0 - ya * s0, o1b = xb * c1 - yb * s1, o2a = ya * c0 + xa * s0, o2b = yb * c1 + xb * s1;
                    *(h16x8*)(base + (size_t)t * 128) = cvt8(o1a, o1b); *(h16x8*)(base + (size_t)t * 128 + 64) = cvt8(o2a, o2b);
                    s1a += o1a; s1b += o1b; s2a += o2a; s2b += o2b; }
            if (kmean) {
#pragma unroll
                for (int j = 0; j < 4; ++j) {
#pragma unroll
                    for (int o = 1; o < 16; o <<= 1) { s1a[j] += __shfl_xor(s1a[j], o); s1b[j] += __shfl_xor(s1b[j], o); s2a[j] += __shfl_xor(s2a[j], o); s2b[j] += __shfl_xor(s2b[j], o); } }
                if (fr == 0) { float* km = kmean + ((size_t)(b * nheads + head) * NBLK + (u.pm & 15)) * 128 + dd0;
#pragma unroll
                    for (int j = 0; j < 4; ++j) { atomicAdd(km + j, s1a[j] * (1.f / MBLK)); atomicAdd(km + 4 + j, s1b[j] * (1.f / MBLK)); atomicAdd(km + 64 + j, s2a[j] * (1.f / MBLK)); atomicAdd(km + 68 + j, s2b[j] * (1.f / MBLK)); } }
            }
        } else {
            const int d0 = 32 * wc + 8 * fq;
#pragma unroll
            for (int bj = 0; bj < 2; ++bj) { f16* base = vdst + ((size_t)(b * nheads + 2 * (u.pn - nrot) + bj) * SEQ) * 128 + d0;
#pragma unroll
                for (int ai = 0; ai < 2; ++ai)
#pragma unroll
                    for (int m = 0; m < 4; ++m) *(h16x8*)(base + (size_t)(t0 + ai * HALF + m * 16) * 128) = cvt8(acc[ai][bj][m][0], acc[ai][bj][m][1]); }
        }
    }
};
}

__global__ __launch_bounds__(256) void k_naive_gemm(const f16* __restrict__ A, const float* __restrict__ W, float* __restrict__ C, int N, int K) {
    __shared__ float As[16][132];
    __shared__ float Bs[16][132];
    const int tid = threadIdx.x, tx = tid & 15, ty = tid >> 4;
    const int bm = blockIdx.y * 128, bn = blockIdx.x * 128;
    float acc[8][8];
#pragma unroll
    for (int i = 0; i < 8; ++i)
#pragma unroll
        for (int j = 0; j < 8; ++j) acc[i][j] = 0.f;
    const int ar = tid >> 1, ac = (tid & 1) * 8;
    const int br = tid >> 4, bc = (tid & 15) * 8;
    for (int k0 = 0; k0 < K; k0 += 16) {
        const f16x8 av = *(const f16x8*)(A + (size_t)(bm + ar) * K + k0 + ac);
        const f32x4 b0 = *(const f32x4*)(W + (size_t)(k0 + br) * N + bn + bc), b1 = *(const f32x4*)(W + (size_t)(k0 + br) * N + bn + bc + 4);
        __syncthreads();
#pragma unroll
        for (int i = 0; i < 8; ++i) As[ac + i][ar] = (float)av[i];
        *(f32x4*)&Bs[br][bc] = b0; *(f32x4*)&Bs[br][bc + 4] = b1;
        __syncthreads();
#pragma unroll
        for (int kk = 0; kk < 16; ++kk) {
            float a[8], b[8];
            const f32x4 a0 = *(const f32x4*)&As[kk][ty * 8], a1 = *(const f32x4*)&As[kk][ty * 8 + 4];
            const f32x4 bb0 = *(const f32x4*)&Bs[kk][tx * 8], bb1 = *(const f32x4*)&Bs[kk][tx * 8 + 4];
            a[0] = a0.x; a[1] = a0.y; a[2] = a0.z; a[3] = a0.w; a[4] = a1.x; a[5] = a1.y; a[6] = a1.z; a[7] = a1.w;
            b[0] = bb0.x; b[1] = bb0.y; b[2] = bb0.z; b[3] = bb0.w; b[4] = bb1.x; b[5] = bb1.y; b[6] = bb1.z; b[7] = bb1.w;
#pragma unroll
            for (int i = 0; i < 8; ++i)
#pragma unroll
                for (int j = 0; j < 8; ++j) acc[i][j] += a[i] * b[j];
        }
    }
#pragma unroll
    for (int i = 0; i < 8; ++i) {
        float* cp = C + (size_t)(bm + ty * 8 + i) * N + bn + tx * 8;
        *(f32x4*)cp = (f32x4){acc[i][0], acc[i][1], acc[i][2], acc[i][3]}; *(f32x4*)(cp + 4) = (f32x4){acc[i][4], acc[i][5], acc[i][6], acc[i][7]};
    }
}
__global__ void k_naive_ffn_act(const float* __restrict__ C, f16* __restrict__ act) {
    const size_t i = (size_t)blockIdx.x * blockDim.x + threadIdx.x;
    if (i >= (size_t)M * FF) return;
    const size_t m = i / FF, j = i % FF;
    act[i] = (f16)(silu_f(C[m * (2 * FF) + j]) * C[m * (2 * FF) + FF + j]);
}
__global__ void k_naive_hgrn_split(const float* __restrict__ C, const float* __restrict__ hgrn_lb, f16* __restrict__ qh, f16* __restrict__ kh, u16* __restrict__ vh, f16* __restrict__ gh, float* __restrict__ lf) {
    const size_t i = (size_t)blockIdx.x * blockDim.x + threadIdx.x;
    if (i >= (size_t)M * DM) return;
    const size_t m = i / DM, j = i % DM;
    const float* c = C + m * (4 * DM);
    const float l0 = hgrn_lb[j], l1 = hgrn_lb[DM + j];
    const float lb = 1.f / (1.f + expf(l1 - l0));
    const float sg = 1.f / (1.f + expf(-c[DM + j]));
    const float forget = lb + (1.f - lb) * sg;
    qh[i] = (f16)silu_f(c[j]);
    kh[i] = (f16)(1.f - forget);
    lf[i] = logf(forget);
    vh[i] = f2bf(c[2 * DM + j]);
    gh[i] = (f16)silu_f(c[3 * DM + j]);
}
__global__ __launch_bounds__(128) void k_naive_scan(const f16* __restrict__ qh, const f16* __restrict__ kh, const u16* __restrict__ vh, const f16* __restrict__ gh, const float* __restrict__ lf,
                                                   const float* __restrict__ gnorm, f16* __restrict__ og) {
    __shared__ float qs[8][128], ks[8][128], fs[8][128];
    __shared__ float red[2];
    const int b = blockIdx.x / NH, h = blockIdx.x % NH, e = threadIdx.x;
    float S[128];
#pragma unroll
    for (int d = 0; d < 128; ++d) S[d] = 0.f;
    const float gn = gnorm[e];
    for (int t0 = 0; t0 < SEQ; t0 += 8) {
        __syncthreads();
#pragma unroll
        for (int i = 0; i < 8; ++i) { const size_t o = (size_t)(b * SEQ + t0 + i) * DM + h * 128 + e; qs[i][e] = (float)qh[o]; ks[i][e] = (float)kh[o]; fs[i][e] = __expf(lf[o]); }
        __syncthreads();
        for (int i = 0; i < 8; ++i) {
            const size_t o = (size_t)(b * SEQ + t0 + i) * DM + h * 128 + e;
            const float v = bf2f(vh[o]);
            float acc = 0.f;
#pragma unroll
            for (int d = 0; d < 128; d += 4) {
                const f32x4 f = *(const f32x4*)&fs[i][d], k = *(const f32x4*)&ks[i][d], q = *(const f32x4*)&qs[i][d];
                S[d] = f.x * S[d] + k.x * v; S[d + 1] = f.y * S[d + 1] + k.y * v; S[d + 2] = f.z * S[d + 2] + k.z * v; S[d + 3] = f.w * S[d + 3] + k.w * v;
                acc += S[d] * q.x + S[d + 1] * q.y + S[d + 2] * q.z + S[d + 3] * q.w;
            }
            const float ss = wave_sum(acc * acc);
            __syncthreads();
            if ((e & 63) == 0) red[e >> 6] = ss;
            __syncthreads();
            const float rstd = rsqrtf((red[0] + red[1]) * (1.f / 128.f) + EPS);
            og[o] = (f16)(acc * rstd * gn * (float)gh[o]);
        }
    }
}
__global__ void k_naive_kv_split(const float* __restrict__ C, const float* __restrict__ rope, f16* __restrict__ K, f16* __restrict__ V) {
    const size_t i = (size_t)blockIdx.x * blockDim.x + threadIdx.x;
    if (i >= (size_t)M * 512) return;
    const int m = (int)(i / 512), j = (int)(i % 512), hh = j / 128, d = j % 128, b = m / SEQ, t = m % SEQ;
    const float* c = C + (size_t)m * 1024;
    const int dd = d & 63; const float cs = rope[t * 64 + dd], sn = rope[SEQ * 64 + t * 64 + dd];
    const float x1 = c[hh * 128 + dd], x2 = c[hh * 128 + dd + 64];
    const float r = d < 64 ? x1 * cs - x2 * sn : x2 * cs + x1 * sn;
    const size_t o = ((size_t)(b * NKV + hh) * SEQ + t) * 128 + d;
    K[o] = (f16)r; V[o] = (f16)c[512 + j];
}
__global__ void k_naive_kmean(const float* __restrict__ C, const float* __restrict__ rope, float* __restrict__ kmean) {
    const int i = blockIdx.x * blockDim.x + threadIdx.x;
    if (i >= BATCH * NKV * NBLK * 128) return;
    const int d = i % 128, blk = (i / 128) % NBLK, hh = (i / (128 * NBLK)) % NKV, b = i / (128 * NBLK * NKV);
    const int dd = d & 63; float s = 0.f;
    for (int tt = 0; tt < MBLK; ++tt) { const int t = blk * MBLK + tt; const float* c = C + (size_t)(b * SEQ + t) * 1024;
        const float cs = rope[t * 64 + dd], sn = rope[SEQ * 64 + t * 64 + dd], x1 = c[hh * 128 + dd], x2 = c[hh * 128 + dd + 64];
        s += d < 64 ? x1 * cs - x2 * sn : x2 * cs + x1 * sn; }
    kmean[i] = s * (1.f / MBLK);
}
__global__ void k_naive_q_split(const float* __restrict__ C, const float* __restrict__ rope, f16* __restrict__ Q) {
    const size_t i = (size_t)blockIdx.x * blockDim.x + threadIdx.x;
    if (i >= (size_t)M * DM) return;
    const int m = (int)(i / DM), j = (int)(i % DM), hh = j / 128, d = j % 128, b = m / SEQ, t = m % SEQ;
    const float* c = C + (size_t)m * DM;
    const int dd = d & 63; const float cs = rope[t * 64 + dd], sn = rope[SEQ * 64 + t * 64 + dd];
    const float x1 = c[hh * 128 + dd], x2 = c[hh * 128 + dd + 64];
    const float r = d < 64 ? x1 * cs - x2 * sn : x2 * cs + x1 * sn;
    Q[((size_t)(b * NH + hh) * SEQ + t) * 128 + d] = (f16)r;
}
__global__ __launch_bounds__(256) void k_naive_attn(const f16* __restrict__ Q, const f16* __restrict__ K, const f16* __restrict__ V, const float* __restrict__ kmean, f16* __restrict__ O) {
    __shared__ float qs[4][128];
    __shared__ float sc[4][4 * MBLK];
    const int w = threadIdx.x >> 6, lane = threadIdx.x & 63;
    const int qi = blockIdx.x * 4 + w;
    const int t = qi % SEQ, bh = qi / SEQ, h = bh % NH, b = bh / NH, kvh = h / (NH / NKV), own = t / MBLK;
    const f16* q = Q + (size_t)qi * 128;
    qs[w][lane] = (float)q[lane]; qs[w][lane + 64] = (float)q[lane + 64];
    __syncthreads();
    float g = -__builtin_inff();
    if (lane < own) { const float* km = kmean + ((size_t)(b * NKV + kvh) * NBLK + lane) * 128; float s = 0.f; for (int d = 0; d < 128; ++d) s += qs[w][d] * km[d]; g = s; }
    int b0 = 0, b1 = 0, b2 = 0, b3 = 0; const int nsel = own < 3 ? own : 3;
    for (int s = 0; s < 3; ++s) {
        float best = g; int bi = lane;
#pragma unroll
        for (int o = 1; o < 64; o <<= 1) { const float ob = __shfl_xor(best, o); const int oi = __shfl_xor(bi, o); if (ob > best || (ob == best && oi < bi)) { best = ob; bi = oi; } }
        if (s == 0) b0 = bi; else if (s == 1) b1 = bi; else b2 = bi;
        if (lane == bi) g = -__builtin_inff();
    }
    if (nsel == 0) b0 = own; else if (nsel == 1) b1 = own; else if (nsel == 2) b2 = own; else b3 = own;
    const int nb = nsel + 1;
#define BLK_OF(s) ((s) == 0 ? b0 : (s) == 1 ? b1 : (s) == 2 ? b2 : b3)
    const f16* Kb = K + (size_t)(b * NKV + kvh) * SEQ * 128; const f16* Vb = V + (size_t)(b * NKV + kvh) * SEQ * 128;
    float mx = -__builtin_inff();
    for (int s = 0; s < nb; ++s) {
        const int blk = BLK_OF(s);
        for (int kk = lane; kk < MBLK; kk += 64) {
            const int key = blk * MBLK + kk; float a = -__builtin_inff();
            if (key <= t) { const f16x8* kr = (const f16x8*)(Kb + (size_t)key * 128); float acc = 0.f;
                for (int d8 = 0; d8 < 16; ++d8) { const f16x8 kv = kr[d8];
#pragma unroll
                    for (int j = 0; j < 8; ++j) acc += qs[w][d8 * 8 + j] * (float)kv[j]; }
                a = acc * ATT_SCALE; }
            sc[w][s * MBLK + kk] = a; mx = fmaxf(mx, a);
        }
    }
#pragma unroll
    for (int o = 1; o < 64; o <<= 1) mx = fmaxf(mx, __shfl_xor(mx, o));
    float sum = 0.f;
    for (int i = lane; i < nb * MBLK; i += 64) { const float p = __expf(sc[w][i] - mx); sc[w][i] = p; sum += p; }
    sum = wave_sum(sum);
    __syncthreads();
    float o0 = 0.f, o1 = 0.f;
    for (int s = 0; s < nb; ++s) { const int blk = BLK_OF(s);
        for (int kk = 0; kk < MBLK; ++kk) { const float p = sc[w][s * MBLK + kk]; if (p != 0.f) { const f16x2 vv = *(const f16x2*)(Vb + (size_t)(blk * MBLK + kk) * 128 + 2 * lane); o0 += p * (float)vv[0]; o1 += p * (float)vv[1]; } } }
    const float inv = 1.f / sum;
    f16x2 ov; ov[0] = (f16)(o0 * inv); ov[1] = (f16)(o1 * inv);
    *(f16x2*)(O + (size_t)(b * SEQ + t) * DM + h * 128 + 2 * lane) = ov;
}


#define XB_TMO      128
#define XB_XCNT(j)  (256  + 64 * (j))
#define XB_XSUB(j)  (1280 + 64 * (j))
#define XB_XGEN(j)  (2304 + 64 * (j))
#define XB_TOP      3328
#define XB_TOPGEN   3392
#define XCD_BAR_WORDS 3456
#define XB_SPIN_CAP (1u << 18)

__device__ __forceinline__ unsigned xb_ld(unsigned* p)              { return __hip_atomic_load(p, __ATOMIC_RELAXED, __HIP_MEMORY_SCOPE_AGENT); }
__device__ __forceinline__ unsigned xb_add(unsigned* p, unsigned v) { return __hip_atomic_fetch_add(p, v, __ATOMIC_RELAXED, __HIP_MEMORY_SCOPE_AGENT); }
__device__ __forceinline__ unsigned xb_xcc_id() { return (unsigned)__builtin_amdgcn_s_getreg((3 << 11) | 20) & 0xFu; }
#define XB_SPIN(cond, bar) do { unsigned _sp = 0; while (cond) { __builtin_amdgcn_s_sleep(1); \
    if ((++_sp & 255u) == 0u) { if (xb_ld(&(bar)[XB_TMO])) break; if (_sp > XB_SPIN_CAP) { atomicAdd(&(bar)[XB_TMO], 1u); break; } } } } while (0)

struct XcdBarrier {
    unsigned* bar; unsigned x;
    volatile LAS unsigned* st;
};

__device__ __forceinline__ XcdBarrier xcd_barrier_post(unsigned* bar, volatile LAS unsigned* st) {
    XcdBarrier b; b.bar = bar; b.x = xb_xcc_id(); b.st = st;
    if (threadIdx.x == 0) (void)xb_add(&bar[XB_XCNT(b.x)], 1u);
    return b;
}
__device__ __forceinline__ void xcd_barrier_complete(unsigned* bar, unsigned x, unsigned& nloc, unsigned& nx) {
    const unsigned G = gridDim.x * gridDim.y * gridDim.z;
    unsigned sum, cnt, mine, sp = 0u;
    for (;;) {
        sum = 0u; cnt = 0u; mine = 0u;
#pragma unroll
        for (unsigned j = 0; j < 16; ++j) { const unsigned c = xb_ld(&bar[XB_XCNT(j)]); sum += c; cnt += (c > 0u) ? 1u : 0u; mine = (j == x) ? c : mine; }
        if (sum == G) break;
        __builtin_amdgcn_s_sleep(1);
        if ((++sp & 255u) == 0u) { if (xb_ld(&bar[XB_TMO])) break; if (sp > XB_SPIN_CAP) { atomicAdd(&bar[XB_TMO], 1u); break; } }
    }
    nloc = mine > 0u ? mine : 1u; nx = cnt > 0u ? cnt : 1u;
}

__device__ __forceinline__ void xcd_barrier(const XcdBarrier& b, const int wave  ) {
    asm volatile("s_waitcnt vmcnt(0)" ::: "memory");
    __syncthreads();
    if (wave == 0 && lane_id_opaque() == 0) {
        unsigned* bar = b.bar;
        __builtin_amdgcn_s_waitcnt(0);
        unsigned nloc = b.st[0], nx = b.st[1];
        if (nloc == 0u) { xcd_barrier_complete(bar, b.x, nloc, nx); b.st[0] = nloc; b.st[1] = nx; }
        const unsigned old = xb_add(&bar[XB_XSUB(b.x)], 1u);
        const unsigned gen = old / nloc;
        if (old + 1u == (gen + 1u) * nloc) {
            __builtin_amdgcn_fence(__ATOMIC_RELEASE, "agent");
            asm volatile("s_waitcnt vmcnt(0)" ::: "memory");
            const unsigned og = xb_add(&bar[XB_TOP], 1u);
            const unsigned tg = og / nx;
            if (og + 1u == (tg + 1u) * nx) xb_add(&bar[XB_TOPGEN], 1u);
            else XB_SPIN(xb_ld(&bar[XB_TOPGEN]) == tg, bar);
            __builtin_amdgcn_fence(__ATOMIC_ACQUIRE, "agent");
            xb_add(&bar[XB_XGEN(b.x)], 1u);
            asm volatile("s_waitcnt vmcnt(0)" ::: "memory");
        } else {
            XB_SPIN(xb_ld(&bar[XB_XGEN(b.x)]) == gen, bar);
            __builtin_amdgcn_fence(__ATOMIC_ACQUIRE, "agent");
            asm volatile("s_waitcnt vmcnt(0)" ::: "memory");
        }
    }
    __syncthreads();
}

namespace scan {
typedef short bf16x8 __attribute__((ext_vector_type(8)));
typedef short bf16x4 __attribute__((ext_vector_type(4)));
typedef unsigned u32x2 __attribute__((ext_vector_type(2)));
constexpr int QT_STRIDE = 272, KT_STRIDE = 144, OB_STRIDE = 132;
constexpr int SC_QT = 0, SC_KH = 17408, SC_KTT = 34816, SC_VT = 53248, SC_P = 71680, SC_AL = 80896, SC_TW = 81408, SC_OB = 85504, SC_END = SC_OB + 64 * OB_STRIDE * 4;
static_assert(SC_END <= 131072, "scan LDS map");
constexpr size_t ST_ATOT = (size_t)256 * 16384;
__device__ __forceinline__ unsigned pkbf(float lo, float hi) { unsigned r; asm volatile("v_cvt_pk_bf16_f32 %0, %1, %2" : "=v"(r) : "v"(lo), "v"(hi)); return r; }
#define MFMA16(a, b, c) __builtin_amdgcn_mfma_f32_16x16x32_bf16((a), (b), (c), 0, 0, 0)

template <bool PHASE_A>
__device__ __forceinline__ void scan_unit(LAS unsigned char* lds, const int u, const int w, const int lane, const f16* __restrict__ QH, const f16* __restrict__ KH, const u16* __restrict__ VH,
                                          const f16* __restrict__ GH, const float* __restrict__ LF, const float* __restrict__ gnorm, float* __restrict__ ST, f16* __restrict__ OG) {
    const int bh = u >> 3, sc = u & 7, b = bh >> 4, h = bh & 15, fl = lane & 15, g = lane >> 4, tid = w * 64 + lane;
    const size_t tok0 = (size_t)b * SEQ + (size_t)sc * 512;
    const size_t eoff = (size_t)h * 128 + 2 * lane;
    LAS unsigned char* Qt = lds + SC_QT; LAS unsigned char* Kh = lds + SC_KH; LAS unsigned char* KtT = lds + SC_KTT; LAS unsigned char* VT = lds + SC_VT; LAS unsigned char* P = lds + SC_P;
    LAS float* AL = (LAS float*)(lds + SC_AL); LAS float* TW = (LAS float*)(lds + SC_TW); LAS float* OB = (LAS float*)(lds + SC_OB);
    f32x4 X[8];
    float* STu = ST + (size_t)u * 16384;
    if (PHASE_A) {
#pragma unroll
        for (int i = 0; i < 8; ++i) X[i] = (f32x4){0.f, 0.f, 0.f, 0.f};
    } else {
#pragma unroll
        for (int i = 0; i < 8; ++i)
#pragma unroll
            for (int r = 0; r < 4; ++r) X[i][r] = STu[(16 * i + 4 * g + r) * 128 + 16 * w + fl];
    }
    float cs0 = 0.f, cs1 = 0.f;
    unsigned rq[8], rk[8], rv[8]; f32x2 rl[8]; f16x8 rg0, rg1;
    const int et = tid >> 3, ees = (tid & 7) * 16;
#define SCAN_LOAD(c) do { _Pragma("unroll") for (int i = 0; i < 8; ++i) { const size_t o = (tok0 + (size_t)(c) * 64 + 8 * w + i) * DM + eoff; \
        if (!PHASE_A) rq[i] = *(const unsigned*)(QH + o); rk[i] = *(const unsigned*)(KH + o); rv[i] = *(const unsigned*)(VH + o); rl[i] = *(const f32x2*)(LF + o); } } while (0)
#define SCAN_LOAD_G(c) do { if (!PHASE_A) { const size_t go = (tok0 + (size_t)(c) * 64 + et) * DM + (size_t)h * 128 + ees; rg0 = *(const f16x8*)(GH + go); rg1 = *(const f16x8*)(GH + go + 8); } } while (0)
    SCAN_LOAD(0); SCAN_LOAD_G(0);
    for (int c = 0; c < 8; ++c) {
        { float r0 = 0.f, r1 = 0.f;
#pragma unroll
            for (int i = 0; i < 8; ++i) { r0 += rl[i].x; r1 += rl[i].y; }
            *(LAS f32x2*)(TW + w * 128 + 2 * lane) = (f32x2){r0, r1}; }
        __syncthreads();
        float off0 = 0.f, off1 = 0.f, tot0 = 0.f, tot1 = 0.f;
#pragma unroll
        for (int ww = 0; ww < 8; ++ww) { const f32x2 t = *(const LAS f32x2*)(TW + ww * 128 + 2 * lane); if (ww < w) { off0 += t.x; off1 += t.y; } tot0 += t.x; tot1 += t.y; }
        unsigned kt0[4], kt1[4], vt0[4], vt1[4]; float cu0 = off0, cu1 = off1;
#pragma unroll
        for (int i = 0; i < 8; ++i) {
            cu0 += rl[i].x; cu1 += rl[i].y;
            const f16x2 kk = __builtin_bit_cast(f16x2, rk[i]); const float k0 = (float)kk[0], k1 = (float)kk[1];
            const float t0 = k0 * __expf(tot0 - cu0), t1 = k1 * __expf(tot1 - cu1);
            if (!PHASE_A) {
                const f16x2 qq = __builtin_bit_cast(f16x2, rq[i]);
                *(LAS unsigned*)(Qt + (8 * w + i) * QT_STRIDE + 4 * lane) = pkbf((float)qq[0] * __expf(cu0), (float)qq[1] * __expf(cu1));
                *(LAS unsigned*)(Kh + (8 * w + i) * QT_STRIDE + 4 * lane) = pkbf(k0 * __expf(-cu0), k1 * __expf(-cu1));
            }
            if (i & 1) { kt0[i >> 1] |= (pkbf(t0, 0.f) << 16); kt1[i >> 1] |= (pkbf(t1, 0.f) << 16); vt0[i >> 1] |= (rv[i] << 16); vt1[i >> 1] |= (rv[i] & 0xffff0000u); }
            else { kt0[i >> 1] = pkbf(t0, 0.f) & 0xffffu; kt1[i >> 1] = pkbf(t1, 0.f) & 0xffffu; vt0[i >> 1] = rv[i] & 0xffffu; vt1[i >> 1] = rv[i] >> 16; }
        }
        *(LAS u32x4*)(KtT + (2 * lane) * KT_STRIDE + 16 * w) = (u32x4){kt0[0], kt0[1], kt0[2], kt0[3]};
        *(LAS u32x4*)(KtT + (2 * lane + 1) * KT_STRIDE + 16 * w) = (u32x4){kt1[0], kt1[1], kt1[2], kt1[3]};
        *(LAS u32x4*)(VT + (2 * lane) * KT_STRIDE + 16 * w) = (u32x4){vt0[0], vt0[1], vt0[2], vt0[3]};
        *(LAS u32x4*)(VT + (2 * lane + 1) * KT_STRIDE + 16 * w) = (u32x4){vt1[0], vt1[1], vt1[2], vt1[3]};
        if (w == 0) *(LAS f32x2*)(AL + 2 * lane) = (f32x2){__expf(tot0), __expf(tot1)};
        cs0 += tot0; cs1 += tot1;
        if (c + 1 < 8) SCAN_LOAD(c + 1);
        __syncthreads();
        f32x4 Y[4];
        if (!PHASE_A) {
            const int ti = w >> 1;
#pragma unroll
            for (int sx = 0; sx < 2; ++sx) { const int si = 2 * (w & 1) + sx; f32x4 z = {0.f, 0.f, 0.f, 0.f};
                if (si <= ti) {
#pragma unroll
                    for (int kd = 0; kd < 4; ++kd) { const bf16x8 a = *(const LAS bf16x8*)(Kh + (16 * si + fl) * QT_STRIDE + (32 * kd + 8 * g) * 2), bq = *(const LAS bf16x8*)(Qt + (16 * ti + fl) * QT_STRIDE + (32 * kd + 8 * g) * 2);
                        z = MFMA16(a, bq, z); }
                    const int t = 16 * ti + fl, s0 = 16 * si + 4 * g;
#pragma unroll
                    for (int r = 0; r < 4; ++r) z[r] = (s0 + r <= t) ? z[r] : 0.f;
                }
                *(LAS u32x2*)(P + (16 * ti + fl) * KT_STRIDE + (16 * si + 4 * g) * 2) = (u32x2){pkbf(z[0], z[1]), pkbf(z[2], z[3])}; }
#pragma unroll
            for (int jt = 0; jt < 4; ++jt) Y[jt] = (f32x4){0.f, 0.f, 0.f, 0.f};
#pragma unroll
            for (int i = 0; i < 4; ++i) { const u32x4 aw = {pkbf(X[2 * i][0], X[2 * i][1]), pkbf(X[2 * i][2], X[2 * i][3]), pkbf(X[2 * i + 1][0], X[2 * i + 1][1]), pkbf(X[2 * i + 1][2], X[2 * i + 1][3])};
                const bf16x8 af = __builtin_bit_cast(bf16x8, aw);
#pragma unroll
                for (int jt = 0; jt < 4; ++jt) { const u32x2 lo = *(const LAS u32x2*)(Qt + (16 * jt + fl) * QT_STRIDE + (32 * i + 4 * g) * 2), hi = *(const LAS u32x2*)(Qt + (16 * jt + fl) * QT_STRIDE + (32 * i + 16 + 4 * g) * 2);
                    const u32x4 bw = {lo.x, lo.y, hi.x, hi.y}; Y[jt] = MFMA16(af, __builtin_bit_cast(bf16x8, bw), Y[jt]); } }
            __syncthreads();
        }
        bf16x8 vf[2];
#pragma unroll
        for (int ks = 0; ks < 2; ++ks) vf[ks] = *(const LAS bf16x8*)(VT + (16 * w + fl) * KT_STRIDE + (32 * ks + 8 * g) * 2);
        if (!PHASE_A) {
#pragma unroll
            for (int jt = 0; jt < 4; ++jt)
#pragma unroll
                for (int ks = 0; ks < 2; ++ks) if (32 * ks <= 16 * jt + 15) { const bf16x8 pf = *(const LAS bf16x8*)(P + (16 * jt + fl) * KT_STRIDE + (32 * ks + 8 * g) * 2); Y[jt] = MFMA16(vf[ks], pf, Y[jt]); }
#pragma unroll
            for (int jt = 0; jt < 4; ++jt) *(LAS f32x4*)(OB + (16 * jt + fl) * OB_STRIDE + 16 * w + 4 * g) = Y[jt];
        }
#pragma unroll
        for (int i = 0; i < 8; ++i) { X[i] = X[i] * *(const LAS f32x4*)(AL + 16 * i + 4 * g);
#pragma unroll
            for (int ks = 0; ks < 2; ++ks) { const bf16x8 a = *(const LAS bf16x8*)(KtT + (16 * i + fl) * KT_STRIDE + (32 * ks + 8 * g) * 2); X[i] = MFMA16(a, vf[ks], X[i]); } }
        __syncthreads();
        if (!PHASE_A) {
            const int t = et, es = ees; f32x4 o[4]; float ss = 0.f;
#pragma unroll
            for (int q = 0; q < 4; ++q) { o[q] = *(const LAS f32x4*)(OB + t * OB_STRIDE + es + 4 * q); ss += (o[q][0] * o[q][0] + o[q][1] * o[q][1]) + (o[q][2] * o[q][2] + o[q][3] * o[q][3]); }
            ss += __shfl_xor(ss, 1); ss += __shfl_xor(ss, 2); ss += __shfl_xor(ss, 4);
            const float rstd = rsqrtf(ss * (1.f / 128.f) + EPS);
            const size_t ro = (tok0 + (size_t)c * 64 + t) * DM + (size_t)h * 128 + es;
            f32x4 r[4];
#pragma unroll
            for (int q = 0; q < 4; ++q) { const f32x4 gn = *(const f32x4*)(gnorm + es + 4 * q);
#pragma unroll
                for (int j = 0; j < 4; ++j) r[q][j] = o[q][j] * rstd * gn[j] * (float)(q < 2 ? rg0[4 * q + j] : rg1[4 * (q - 2) + j]); }
            *(u32x4*)(OG + ro) = op_pk8(r[0], r[1]); *(u32x4*)(OG + ro + 8) = op_pk8(r[2], r[3]);
            if (c + 1 < 8) SCAN_LOAD_G(c + 1);
        }
    }
#undef SCAN_LOAD
#undef SCAN_LOAD_G
    if (PHASE_A) {
#pragma unroll
        for (int i = 0; i < 8; ++i)
#pragma unroll
            for (int r = 0; r < 4; ++r) STu[(16 * i + 4 * g + r) * 128 + 16 * w + fl] = X[i][r];
        if (w == 0) *(f32x2*)(ST + ST_ATOT + (size_t)u * 128 + 2 * lane) = (f32x2){__expf(cs0), __expf(cs1)};
    }
    __syncthreads();
}
__device__ __forceinline__ void scan_carry(float* __restrict__ ST, const int gtid, const int nthreads) {
    for (int i = gtid; i < 32 * 4096; i += nthreads) {
        const int bh = i >> 12, q = i & 4095, d = q >> 5;
        f32x4 s = {0.f, 0.f, 0.f, 0.f};
#pragma unroll
        for (int sc = 0; sc < 8; ++sc) { f32x4* p = (f32x4*)(ST + (size_t)(bh * 8 + sc) * 16384) + q;
            if (sc < 7) { const f32x4 l = *p; const float a = ST[ST_ATOT + (size_t)(bh * 8 + sc) * 128 + d]; *p = s; s = s * a + l; } else *p = s; }
    }
}
#undef MFMA16
}

namespace attn {
constexpr int D = 128;
constexpr float THR = 8.f;
constexpr bool WSKIP = false;
constexpr int OSTRIDE = DM;
constexpr float SCALE = 0.08838834764831845f;
constexpr int NW = 8, QBLK = 32, KVBLK = 64, QB = NW * QBLK;
constexpr int SHM_V = KVBLK * D * 2, SHM_K = KVBLK * D * 2;
constexpr int LDS_BYTES = 2 * SHM_V + 2 * SHM_K + NW * 96 * 4;
using bf16 = _Float16;
typedef short s16x8 __attribute__((ext_vector_type(8)));
typedef _Float16 bf16x8 __attribute__((ext_vector_type(8)));
typedef short s16x4 __attribute__((ext_vector_type(4)));
typedef float f32x16 __attribute__((ext_vector_type(16)));
template <class A, class Bt> struct same_t { static constexpr bool v = false; };
template <class A> struct same_t<A, A> { static constexpr bool v = true; };

#define KSWZ(row, colB) ((row) * 256 + ((colB) ^ (((row) & 7) << 4)))
#define SBAR() __builtin_amdgcn_sched_barrier(0)
__device__ __forceinline__ int v_st(int k, int c) { const int kk = (k & ~0xC) | ((k & 4) << 1) | ((k & 8) >> 1); return ((kk >> 3) * 4 + (c >> 5)) * 512 + ((kk & 7) * 32 + (c & 31)) * 2; }
__device__ __forceinline__ int v_rd_base(int lane) { return ((lane & 3) << 3) | (((lane >> 2) & 3) << 6) | (((lane >> 4) & 1) << 5) | (((lane >> 5) & 1) << 8); }
constexpr int v_rd_off(int d0, int ks, int half) { return d0 * 512 + ks * 4096 + half * 2048; }
__device__ __forceinline__ int crow(int r, int hi) { return (r & 3) + 8 * (r >> 2) + 4 * hi; }
__device__ __forceinline__ unsigned cvtpk(float lo, float hi) {
    unsigned r; asm volatile("v_cvt_pk_f16_f32 %0, %1, %2" : "=v"(r) : "v"(lo), "v"(hi)); return r;
}
__device__ __forceinline__ bf16x8 pack8(f32x4 a, f32x4 b) {
    u32x4 w = {cvtpk(a[0], a[1]), cvtpk(a[2], a[3]), cvtpk(b[0], b[1]), cvtpk(b[2], b[3])};
    return *reinterpret_cast<bf16x8*>(&w);
}
template <class T> __device__ __forceinline__ bf16x8 load8(const T* p) {
    if constexpr (same_t<T, float>::v) { return pack8(*(const f32x4*)p, *(const f32x4*)(p + 4)); }
    else { return *reinterpret_cast<const bf16x8*>(p); }
}
__device__ __forceinline__ void mask_tile(f32x16& p0, f32x16& p1, int dq, unsigned W) {
    const float NEG = -__builtin_inff();
#pragma unroll
    for (int r = 0; r < 16; ++r) {
        const int c = (r & 3) + 8 * (r >> 2);
        if ((unsigned)(dq - c) >= W) p0[r] = NEG;
        if ((unsigned)(dq - c - 32) >= W) p1[r] = NEG;
    }
}
__device__ __forceinline__ void partialSM(f32x16& p0, f32x16& p1, float& m_reg, float& mn, float& alpha, const bool rowok = true) {
    float pmax = p0[0]; for (int r = 1; r < 16; ++r) pmax = fmaxf(pmax, p0[r]); for (int r = 0; r < 16; ++r) pmax = fmaxf(pmax, p1[r]);
    { auto rr = __builtin_amdgcn_permlane32_swap(__float_as_uint(pmax), __float_as_uint(pmax), false, false);
      pmax = fmaxf(__uint_as_float(rr[0]), __uint_as_float(rr[1])); }
    pmax = rowok ? pmax : -__builtin_inff();
    constexpr float C2 = 1.4426950408889634f * SCALE;
    if (__builtin_expect(__all((pmax - m_reg) * SCALE <= THR), 1)) { mn = m_reg; alpha = 1.f; }
    else { mn = fmaxf(m_reg, pmax); alpha = __builtin_amdgcn_exp2f((m_reg - mn) * C2); m_reg = mn; }
    const float mnL = rowok ? -mn * C2 : -__builtin_inff();
    for (int r = 0; r < 16; ++r) p0[r] = fmaf(p0[r], C2, mnL); for (int r = 0; r < 16; ++r) p1[r] = fmaf(p1[r], C2, mnL);
    for (int r = 0; r < 16; ++r) p0[r] = __builtin_amdgcn_exp2f(p0[r]);
}
__device__ __forceinline__ void finishSM(f32x16& p0, f32x16& p1, float alpha, float& l_reg, bf16x8& pa0, bf16x8& pa1, bf16x8& pa2, bf16x8& pa3) {
    for (int r = 0; r < 16; ++r) p1[r] = __builtin_amdgcn_exp2f(p1[r]);
    float ps = 0; for (int r = 0; r < 16; ++r) ps += p0[r]; for (int r = 0; r < 16; ++r) ps += p1[r];
    { auto rr = __builtin_amdgcn_permlane32_swap(__float_as_uint(ps), __float_as_uint(ps), false, false);
      ps = __uint_as_float(rr[0]) + __uint_as_float(rr[1]); }
    l_reg = l_reg * alpha + ps;
#define PK4(P, B_, OUT) do { unsigned a0 = cvtpk(P[B_+0], P[B_+1]), a1 = cvtpk(P[B_+2], P[B_+3]);                          \
        unsigned b0 = cvtpk(P[B_+4], P[B_+5]), b1 = cvtpk(P[B_+6], P[B_+7]);                                             \
        auto r0 = __builtin_amdgcn_permlane32_swap(a0, b0, false, false); auto r1 = __builtin_amdgcn_permlane32_swap(a1, b1, false, false); \
        u32x4 w = {r0[0], r1[0], r0[1], r1[1]}; OUT = *reinterpret_cast<bf16x8*>(&w); } while (0)
    PK4(p0, 0, pa0); PK4(p0, 8, pa1); PK4(p1, 0, pa2); PK4(p1, 8, pa3);
#undef PK4
}
template <int KB, bool SK>
__device__ __forceinline__ void qkt(f32x16& p0, f32x16& p1, const char* K_lds, int r32, int hi, const bf16x8* qr, bool act) {
    if (SK && !act) { const float NEG = -__builtin_inff();
#pragma unroll
        for (int r = 0; r < 16; ++r) { p0[r] = NEG; p1[r] = NEG; } return; }
    p0 = f32x16{}; p1 = f32x16{};
    const char* kb[4];
#pragma unroll
    for (int dd = 0; dd < 4; ++dd) kb[dd] = K_lds + KB * SHM_K + KSWZ(r32, (dd * 16 + hi * 8) * 2);
#pragma unroll
    for (int d0 = 0; d0 < 8; ++d0) { const char* a = kb[d0 & 3] + (d0 >> 2) * 128;
        bf16x8 b0 = *reinterpret_cast<const bf16x8*>(a);
        bf16x8 b1 = *reinterpret_cast<const bf16x8*>(a + 32 * 256);
        p0 = __builtin_amdgcn_mfma_f32_32x32x16_f16(b0, qr[d0], p0, 0, 0, 0);
        p1 = __builtin_amdgcn_mfma_f32_32x32x16_f16(b1, qr[d0], p1, 0, 0, 0); }
}
template <int VB, bool SK>
__device__ __forceinline__ void pv_tile(f32x16* o, int vb0, bf16x8 pa0, bf16x8 pa1, bf16x8 pa2, bf16x8 pa3, bool act) {
    if (SK && !act) return;
#define TRRD(dst, off) asm volatile("ds_read_b64_tr_b16 %0, %1 offset:%2" : "=&v"(dst) : "v"(vb0), "i"(off) : "memory")
#define PV_D0(d0) do { s16x4 l0, l1, l2, l3, h0, h1, h2, h3; constexpr int b_ = VB * SHM_V + v_rd_off(d0, 0, 0);     \
        TRRD(l0, b_); TRRD(h0, b_ + 2048); TRRD(l1, b_ + 4096); TRRD(h1, b_ + 6144); TRRD(l2, b_ + 8192); TRRD(h2, b_ + 10240); TRRD(l3, b_ + 12288); TRRD(h3, b_ + 14336); \
        asm volatile("s_waitcnt lgkmcnt(0)" ::: "memory"); SBAR();                 \
        o[d0] = __builtin_amdgcn_mfma_f32_32x32x16_f16(pa0, __builtin_bit_cast(bf16x8, (s16x8){l0[0], l0[1], l0[2], l0[3], h0[0], h0[1], h0[2], h0[3]}), o[d0], 0, 0, 0);   \
        o[d0] = __builtin_amdgcn_mfma_f32_32x32x16_f16(pa1, __builtin_bit_cast(bf16x8, (s16x8){l1[0], l1[1], l1[2], l1[3], h1[0], h1[1], h1[2], h1[3]}), o[d0], 0, 0, 0);   \
        o[d0] = __builtin_amdgcn_mfma_f32_32x32x16_f16(pa2, __builtin_bit_cast(bf16x8, (s16x8){l2[0], l2[1], l2[2], l2[3], h2[0], h2[1], h2[2], h2[3]}), o[d0], 0, 0, 0);   \
        o[d0] = __builtin_amdgcn_mfma_f32_32x32x16_f16(pa3, __builtin_bit_cast(bf16x8, (s16x8){l3[0], l3[1], l3[2], l3[3], h3[0], h3[1], h3[2], h3[3]}), o[d0], 0, 0, 0); } while (0)
    PV_D0(0); PV_D0(1); PV_D0(2); PV_D0(3);
#undef PV_D0
#undef TRRD
}

template <class TIn, class TOut> struct BlockRef { const TIn* Q; const TIn* K; const TIn* V; TOut* O; int P0; const float* KM; int own; };
template <class TIn> struct Seam {
    bf16x8 qr[8];
    bf16x8 st_v0, st_v1, st_k0, st_k1; f32x4 sf0, sf1, sf2, sf3;
    f32x4 tq[16];
};
__device__ __forceinline__ int swa_jlo(int P0, int W) { const int lowk = P0 - W + 1; return lowk > 0 ? lowk / KVBLK : 0; }
#define ROW(p, k0, rr) ((p) + (size_t)((k0) + (rr)) * D + sc)
#define VMW() asm volatile("s_waitcnt vmcnt(0)" ::: "memory")
#define VMWN(n) asm volatile("s_waitcnt vmcnt(%0)" :: "i"(n) : "memory")
#define SLOAD_H(Kp, Vp, k0) do { S.st_v0 = load8<TIn>(ROW(Vp, k0, sr)); S.st_v1 = load8<TIn>(ROW(Vp, k0, 32 + sr));              \
                         S.st_k0 = load8<TIn>(ROW(Kp, k0, sr)); S.st_k1 = load8<TIn>(ROW(Kp, k0, 32 + sr)); } while (0)
#define SWRITE_HK(bf) do { *(bf16x8*)(K_lds + (bf) * SHM_K + kws) = S.st_k0; *(bf16x8*)(K_lds + (bf) * SHM_K + kws + 32 * 256) = S.st_k1; } while (0)
#define SWRITE_HV(bf) do { *(bf16x8*)(V_lds + (bf) * SHM_V + vst0) = S.st_v0; *(bf16x8*)(V_lds + (bf) * SHM_V + vst1) = S.st_v1; } while (0)
#define SWRITE_H(bf) do { SWRITE_HV(bf); SWRITE_HK(bf); } while (0)
#define SLOAD_F(p, k0) do { S.sf0 = *(const f32x4*)ROW(p, k0, sr); S.sf1 = *(const f32x4*)(ROW(p, k0, sr) + 4);                \
                            S.sf2 = *(const f32x4*)ROW(p, k0, 32 + sr); S.sf3 = *(const f32x4*)(ROW(p, k0, 32 + sr) + 4); } while (0)
#define SWRITE_KF(bf) do { *(bf16x8*)(K_lds + (bf) * SHM_K + kws) = pack8(S.sf0, S.sf1); *(bf16x8*)(K_lds + (bf) * SHM_K + kws + 32 * 256) = pack8(S.sf2, S.sf3); } while (0)
#define SWRITE_VF(bf) do { *(bf16x8*)(V_lds + (bf) * SHM_V + vst0) = pack8(S.sf0, S.sf1); *(bf16x8*)(V_lds + (bf) * SHM_V + vst1) = pack8(S.sf2, S.sf3); } while (0)
template <class TIn, class TOut>
__device__ __forceinline__ void causal_swa_prime(const BlockRef<TIn, TOut>& cur, char* lds, Seam<TIn>& S, const int wid) {
    constexpr bool F32 = same_t<TIn, float>::v;
    const int lane = lane_id_opaque(), tid = wid * 64 + lane, r32 = lane & 31, hi = lane >> 5;
    const int sr = tid >> 4, sc = (tid & 15) * 8, kws = KSWZ(sr, sc * 2); char* K_lds = lds + 2 * SHM_V;
    const int kb0 = 0;
    for (int d0 = 0; d0 < 8; ++d0) S.qr[d0] = load8<TIn>(cur.Q + (size_t)(wid * QBLK + r32) * D + d0 * 16 + hi * 8);
    if constexpr (F32) { SLOAD_F((const float*)cur.K, kb0); VMW(); SWRITE_KF(0); SBAR(); SLOAD_F((const float*)cur.V, kb0); }
    else { SLOAD_H(cur.K, cur.V, kb0); VMW(); SWRITE_HK(0); }
    __syncthreads();
}
template <class TIn, class TOut>
__device__ __forceinline__ void causal_swa_block(const BlockRef<TIn, TOut>& cur, const BlockRef<TIn, TOut>& nxt, int skv, char* lds, Seam<TIn>& S, const int wid) {
    constexpr bool F32 = same_t<TIn, float>::v;
    const int lane = lane_id_opaque(), tid = wid * 64 + lane, r32 = lane & 31, hi = lane >> 5;
    const int j_lo = 0, own = cur.own; constexpr int W = 0x7fffffff;
    int j_hi = (cur.P0 + QB - 1) / KVBLK + 1; if (j_hi > skv / KVBLK) j_hi = skv / KVBLK;
    const int NT = j_hi - j_lo;
    const int kbn = 0;
    const int qlo = cur.P0 + wid * QBLK, qm = qlo + r32 - 4 * hi;
    char* V_lds = lds; char* K_lds = lds + 2 * SHM_V;
    float* ws = (float*)(lds + 2 * SHM_V + 2 * SHM_K) + wid * 96; float* li_l = ws, * al_l = ws + 32; unsigned* sel_l = (unsigned*)(ws + 64);
    float m_reg = -1e30f, l_reg = 0; f32x16 o[4] = {};
    const int sr = tid >> 4, sc = (tid & 15) * 8, vst0 = v_st(sr, sc), vst1 = v_st(32 + sr, sc), kws = KSWZ(sr, sc * 2);
    const int vb0 = (int)(uintptr_t)V_lds + v_rd_base(lane);
    const TIn* Kh = cur.K; const TIn* Vh = cur.V;
#define RESC(a) do { if (__any((a) < 1.f)) { if (hi == 0) al_l[r32] = (a); asm volatile("s_waitcnt lgkmcnt(0)" ::: "memory");              \
                     for (int d_ = 0; d_ < 4; ++d_) for (int r = 0; r < 16; ++r) o[d_][r] *= al_l[crow(r, hi)]; } } while (0)
#define KBASE(t) ((j_lo + (t)) * KVBLK)
#define ACT(t) (KBASE(t) <= qlo + QBLK - 1 && KBASE(t) + KVBLK - 1 >= qlo - W + 1)
#define MASKT(P0_, P1_, t) do { const int kb_ = KBASE(t); if ((((t) >> 2) == own) && (kb_ + KVBLK - 1 > qlo)) mask_tile(P0_, P1_, qm - kb_, (unsigned)W); } while (0)
#define ROWOK(t) ((((t) >> 2) == own) || ((sel_l[r32] >> ((t) >> 2)) & 1u))
    constexpr int NQL = F32 ? 16 : 8;
    constexpr bool SK = WSKIP && !F32;
#define SEAM_K0() do { VMWN(NQL); if constexpr (F32) { SWRITE_KF(0); SBAR(); SLOAD_F((const float*)nxt.V, kbn); } else { SWRITE_HK(0); } SBAR(); } while (0)
    f32x16 pA0, pA1, pB0, pB1; float mnA, mnB, alA, alB; bf16x8 pa0, pa1, pa2, pa3;
    { f32x16 pg = {};
      const int jg = (r32 & 3) + 4 * (r32 >> 3); const bool live = (r32 & 4) == 0;
#pragma unroll
      for (int d0 = 0; d0 < 8; ++d0) { f32x4 a = {0.f, 0.f, 0.f, 0.f}, b2 = a;
          if (live) { a = *(const f32x4*)(cur.KM + jg * 128 + d0 * 16 + hi * 8); b2 = *(const f32x4*)(cur.KM + jg * 128 + d0 * 16 + hi * 8 + 4); }
          pg = __builtin_amdgcn_mfma_f32_32x32x16_f16(pack8(a, b2), S.qr[d0], pg, 0, 0, 0); }
      unsigned sel = 0u;
#pragma unroll
      for (int rep_ = 0; rep_ < 3; ++rep_) { float best = -__builtin_inff(); int bi = -1;
#pragma unroll
          for (int j = 0; j < 16; ++j) { const bool ok = (j < own) && !((sel >> j) & 1u) && (pg[j] > best); best = ok ? pg[j] : best; bi = ok ? j : bi; }
          if (bi >= 0) sel |= 1u << bi; }
      if (hi == 0) sel_l[r32] = sel;
      asm volatile("s_waitcnt lgkmcnt(0)" ::: "memory"); }
    if constexpr (F32) { VMW(); SWRITE_VF(0); SBAR(); } else { SWRITE_HV(0); SBAR(); }
    if (NT > 1) { if constexpr (F32) SLOAD_F((const float*)Kh, KBASE(1)); else SLOAD_H(Kh, Vh, KBASE(1)); }
    SBAR(); qkt<0, SK>(pA0, pA1, K_lds, r32, hi, S.qr, ACT(0));
    if constexpr (F32) { if (NT > 1) { VMW(); SWRITE_KF(1); SBAR(); SLOAD_F((const float*)Vh, KBASE(1)); } }
    MASKT(pA0, pA1, 0); partialSM(pA0, pA1, m_reg, mnA, alA, ROWOK(0));
    if (NT > 1) { VMW(); if constexpr (F32) { SWRITE_VF(1); SBAR(); if (NT > 2) SLOAD_F((const float*)Kh, KBASE(2)); } else SWRITE_H(1); }
    __syncthreads();
#define HALF_STEP(PX0, PX1, mnX, alX, PY0, PY1, alY, t, KB, VB, SB) do {                                                      \
        SBAR(); qkt<KB, SK>(PX0, PX1, K_lds, r32, hi, S.qr, ACT(t));                                             \
        finishSM(PY0, PY1, alY, l_reg, pa0, pa1, pa2, pa3); SBAR();                                                           \
        if ((t) + 1 < NT) { if constexpr (F32) { VMW(); SWRITE_KF(SB); SBAR(); SLOAD_F((const float*)Vh, KBASE((t) + 1)); }  \
                            else { SLOAD_H(Kh, Vh, KBASE((t) + 1)); } SBAR(); }                                               \
        pv_tile<VB, SK>(o, vb0, pa0, pa1, pa2, pa3, ACT((t) - 1)); MASKT(PX0, PX1, (t)); partialSM(PX0, PX1, m_reg, mnX, alX, ROWOK((t)));                                        \
        __syncthreads();                                                                                                      \
        if ((t) + 1 < NT) { VMW(); if constexpr (F32) { SWRITE_VF(SB); SBAR(); if ((t) + 2 < NT) SLOAD_F((const float*)Kh, KBASE((t) + 2)); } \
                            else { SWRITE_H(SB); } }                                                                          \
        RESC(alX); __syncthreads(); } while (0)
    for (int t = 1; t + 1 < NT; t += 2) {
        HALF_STEP(pB0, pB1, mnB, alB, pA0, pA1, alA, t, 1, 0, 0);
        HALF_STEP(pA0, pA1, mnA, alA, pB0, pB1, alB, t + 1, 0, 1, 1);
    }
    const bool even = (NT & 1) == 0;
    if (even) { SBAR(); qkt<1, SK>(pB0, pB1, K_lds, r32, hi, S.qr, ACT(NT - 1)); SBAR(); }
#define QROW(e) (nxt.Q + (size_t)(wid * QBLK + r32) * D + ((e) >> 1) * 16 + hi * 8 + ((e) & 1) * 4)
    if constexpr (F32) { SLOAD_F((const float*)nxt.K, kbn); SBAR();
#pragma unroll
        for (int e = 0; e < 8; ++e) S.tq[e] = *(const f32x4*)QROW(e); }
    else { SLOAD_H(nxt.K, nxt.V, kbn); SBAR();
#pragma unroll
        for (int d0 = 0; d0 < 8; ++d0) S.qr[d0] = load8<TIn>(nxt.Q + (size_t)(wid * QBLK + r32) * D + d0 * 16 + hi * 8); }
    SBAR();
    finishSM(pA0, pA1, alA, l_reg, pa0, pa1, pa2, pa3); SBAR();
    if constexpr (F32) {
#pragma unroll
        for (int e = 8; e < 16; ++e) S.tq[e] = *(const f32x4*)QROW(e); SBAR(); }
#undef QROW
    pv_tile<0, SK>(o, vb0, pa0, pa1, pa2, pa3, ACT(even ? NT - 2 : NT - 1));
    if (even) { MASKT(pB0, pB1, NT - 1); partialSM(pB0, pB1, m_reg, mnB, alB, ROWOK(NT - 1)); __syncthreads(); RESC(alB);
        finishSM(pB0, pB1, alB, l_reg, pa0, pa1, pa2, pa3); SBAR(); pv_tile<1, SK>(o, vb0, pa0, pa1, pa2, pa3, ACT(NT - 1)); }
    SBAR(); SEAM_K0();
    if (hi == 0) li_l[r32] = l_reg; asm volatile("s_waitcnt lgkmcnt(0)" ::: "memory");
    float rli[16];
#pragma unroll
    for (int r = 0; r < 16; ++r) rli[r] = __builtin_amdgcn_rcpf(li_l[crow(r, hi)]);
    TOut* Ow = cur.O + (size_t)(wid * QBLK) * OSTRIDE;
#pragma unroll
    for (int r = 0; r < 16; ++r) { const int orow = crow(r, hi);
#pragma unroll
        for (int d0 = 0; d0 < 4; ++d0) { const float v = o[d0][r] * rli[r];
            if constexpr (same_t<TOut, float>::v) { Ow[(size_t)orow * OSTRIDE + d0 * 32 + r32] = v; }
            else { const float vn = __shfl_xor(v, 1);
                   if ((r32 & 1) == 0) *(unsigned*)(Ow + (size_t)orow * OSTRIDE + d0 * 32 + r32) = op_pk2(v, vn); } } }
    if constexpr (F32) {
#pragma unroll
        for (int d0 = 0; d0 < 8; ++d0) S.qr[d0] = pack8(S.tq[2 * d0], S.tq[2 * d0 + 1]); }
    __syncthreads();
#undef RESC
#undef KBASE
#undef ACT
#undef MASKT
#undef ROWOK
#undef SEAM_K0
#undef HALF_STEP
}
#undef ROW
#undef VMW
#undef VMWN
#undef SLOAD_H
#undef SWRITE_HK
#undef SWRITE_HV
#undef SWRITE_H
#undef SLOAD_F
#undef SWRITE_KF
#undef SWRITE_VF
__device__ __forceinline__ BlockRef<f16, f16> moba_ref(const int L, const int pass, const f16* Q, const f16* K, const f16* V, const float* KM, f16* O) {
    const int grp = L >> 5, hq = (L >> 3) & 3, y = L & 7, b = grp >> 2, kvh = grp & 3, h = kvh * 4 + hq, qb = pass ? 15 - y : y;
    BlockRef<f16, f16> r;
    r.Q = Q + ((size_t)(b * NH + h) * SEQ + (size_t)qb * QB) * D; r.K = K + (size_t)(b * NKV + kvh) * SEQ * D; r.V = V + (size_t)(b * NKV + kvh) * SEQ * D;
    r.O = O + ((size_t)b * SEQ + (size_t)qb * QB) * OSTRIDE + h * D; r.P0 = qb * QB; r.KM = KM + (size_t)(b * NKV + kvh) * NBLK * D; r.own = qb;
    return r;
}
__device__ __forceinline__ void moba_phase(char* lds, const int wid, const int vcu, const int G, const f16* Q, const f16* K, const f16* V, const float* KM, f16* O) {
    constexpr int total = BATCH * NH * (NBLK / 2);
    int L = vcu; if (L >= total) return;
    int pass = 0;
    BlockRef<f16, f16> cur = moba_ref(L, 0, Q, K, V, KM, O);
    Seam<f16> S;
    causal_swa_prime<f16, f16>(cur, lds, S, wid);
    for (;;) {
        const bool more_pass = pass == 0, more_item = L + G < total, last = !more_pass && !more_item;
        int passn = pass + 1, Ln = L;
        if (!more_pass) { passn = 0; Ln = more_item ? L + G : L; }
        const BlockRef<f16, f16> nxt = last ? cur : moba_ref(Ln, passn, Q, K, V, KM, O);
        causal_swa_block<f16, f16>(cur, nxt, SEQ, lds, S, wid);
        if (last) break;
        cur = nxt; pass = passn; L = Ln;
    }
}
}

constexpr int NWAVES = 8;
constexpr int RING_BYTES = 131072, LDSCTL_OFF = RING_BYTES, MISC_OFF = LDSCTL_OFF + 320, LDS_BYTES = 147456;
constexpr size_t W16_GU = 0, W16_GU_SZ = (size_t)2 * FF * DM, W16_DN = 4 * W16_GU_SZ, W16_DN_SZ = (size_t)DM * FF, W16_IN = W16_DN + 4 * W16_DN_SZ, W16_OUT = W16_IN + (size_t)4 * DM * DM,
                 W16_KV = W16_OUT + (size_t)DM * DM, W16_Q = W16_KV + (size_t)1024 * DM, W16_O = W16_Q + (size_t)DM * DM, W16_END = W16_O + (size_t)DM * DM;
static_assert(WS_W16 + W16_END * 2 <= WS_END, "fp16 weights fit");
enum { PC_PRO = 0, PC_NORM0 = 1, PC_S0_FA = 2, PC_S0_FB = 3, PC_S0_NF = 4, PC_HG = 5, PC_SA = 6, PC_SB = 7, PC_SC = 8, PC_HO = 9, PC_NM0 = 10, PC_S1_FA = 11, PC_S1_FB = 12, PC_S1_NF = 13,
       PC_KV = 14, PC_S2_FA = 15, PC_S2_FB = 16, PC_S2_NF = 17, PC_QP = 18, PC_AT = 19, PC_OP = 20, PC_NM1 = 21, PC_S3_FA = 22, PC_S3_FB = 23, PC_S3_NF = 24, PC_END = 25 };

struct MegaArgs { const float* in[16]; float* out; unsigned char* ws; int lo, hi; };

enum { MAP_NAT = 0, MAP_SWIGLU = 1, MAP_ROT = 2 };
__device__ __forceinline__ int map_col(int kind, int nrot_rows, int n) {
    if (kind == MAP_SWIGLU) return ((n >> 7) & 1) * FF + (n >> 8) * 128 + (n & 127);
    if (kind == MAP_ROT && n < nrot_rows) return (2 * (n >> 8) + ((n >> 6) & 1)) * 128 + ((n >> 7) & 1) * 64 + (n & 63);
    return n;
}
constexpr int PTAB_OFF = LDSCTL_OFF + 1024;
__device__ __forceinline__ unsigned long long ldptr(LAS unsigned char* lds, int i) {
    const volatile LAS unsigned* t = (const volatile LAS unsigned*)(lds + PTAB_OFF) + 2 * i;
    const unsigned a = __builtin_amdgcn_readfirstlane(t[0]), b = __builtin_amdgcn_readfirstlane(t[1]);
    return ((unsigned long long)b << 32) | a;
}
struct ConvItem { const float* src; f16* dst; int N, K; };
__device__ __forceinline__ ConvItem conv_decode(const float* W, int K, int N, f16* WT, int kind, int nrot_rows, int item, int lane) {
    const int nblk = N >> 5, kb = item / nblk, nb = item - kb * nblk, k0 = kb * 64, n0 = nb * 32, ns0 = map_col(kind, nrot_rows, n0);
    const int r = lane >> 3, q = lane & 7;
    ConvItem c; c.src = W + (size_t)(k0 + 8 * r) * N + ns0 + 4 * q; c.dst = WT + (size_t)(n0 + 4 * q) * K + k0 + 8 * r; c.N = N; c.K = K; return c;
}
__device__ __forceinline__ void conv_load(const ConvItem& c, f32x4 (&v)[8]) {
#pragma unroll
    for (int i = 0; i < 8; ++i) v[i] = __builtin_nontemporal_load((const f32x4*)(c.src + (size_t)i * c.N));
}
__device__ __forceinline__ void conv_store(const ConvItem& c, const f32x4 (&v)[8]) {
#pragma unroll
    for (int nn = 0; nn < 4; ++nn) { const pg8::f32x8 o = {v[0][nn], v[1][nn], v[2][nn], v[3][nn], v[4][nn], v[5][nn], v[6][nn], v[7][nn]};
        *(u32x4*)(c.dst + (size_t)nn * c.K) = op_pk8((f32x4){o[0], o[1], o[2], o[3]}, (f32x4){o[4], o[5], o[6], o[7]}); }
}
constexpr int CI_GU = (DM / 64) * (2 * FF / 32), CI_DN = (FF / 64) * (DM / 32), CI_IN = (DM / 64) * (4 * DM / 32), CI_SQ = (DM / 64) * (DM / 32), CI_KV = (DM / 64) * (1024 / 32);
constexpr int CONV_NITEMS = 4 * CI_GU + 4 * CI_DN + CI_IN + CI_SQ + CI_KV + CI_SQ + CI_SQ;
constexpr int CR_GU0 = 0, CR_DN0 = 4 * CI_GU, CR_IN = CR_DN0 + 4 * CI_DN, CR_OUT = CR_IN + CI_IN, CR_KV = CR_OUT + CI_SQ, CR_Q = CR_KV + CI_KV, CR_O = CR_Q + CI_SQ;
static_assert(CR_O + CI_SQ == CONV_NITEMS, "conversion item ranges");
#define W16P_(wsb, off) ((f16*)((wsb) + WS_W16) + (off))
__device__ __forceinline__ ConvItem conv_item_of(LAS unsigned char* lds, unsigned char* ws, int it, int lane) {
    int r = it;
    if (r < 4 * CI_GU) { const int s = r / CI_GU; return conv_decode((const float*)ldptr(lds, 6) + (size_t)s * DM * 2 * FF, DM, 2 * FF, W16P_(ws, W16_GU + s * W16_GU_SZ), MAP_SWIGLU, 0, r - s * CI_GU, lane); } r -= 4 * CI_GU;
    if (r < 4 * CI_DN) { const int s = r / CI_DN; return conv_decode((const float*)ldptr(lds, 7) + (size_t)s * FF * DM, FF, DM, W16P_(ws, W16_DN + s * W16_DN_SZ), MAP_NAT, 0, r - s * CI_DN, lane); } r -= 4 * CI_DN;
    if (r < CI_IN) return conv_decode((const float*)ldptr(lds, 8), DM, 4 * DM, W16P_(ws, W16_IN), MAP_NAT, 0, r, lane); r -= CI_IN;
    if (r < CI_SQ) return conv_decode((const float*)ldptr(lds, 11), DM, DM, W16P_(ws, W16_OUT), MAP_NAT, 0, r, lane); r -= CI_SQ;
    if (r < CI_KV) return conv_decode((const float*)ldptr(lds, 13), DM, 1024, W16P_(ws, W16_KV), MAP_ROT, 512, r, lane); r -= CI_KV;
    if (r < CI_SQ) return conv_decode((const float*)ldptr(lds, 14), DM, DM, W16P_(ws, W16_Q), MAP_ROT, DM, r, lane); r -= CI_SQ;
    return conv_decode((const float*)ldptr(lds, 15), DM, DM, W16P_(ws, W16_O), MAP_NAT, 0, r, lane);
}
__device__ __forceinline__ void conv_range(LAS unsigned char* lds, unsigned char* ws, int it0, int it1, int gw, int nw, int lane) {
    for (int it = it0 + gw; it < it1; it += 2 * nw) {
        const ConvItem a = conv_item_of(lds, ws, it, lane); f32x4 va[8], vb[8]; conv_load(a, va);
        const bool two = it + nw < it1;
        if (two) { const ConvItem b = conv_item_of(lds, ws, it + nw, lane); conv_load(b, vb); conv_store(a, va); conv_store(b, vb); }
        else conv_store(a, va);
    }
}

#define WSP(T, off) ((T)(ws + (off)))
#define PHASE_LANE() const int lane = lane_id_opaque(); const int tid = wave * 64 + lane; (void)tid
#define LDP(T, i) ((T)ldptr(lds, (i)))
#define PH_BEGIN if (pc >= lo && pc < hi) { unsigned char* const ws = LDP(unsigned char*, 17); PHASE_LANE();
#define PH_END if (pc + 1 < hi) xcd_barrier(bar, wave); } ++pc;
#define GEMM_CALL(EpiT, Aptr, Btptr, Nn, Kk, Eobj) do { pg8::Gemm g_{(const pg8::bf16_t*)(Aptr), (const pg8::bf16_t*)(Btptr), M, (Nn), (Kk)}; pg8::StaticOrder S_; S_.init(M, (Nn), G, bx); \
        pg8::gemm_phase<EpiT, pg8::StaticOrder, false, true>(lds, g_, S_, (Eobj), wave); } while (0)
#define W16P(off) (WSP(f16*, WS_W16) + (off))
#define SIDE_CONV(i0, i1) do { if (G == 256 && bx >= 128) conv_range(lds, ws, (i0), (i1), (bx - 128) * NWAVES + wave, 128 * NWAVES, lane); } while (0)


template <int s>
__device__ __forceinline__ void sub_body(LAS unsigned char* lds, const int G, const int bx, const int vcu, const int wave, const int lo, const int hi, const XcdBarrier bar, int& pc) {
    constexpr int l = s >> 1, half = s & 1;

        if (half == 1) {
            if (l == 0) {
                PH_BEGIN { pg8::EpiHgrn E{WSP(f16*, WS_QH), WSP(f16*, WS_KH), WSP(u16*, WS_VH), WSP(f16*, WS_GH), WSP(float*, WS_LF), WSP(const float*, WS_LBT)}; GEMM_CALL(pg8::EpiHgrn, WSP(f16*, WS_H), W16P(W16_IN), 4 * DM, DM, E); } PH_END
                PH_BEGIN { for (int u = vcu; u < 256; u += G) if ((u & 7) != 7) scan::scan_unit<true>(lds, u, wave, lane, WSP(const f16*, WS_QH), WSP(const f16*, WS_KH), WSP(const u16*, WS_VH), WSP(const f16*, WS_GH), WSP(const float*, WS_LF), LDP(const float*, 10), WSP(float*, WS_ST), WSP(f16*, WS_OG)); } PH_END
                PH_BEGIN { scan::scan_carry(WSP(float*, WS_ST), vcu * 512 + tid, G * 512); } PH_END
                PH_BEGIN { for (int u = vcu; u < 256; u += G) scan::scan_unit<false>(lds, u, wave, lane, WSP(const f16*, WS_QH), WSP(const f16*, WS_KH), WSP(const u16*, WS_VH), WSP(const f16*, WS_GH), WSP(const float*, WS_LF), LDP(const float*, 10), WSP(float*, WS_ST), WSP(f16*, WS_OG)); } PH_END
                PH_BEGIN { pg8::EpiF16 E{WSP(f16*, WS_Y), DM}; GEMM_CALL(pg8::EpiF16, WSP(f16*, WS_OG), W16P(W16_OUT), DM, DM, E); } PH_END
            } else {
                PH_BEGIN { pg8::EpiRot E{WSP(f16*, WS_Q), NH, WSP(const float*, WS_ROPE), nullptr, nullptr, DM / 256}; GEMM_CALL(pg8::EpiRot, WSP(f16*, WS_H), W16P(W16_Q), DM, DM, E); } PH_END
                PH_BEGIN { attn::moba_phase((char*)lds, wave, vcu, G, WSP(const f16*, WS_Q), WSP(const f16*, WS_K), WSP(const f16*, WS_V), WSP(const float*, WS_KMEAN), WSP(f16*, WS_O)); } PH_END
                PH_BEGIN { pg8::EpiF16 E{WSP(f16*, WS_Y), DM}; GEMM_CALL(pg8::EpiF16, WSP(f16*, WS_O), W16P(W16_O), DM, DM, E); } PH_END
            }
            PH_BEGIN
            {
                float* mods = WSP(float*, WS_MODS); const float* norm_pre = LDP(const float*, 4); const float* norm_post = LDP(const float*, 5);
                NormArgs2 a{}; a.x_in = WSP(const f16*, WS_X16); a.y = WSP(const f16*, WS_Y); a.x_out = WSP(f16*, WS_X16); a.h = WSP(f16*, WS_H); a.gate = mods + (size_t)(l * 2) * MODW + 1 * 3 * DM + 2 * DM; a.post = norm_post + (l * 3 + 1) * DM;
                a.pre = norm_pre + (l * 3 + 2) * DM; a.shift = mods + (size_t)(l * 2) * MODW + 2 * 3 * DM; a.scale = a.shift + DM; a.w = 1.0f; a.has_y = 1; a.has_h = 1;
                norm_rows_lds<true, true>(a, lds, vcu, G, wave, lane);
            }
            PH_END
        }
        if (s == 2) {
            PH_BEGIN { pg8::EpiRot E{WSP(f16*, WS_K), NKV, WSP(const float*, WS_ROPE), WSP(float*, WS_KMEAN), WSP(f16*, WS_V), 2}; GEMM_CALL(pg8::EpiRot, WSP(f16*, WS_HKV), W16P(W16_KV), 1024, DM, E);
                SIDE_CONV(CR_DN0 + 2 * CI_DN, CR_DN0 + 3 * CI_DN); SIDE_CONV(CR_Q, CONV_NITEMS); } PH_END
        }
        PH_BEGIN { pg8::EpiSwiGLU E{WSP(f16*, WS_ACT)}; GEMM_CALL(pg8::EpiSwiGLU, WSP(f16*, WS_H), W16P(W16_GU + s * W16_GU_SZ), 2 * FF, DM, E);
            if (s == 0) { SIDE_CONV(CR_DN0, CR_DN0 + CI_DN); SIDE_CONV(CR_IN, CR_KV); }
            if (s == 1) { SIDE_CONV(CR_DN0 + CI_DN, CR_DN0 + 2 * CI_DN); SIDE_CONV(CR_KV, CR_Q); SIDE_CONV(CR_GU0 + 2 * CI_GU, CR_GU0 + 3 * CI_GU); }
            if (s == 2) { SIDE_CONV(CR_GU0 + 3 * CI_GU, CR_GU0 + 4 * CI_GU); SIDE_CONV(CR_DN0 + 3 * CI_DN, CR_DN0 + 4 * CI_DN); }
        } PH_END
        PH_BEGIN { pg8::EpiF16 E{WSP(f16*, WS_Y), DM}; GEMM_CALL(pg8::EpiF16, WSP(f16*, WS_ACT), W16P(W16_DN + s * W16_DN_SZ), DM, FF, E); } PH_END
        PH_BEGIN
        {
            float* mods = WSP(float*, WS_MODS); const float* norm_pre = LDP(const float*, 4); const float* norm_post = LDP(const float*, 5);
            NormArgs2 a{}; a.x_in = (s == 0) ? (const void*)LDP(const float*, 0) : (const void*)WSP(const f16*, WS_X16); a.y = WSP(const f16*, WS_Y); a.x_out = (s == 3) ? (void*)LDP(float*, 16) : (void*)WSP(f16*, WS_X16);
            a.h = WSP(f16*, WS_H); a.h2 = WSP(f16*, WS_HKV); a.kvn = LDP(const float*, 12);
            a.gate = mods + (size_t)(l * 2) * MODW + (half * 2) * 3 * DM + 2 * DM; a.post = norm_post + (l * 3 + half * 2) * DM; a.w = 0.5f; a.has_y = 1;
            if (half == 0) { a.pre = norm_pre + (l * 3 + 1) * DM; a.shift = mods + (size_t)(l * 2) * MODW + 1 * 3 * DM; a.scale = a.shift + DM; a.has_h = 1; }
            else if (l == 0) { a.pre = norm_pre + 3 * DM; a.shift = mods + (size_t)2 * MODW; a.scale = a.shift + DM; a.has_h = 1; a.has_kv = 1; }
            else { a.pre = norm_pre; a.shift = mods; a.scale = mods; }
            norm_rows_lds<(s != 0), (s != 3)>(a, lds, vcu, G, wave, lane);
        }
        PH_END
    }

__global__ void __launch_bounds__(NWAVES * 64, 2) mega(MegaArgs args) {
    extern __shared__ __attribute__((aligned(16))) unsigned char lds_raw[];
    LAS unsigned char* lds = (LAS unsigned char*)lds_raw;
    volatile LAS unsigned* MISC = (volatile LAS unsigned*)(lds + MISC_OFF);
    const int wave = __builtin_amdgcn_readfirstlane(threadIdx.x >> 6);
    const int G = gridDim.x, bx = blockIdx.x, vcu = (G % 8 == 0) ? (bx % 8) * (G / 8) + bx / 8 : bx;
    const int lo = args.lo, hi = args.hi;
    { const int tid = threadIdx.x;
    if (tid < 18) ((LAS unsigned long long*)(lds + PTAB_OFF))[tid] = (tid < 16) ? (unsigned long long)args.in[tid] : (tid == 16 ? (unsigned long long)args.out : (unsigned long long)args.ws);
    for (int u = tid; u < 64; u += NWAVES * 64) ((LAS unsigned*)(lds + LDSCTL_OFF))[u + 80] = 0u; }
    __syncthreads();
    XcdBarrier bar; bar.bar = (unsigned*)(args.ws + WS_CTL) + 4096; bar.x = 0; bar.st = nullptr;
    if (hi - lo > 1) bar = xcd_barrier_post((unsigned*)(args.ws + WS_CTL) + 4096, MISC + 8);

    int pc = 0;
    PH_BEGIN
    {
        const float* cvec = LDP(const float*, 1); const float* ada_w = LDP(const float*, 2); const float* ada_b = LDP(const float*, 3);
        float* mods = WSP(float*, WS_MODS); float* rope = WSP(float*, WS_ROPE); float* kmean = WSP(float*, WS_KMEAN);
        LAS float* sc = (LAS float*)lds; LAS float* red = (LAS float*)(lds + 16384);
        for (int i = tid; i < 2 * DM; i += 512) sc[i] = silu_f(cvec[i]);
        __syncthreads();
        constexpr int nchunk = MODW / 64;
        for (int u = vcu; u < 2 * nchunk; u += G) {
            const int l = u / nchunk, c0 = (u % nchunk) * 64;
            const float* W = ada_w + (size_t)l * DM * MODW + c0 + lane;
            float a0 = 0.f, a1 = 0.f; const int k0 = wave * 256;
#pragma unroll 16
            for (int k = 0; k < 256; ++k) { const float wv = W[(size_t)(k0 + k) * MODW]; a0 += sc[k0 + k] * wv; a1 += sc[DM + k0 + k] * wv; }
            red[(wave * 2 + 0) * 64 + lane] = a0; red[(wave * 2 + 1) * 64 + lane] = a1;
            __syncthreads();
            if (tid < 128) { const int b = tid >> 6; float s = 0.f;
#pragma unroll
                for (int ww = 0; ww < 8; ++ww) s += red[(ww * 2 + b) * 64 + lane];
                mods[(size_t)(l * 2 + b) * MODW + c0 + lane] = s + ada_b[(size_t)l * MODW + c0 + lane]; }
            __syncthreads();
        }
        for (int i = vcu * 512 + tid; i < SEQ * 64; i += G * 512) { const int t = i >> 6, d = i & 63; const float inv = powf(10000.0f, -(float)d / 64.0f); const float ang = (float)t * inv; float s, c; sincosf(ang, &s, &c); rope[i] = c; rope[SEQ * 64 + i] = s; }
        for (int i = vcu * 512 + tid; i < BATCH * NKV * NBLK * 128; i += G * 512) kmean[i] = 0.f;
        { const float* hl = LDP(const float*, 9); float* lbt = WSP(float*, WS_LBT); for (int i = vcu * 512 + tid; i < DM; i += G * 512) lbt[i] = 1.f / (1.f + expf(hl[DM + i] - hl[i])); }
        if (G == 256) conv_range(lds, ws, CR_GU0, CR_GU0 + 2 * CI_GU, vcu * NWAVES + wave, G * NWAVES, lane);
        else conv_range(lds, ws, 0, CONV_NITEMS, vcu * NWAVES + wave, G * NWAVES, lane);
    }
    PH_END
    PH_BEGIN
    {
        float* mods = WSP(float*, WS_MODS);
        NormArgs2 a{}; a.x_in = LDP(const float*, 0); a.h = WSP(f16*, WS_H); a.pre = LDP(const float*, 4); a.shift = mods; a.scale = mods + DM; a.has_h = 1;
        norm_rows_lds<false, false>(a, lds, vcu, G, wave, lane);
    }
    PH_END
    sub_body<0>(lds, G, bx, vcu, wave, lo, hi, bar, pc);
    sub_body<1>(lds, G, bx, vcu, wave, lo, hi, bar, pc);
    sub_body<2>(lds, G, bx, vcu, wave, lo, hi, bar, pc);
    sub_body<3>(lds, G, bx, vcu, wave, lo, hi, bar, pc);
}

#define FAST_SCAN 1
#define FAST_ATTN 1
#ifndef N_LAUNCH_MODE
#define N_LAUNCH_MODE 1
#endif
extern "C" void kernel_launch(void* const* d_in, const int* in_sizes, int n_in, void* d_out, int out_size, void* d_ws, size_t ws_size, hipStream_t stream) {
    static int grid = 0;
    if (grid == 0) {
        if (n_in != 16 || out_size != M * DM || ws_size < WS_END) { fprintf(stderr, "kernel_launch: unexpected shapes (n_in %d out %d ws %zu)\n", n_in, out_size, ws_size); grid = -1; return; }
        int dev = 0, cus = 0, per_cu = 0;
        if (hipGetDevice(&dev) != hipSuccess || hipDeviceGetAttribute(&cus, hipDeviceAttributeMultiprocessorCount, dev) != hipSuccess) { grid = -1; return; }
        if (hipFuncSetAttribute((const void*)mega, hipFuncAttributeMaxDynamicSharedMemorySize, LDS_BYTES) != hipSuccess) { fprintf(stderr, "kernel_launch: hipFuncSetAttribute failed\n"); grid = -1; return; }
        if (hipOccupancyMaxActiveBlocksPerMultiprocessor(&per_cu, (const void*)mega, NWAVES * 64, LDS_BYTES) != hipSuccess || per_cu < 1) fprintf(stderr, "kernel_launch: occupancy query says %d\n", per_cu);
        (void)hipGetLastError();
        grid = cus;
    }
    if (grid < 0) return;
    unsigned char* ws = (unsigned char*)d_ws;
    (void)hipMemsetAsync(ws + WS_CTL, 0, 1 * MiB, stream);
    MegaArgs a{};
    for (int i = 0; i < 16; ++i) a.in[i] = (const float*)d_in[i];
    a.out = (float*)d_out; a.ws = ws;
#if N_LAUNCH_MODE == 1
    a.lo = 0; a.hi = PC_END;
    hipLaunchKernelGGL(mega, dim3(grid), dim3(NWAVES * 64), LDS_BYTES, stream, a);
#else
    f16* Kb = (f16*)(ws + WS_K); f16* Vb = (f16*)(ws + WS_V); float* kmean = (float*)(ws + WS_KMEAN);
    f16* QH = (f16*)(ws + WS_QH); f16* KH = (f16*)(ws + WS_KH); u16* VH = (u16*)(ws + WS_VH); f16* GH = (f16*)(ws + WS_GH); float* LF = (float*)(ws + WS_LF); f16* OG = (f16*)(ws + WS_OG);
    f16* Qb = (f16*)(ws + WS_Q); f16* Ob = (f16*)(ws + WS_O);
    for (int pc = 0; pc < PC_END; ++pc) {
#ifndef FAST_SCAN
        if (pc == PC_SA) { hipLaunchKernelGGL(k_naive_scan, dim3(BATCH * NH), dim3(128), 0, stream, QH, KH, VH, GH, LF, (const float*)d_in[10], OG); continue; }
        if (pc == PC_SB || pc == PC_SC) continue;
#endif
#ifndef FAST_ATTN
        if (pc == PC_AT) { hipLaunchKernelGGL(k_naive_attn, dim3(BATCH * NH * SEQ / 4), dim3(256), 0, stream, Qb, Kb, Vb, kmean, Ob); continue; }
#endif
        a.lo = pc; a.hi = pc + 1;
        int nrep = 1;
#ifdef PROBE_DUP
        { const int dup[][2] = PROBE_DUP; for (unsigned q = 0; q < sizeof(dup) / sizeof(dup[0]); ++q) if (dup[q][0] == pc) nrep += dup[q][1]; }
#endif
        for (int r = 0; r < nrep; ++r) hipLaunchKernelGGL(mega, dim3(grid), dim3(NWAVES * 64), LDS_BYTES, stream, a);
    }
#endif
}
```

```cpp
#include <hip/hip_runtime.h>
#include <cstdio>
#include <cstdint>

#define LAS __attribute__((address_space(3)))
typedef _Float16 f16;
typedef unsigned short u16;
typedef float f32x4 __attribute__((ext_vector_type(4)));
typedef float f32x2 __attribute__((ext_vector_type(2)));
typedef _Float16 f16x2 __attribute__((ext_vector_type(2)));
typedef _Float16 f16x4 __attribute__((ext_vector_type(4)));
typedef _Float16 f16x8 __attribute__((ext_vector_type(8)));
typedef unsigned u32x4 __attribute__((ext_vector_type(4)));

constexpr int DM = 2048, BATCH = 2, SEQ = 4096, M = BATCH * SEQ, FF = 5632, MODW = 9 * DM;
constexpr int HD = 128, NH = 16, NKV = 4, MBLK = 256, NBLK = SEQ / MBLK;
constexpr float EPS = 1e-6f;
constexpr float ATT_SCALE = 0.08838834764831845f;

constexpr size_t MiB = 1u << 20;
constexpr size_t WS_CTL = 0;
constexpr size_t WS_MODS = 1 * MiB;
constexpr size_t WS_LBT = 1 * MiB + 512 * 1024;
constexpr size_t WS_ROPE = 2 * MiB;
constexpr size_t WS_KMEAN = 4 * MiB;
constexpr size_t WS_H = 8 * MiB;
constexpr size_t WS_HKV = 40 * MiB;
constexpr size_t WS_Y = 72 * MiB;
constexpr size_t WS_K = 136 * MiB;
constexpr size_t WS_V = 144 * MiB;
constexpr size_t WS_ST = 152 * MiB;
constexpr size_t WS_RA = 176 * MiB;
constexpr size_t WS_QH = WS_RA, WS_KH = WS_RA + 32 * MiB, WS_VH = WS_RA + 64 * MiB, WS_GH = WS_RA + 96 * MiB, WS_LF = WS_RA + 128 * MiB, WS_OG = WS_RA + 192 * MiB;
constexpr size_t WS_ACT = WS_RA;
constexpr size_t WS_Q = WS_RA, WS_O = WS_RA + 32 * MiB;
constexpr size_t WS_X16 = 400 * MiB;
constexpr size_t WS_C = 400 * MiB;
constexpr size_t WS_W16 = 752 * MiB;
constexpr size_t WS_END = 1100 * MiB;

__device__ __forceinline__ float silu_f(float x) { return x / (1.f + __expf(-x)); }
__device__ __forceinline__ float wave_sum(float v) {
#pragma unroll
    for (int o = 1; o < 64; o <<= 1) v += __shfl_xor(v, o);
    return v;
}

__device__ __forceinline__ u16 f2bf(float f) { unsigned u = __builtin_bit_cast(unsigned, f); return (u16)((u + 0x7fffu + ((u >> 16) & 1u)) >> 16); }
__device__ __forceinline__ float bf2f(u16 b) { return __builtin_bit_cast(float, (unsigned)b << 16); }
__device__ __forceinline__ int lane_id_opaque() { int l; asm volatile("v_mbcnt_lo_u32_b32 %0, -1, 0\n\tv_mbcnt_hi_u32_b32 %0, -1, %0" : "=v"(l)); return l; }
#ifndef OPBF16
#define OPBF16 1
#endif
typedef unsigned u32x2_t __attribute__((ext_vector_type(2)));
__device__ __forceinline__ unsigned op_pk2(float lo, float hi) {
#if OPBF16
    unsigned r; asm volatile("v_cvt_pk_bf16_f32 %0, %1, %2" : "=v"(r) : "v"(lo), "v"(hi)); return r;
#else
    const f32x2 v = {lo, hi}; return __builtin_bit_cast(unsigned, __builtin_convertvector(v, f16x2));
#endif
}
__device__ __forceinline__ u32x4 op_pk8(f32x4 a, f32x4 b) { return (u32x4){op_pk2(a[0], a[1]), op_pk2(a[2], a[3]), op_pk2(b[0], b[1]), op_pk2(b[2], b[3])}; }
__device__ __forceinline__ u32x2_t op_pk4(f32x4 a) { return (u32x2_t){op_pk2(a[0], a[1]), op_pk2(a[2], a[3])}; }
#ifndef WT_STORES
#define WT_STORES 0
#endif
template <int OFF = 0> __device__ __forceinline__ void st16_wt(void* p, u32x4 v) {
#if WT_STORES
    asm volatile("global_store_dwordx4 %0, %1, off offset:%2 sc1\n\ts_nop 1" :: "v"(p), "v"(v), "i"(OFF) : "memory");
#else
    *(u32x4*)((char*)p + OFF) = v;
#endif
}
__device__ __forceinline__ void st8_wt(void* p, u32x2_t v) {
#if WT_STORES
    asm volatile("global_store_dwordx2 %0, %1, off sc1\n\ts_nop 1" :: "v"(p), "v"(v) : "memory");
#else
    *(u32x2_t*)p = v;
#endif
}

__global__ __launch_bounds__(512) void k_mods(const float* __restrict__ c, const float* __restrict__ ada_w, const float* __restrict__ ada_b, float* __restrict__ mods) {
    __shared__ float sc[2][DM];
    __shared__ float red[8][2][64];
    const int tid = threadIdx.x, lane = tid & 63, w = tid >> 6;
    for (int i = tid; i < 2 * DM; i += 512) sc[i / DM][i % DM] = silu_f(c[i]);
    __syncthreads();
    const int nchunk = MODW / 64;
    for (int u = blockIdx.x; u < 2 * nchunk; u += gridDim.x) {
        const int l = u / nchunk, c0 = (u % nchunk) * 64;
        const float* W = ada_w + (size_t)l * DM * MODW + c0 + lane;
        float a0 = 0.f, a1 = 0.f;
        const int k0 = w * 256;
#pragma unroll 8
        for (int k = 0; k < 256; ++k) { const float wv = W[(size_t)(k0 + k) * MODW]; a0 += sc[0][k0 + k] * wv; a1 += sc[1][k0 + k] * wv; }
        red[w][0][lane] = a0; red[w][1][lane] = a1;
        __syncthreads();
        if (tid < 128) { const int b = tid >> 6; float s = 0.f;
#pragma unroll
            for (int ww = 0; ww < 8; ++ww) s += red[ww][b][lane];
            mods[(size_t)(l * 2 + b) * MODW + c0 + lane] = s + ada_b[(size_t)l * MODW + c0 + lane]; }
        __syncthreads();
    }
}
__global__ void k_rope(float* __restrict__ rope) {
    const int i = blockIdx.x * blockDim.x + threadIdx.x;
    if (i >= SEQ * 64) return;
    const int t = i / 64, d = i % 64;
    const float inv = powf(10000.0f, -(float)d / 64.0f);
    const float ang = (float)t * inv;
    float s, c; sincosf(ang, &s, &c);
    rope[i] = c; rope[SEQ * 64 + i] = s;
}

struct NormArgs {
    const float* x_in; const float* y; float* x_out; f16* h; f16* h2;
    const float* gate; const float* post; const float* pre; const float* scale; const float* shift; const float* kvn;
    float w; int has_y, has_h, has_kv, pad;
};
__device__ __forceinline__ void norm_rows(const NormArgs& a, int gw, int ngw, int lane) {
    for (int row = gw; row < M; row += ngw) {
        const int b = row / SEQ;
        const f32x4* xr = (const f32x4*)(a.x_in + (size_t)row * DM) + lane;
        f32x4 v[8];
#pragma unroll
        for (int j = 0; j < 8; ++j) v[j] = xr[64 * j];
        if (a.has_y) {
            const f32x4* yr = (const f32x4*)(a.y + (size_t)row * DM) + lane;
            f32x4 yv[8]; float s = 0.f;
#pragma unroll
            for (int j = 0; j < 8; ++j) { yv[j] = yr[64 * j]; s += (yv[j].x * yv[j].x + yv[j].y * yv[j].y) + (yv[j].z * yv[j].z + yv[j].w * yv[j].w); }
            const float r1 = rsqrtf(wave_sum(s) * (1.f / DM) + EPS) * a.w;
            const f32x4* gp = (const f32x4*)(a.gate + (size_t)b * MODW) + lane; const f32x4* pp = (const f32x4*)a.post + lane;
#pragma unroll
            for (int j = 0; j < 8; ++j) { const f32x4 g = gp[64 * j], p = pp[64 * j]; v[j] = v[j] + (yv[j] * r1) * p * g; }
            f32x4* xo = (f32x4*)(a.x_out + (size_t)row * DM) + lane;
#pragma unroll
            for (int j = 0; j < 8; ++j) xo[64 * j] = v[j];
        }
        if (a.has_h || a.has_kv) {
            float s = 0.f;
#pragma unroll
            for (int j = 0; j < 8; ++j) s += (v[j].x * v[j].x + v[j].y * v[j].y) + (v[j].z * v[j].z + v[j].w * v[j].w);
            const float r2 = rsqrtf(wave_sum(s) * (1.f / DM) + EPS);
            if (a.has_h) {
                const f32x4* pp = (const f32x4*)a.pre + lane; const f32x4* sp = (const f32x4*)(a.scale + (size_t)b * MODW) + lane; const f32x4* hp = (const f32x4*)(a.shift + (size_t)b * MODW) + lane;
                f16x4* ho = (f16x4*)(a.h + (size_t)row * DM) + lane;
#pragma unroll
                for (int j = 0; j < 8; ++j) { const f32x4 p = pp[64 * j], sc = sp[64 * j], sh = hp[64 * j]; const f32x4 o = (v[j] * r2) * p * (sc + 1.f) + sh;
                    ho[64 * j] = __builtin_convertvector(o, f16x4); }
            }
            if (a.has_kv) {
                const f32x4* pp = (const f32x4*)a.kvn + lane; f16x4* ho = (f16x4*)(a.h2 + (size_t)row * DM) + lane;
#pragma unroll
                for (int j = 0; j < 8; ++j) { const f32x4 o = (v[j] * r2) * pp[64 * j]; ho[64 * j] = __builtin_convertvector(o, f16x4); }
            }
        }
    }
}
struct NormArgs2 {
    const void* x_in; const f16* y; void* x_out; f16* h; f16* h2;
    const float* gate; const float* post; const float* pre; const float* scale; const float* shift; const float* kvn;
    float w; int has_y, has_h, has_kv;
};
template <bool XIN16, bool XOUT16>
__device__ __forceinline__ void norm_rows_lds(const NormArgs2& a, LAS unsigned char* lds, const int vcu, const int G, const int wave, const int lane) {
    const int rows_per_wg = M / G, row0 = vcu * rows_per_wg, b = row0 / SEQ, tid = wave * 64 + lane;
    LAS f32x4* LA = (LAS f32x4*)lds; LAS f32x4* LB = LA + 512; LAS f32x4* LC = LA + 1024; LAS f32x4* LK = LA + 1536;
    { const int i = tid;
      if (a.has_y) { const f32x4 g = ((const f32x4*)(a.gate + (size_t)b * MODW))[i], p = ((const f32x4*)a.post)[i]; LA[i] = g * p * a.w; }
      if (a.has_h) { const f32x4 p = ((const f32x4*)a.pre)[i], sc = ((const f32x4*)(a.scale + (size_t)b * MODW))[i]; LB[i] = p * (sc + 1.f); LC[i] = ((const f32x4*)(a.shift + (size_t)b * MODW))[i]; }
      if (a.has_kv) LK[i] = ((const f32x4*)a.kvn)[i]; }
    __syncthreads();
    for (int rr = wave * 2; rr < rows_per_wg; rr += 16) {
        const int row = row0 + rr;
        f32x4 v[2][8]; f16x4 yv[2][8];
#pragma unroll
        for (int q = 0; q < 2; ++q) {
            if (XIN16) { const f16x4* xr = (const f16x4*)((const f16*)a.x_in + (size_t)(row + q) * DM) + lane;
#pragma unroll
                for (int j = 0; j < 8; ++j) v[q][j] = __builtin_convertvector(xr[64 * j], f32x4); }
            else { const f32x4* xr = (const f32x4*)((const float*)a.x_in + (size_t)(row + q) * DM) + lane;
#pragma unroll
                for (int j = 0; j < 8; ++j) v[q][j] = xr[64 * j]; } }
        if (a.has_y) {
#pragma unroll
            for (int q = 0; q < 2; ++q) { const f16x4* yr = (const f16x4*)(a.y + (size_t)(row + q) * DM) + lane;
#pragma unroll
                for (int j = 0; j < 8; ++j) yv[q][j] = yr[64 * j]; }
#pragma unroll
            for (int q = 0; q < 2; ++q) { float s = 0.f; f32x4 yf[8];
#pragma unroll
                for (int j = 0; j < 8; ++j) { yf[j] = __builtin_convertvector(yv[q][j], f32x4); s += (yf[j].x * yf[j].x + yf[j].y * yf[j].y) + (yf[j].z * yf[j].z + yf[j].w * yf[j].w); }
                const float r1 = rsqrtf(wave_sum(s) * (1.f / DM) + EPS);
#pragma unroll
                for (int j = 0; j < 8; ++j) v[q][j] = v[q][j] + (yf[j] * r1) * LA[lane + 64 * j];
                if (XOUT16) { f16x4* xo = (f16x4*)((f16*)a.x_out + (size_t)(row + q) * DM) + lane;
#pragma unroll
                    for (int j = 0; j < 8; ++j) xo[64 * j] = __builtin_convertvector(v[q][j], f16x4); }
                else { f32x4* xo = (f32x4*)((float*)a.x_out + (size_t)(row + q) * DM) + lane;
#pragma unroll
                    for (int j = 0; j < 8; ++j) xo[64 * j] = v[q][j]; } }
        }
        if (a.has_h || a.has_kv) {
#pragma unroll
            for (int q = 0; q < 2; ++q) { float s = 0.f;
#pragma unroll
                for (int j = 0; j < 8; ++j) s += (v[q][j].x * v[q][j].x + v[q][j].y * v[q][j].y) + (v[q][j].z * v[q][j].z + v[q][j].w * v[q][j].w);
                const float r2 = rsqrtf(wave_sum(s) * (1.f / DM) + EPS);
                if (a.has_h) { u32x2_t* ho = (u32x2_t*)(a.h + (size_t)(row + q) * DM) + lane;
#pragma unroll
                    for (int j = 0; j < 8; ++j) { const f32x4 o = (v[q][j] * r2) * LB[lane + 64 * j] + LC[lane + 64 * j]; ho[64 * j] = op_pk4(o); } }
                if (a.has_kv) { u32x2_t* ho = (u32x2_t*)(a.h2 + (size_t)(row + q) * DM) + lane;
#pragma unroll
                    for (int j = 0; j < 8; ++j) { const f32x4 o = (v[q][j] * r2) * LK[lane + 64 * j]; ho[64 * j] = op_pk4(o); } }
            }
        }
    }
    __syncthreads();
}
__global__ __launch_bounds__(512) void k_norm(NormArgs a) {
    const int lane = threadIdx.x & 63, w = threadIdx.x >> 6;
    norm_rows(a, blockIdx.x * 8 + w, gridDim.x * 8, lane);
}


namespace pg8 {
#define PG8_LAS __attribute__((address_space(3)))
typedef unsigned short bf16_t;
#if OPBF16
typedef short bf16x8 __attribute__((ext_vector_type(8)));
#define PG8_MFMA16 __builtin_amdgcn_mfma_f32_16x16x32_bf16
#else
typedef _Float16 bf16x8 __attribute__((ext_vector_type(8)));
#define PG8_MFMA16 __builtin_amdgcn_mfma_f32_16x16x32_f16
#endif
typedef float f32x4 __attribute__((ext_vector_type(4)));
typedef unsigned u32x4 __attribute__((ext_vector_type(4)));
constexpr int BM = 256, BK = 64, HALF = 128, HTB = HALF * BK * 2  , STAGE_BYTES = 8 * HTB, NXCD = 8, WGM = 8;

__host__ __device__ __forceinline__ int lds_byte(int r, int c) { const int st = (r >> 4) * 2 + (c >> 5), rr = r & 15, cc = c & 31, ob = rr * 64 + cc * 2; return st * 1024 + (ob ^ (((ob >> 9) & 1) << 5)); }
__host__ __device__ __forceinline__ void stage_rc(int b, int& R, int& C) { const int st = b / 1024, sb = b % 1024, swz = sb ^ (((sb >> 9) & 1) << 5); R = (st >> 1) * 16 + swz / 64; C = (st & 1) * 32 + (swz % 64) / 2; }
__host__ __device__ __forceinline__ int perm32(int rho) { const int n = rho >> 4, i = rho & 15; return 8 * (i >> 2) + 4 * n + (i & 3); }

struct Unit { int pm, pn; };
struct Gemm { const bf16_t* A; const bf16_t* Bt; int M, N, K; };

struct StaticOrder {
    int nM, nN, nwg, G, c;
    __host__ __device__ void init(int M, int N, int G_, int c_) { nM = M / BM; nN = N / BM; nwg = nM * nN; G = G_; c = c_; }
    __host__ __device__ bool next(int i, Unit& u) const {
        const long L = (long)i * G + c; if (L >= nwg) return false;
        int wgid = (int)L; { const int q = nwg / NXCD, r = nwg % NXCD, xcd = wgid % NXCD, off = wgid / NXCD; wgid = (xcd < r ? xcd * (q + 1) : r * (q + 1) + (xcd - r) * q) + off; }
        const int nig = WGM * nN, gid = wgid / nig, fm = gid * WGM, gsz = (nM - fm) < WGM ? (nM - fm) : WGM;
        u.pm = fm + ((wgid % nig) % gsz); u.pn = (wgid % nig) / gsz; return true;
    }
    __device__ __forceinline__ void a_ready(const Unit&) const {}
    __device__ __forceinline__ void done(const Unit&) const {}
};
template <class Epi, class Sched, bool ALIGN_EPI = false, bool SP2 = false>
__device__ __forceinline__ void gemm_phase(PG8_LAS unsigned char* lds, const Gemm g, const Sched& S, const Epi& E, const int wid  ) {
    const int lane = lane_id_opaque(), tid = wid * 64 + lane, wr = wid >> 2, wc = wid & 3, fr = lane & 15, fq = lane >> 4;
    const int K = g.K, nt = K / BK;
    unsigned voffA[2], voffB[2];
#pragma unroll
    for (int i = 0; i < 2; ++i) { int R, C; stage_rc(tid * 16 + i * 8192, R, C); const int Rb = Epi::PERM ? ((R & ~31) + perm32(R & 31)) : R;
        voffA[i] = (unsigned)(R * K + C) * 2u; voffB[i] = (unsigned)(Rb * K + C) * 2u; }
    const size_t kstep = (size_t)(BK * 2);
    const size_t hstep = (size_t)HALF * K * 2;
    const size_t tstep = 2 * hstep;
    const unsigned ldsw = (unsigned)wid * 1024u;
    const int aoff = lds_byte(wr * 64 + fr, fq * 8), boff = lds_byte(wc * 32 + fr, fq * 8);
#define PG8_SA(b, h) (((b) * 2 + (h)) * HTB)
#define PG8_SB(b, h) ((4 + (b) * 2 + (h)) * HTB)
#define PG8_STAGE(bufoff, gbase, voff) do { _Pragma("unroll") for (int _i = 0; _i < 2; ++_i) \
        __builtin_amdgcn_global_load_lds((const unsigned*)((const char*)(gbase) + (voff)[_i]), (PG8_LAS unsigned*)(lds + (bufoff) + ldsw + _i * 8192), 16, 0, 0); } while (0)
#define PG8_LDA(dst, b, h) do { _Pragma("unroll") for (int m = 0; m < 4; ++m) _Pragma("unroll") for (int k = 0; k < 2; ++k) dst[m][k] = *(const PG8_LAS bf16x8*)(lds + PG8_SA(b, h) + aoff + m * 2048 + k * 1024); } while (0)
#define PG8_LDB(dst, b, h) do { _Pragma("unroll") for (int n = 0; n < 2; ++n) _Pragma("unroll") for (int k = 0; k < 2; ++k) dst[n][k] = *(const PG8_LAS bf16x8*)(lds + PG8_SB(b, h) + boff + n * 2048 + k * 1024); } while (0)
#define PG8_MMA(ai, bj, At, Bt) do { __builtin_amdgcn_s_setprio(1); _Pragma("unroll") for (int m = 0; m < 4; ++m) _Pragma("unroll") for (int n = 0; n < 2; ++n) _Pragma("unroll") for (int k = 0; k < 2; ++k) \
        acc[ai][bj][m][n] = PG8_MFMA16(Bt[n][k], At[m][k], acc[ai][bj][m][n], 0, 0, 0); __builtin_amdgcn_s_setprio(0); } while (0)
#define PG8_WAIT_V(n) asm volatile("s_waitcnt vmcnt(" #n ")" ::: "memory")
#define PG8_WAIT_L(n) asm volatile("s_waitcnt lgkmcnt(" #n ")" ::: "memory")
#define PG8_BAR __builtin_amdgcn_s_barrier()
#define PG8_SCHED __builtin_amdgcn_sched_barrier(0)
    Unit cur, nxt; int ui = 0;
    if (!S.next(0, cur)) return;
    f32x4 acc[2][2][4][2];
#pragma unroll
    for (int a = 0; a < 2; ++a)
#pragma unroll
        for (int b = 0; b < 2; ++b)
#pragma unroll
            for (int m = 0; m < 4; ++m)
#pragma unroll
                for (int n = 0; n < 2; ++n) acc[a][b][m][n] = (f32x4){0.f, 0.f, 0.f, 0.f};
    bf16x8 At[4][2], B0[2][2], B1[2][2];
    const char* cA = (const char*)g.A + (size_t)cur.pm * tstep; const char* cB = (const char*)g.Bt + (size_t)cur.pn * tstep;
    S.a_ready(cur);
    if constexpr (SP2) {
        PG8_STAGE(PG8_SB(0, 0), cB, voffB); PG8_STAGE(PG8_SB(0, 1), cB + hstep, voffB); PG8_STAGE(PG8_SA(0, 0), cA, voffA); PG8_STAGE(PG8_SA(0, 1), cA + hstep, voffA);
        if (wr == 1) PG8_BAR;
        PG8_WAIT_V(2); PG8_BAR;
        PG8_STAGE(PG8_SB(1, 0), cB + kstep, voffB); PG8_STAGE(PG8_SA(1, 0), cA + kstep, voffA); PG8_STAGE(PG8_SB(1, 1), cB + hstep + kstep, voffB);
        PG8_WAIT_V(6); PG8_BAR;
    } else {
        PG8_STAGE(PG8_SB(0, 0), cB, voffB); PG8_STAGE(PG8_SA(0, 0), cA, voffA); PG8_STAGE(PG8_SB(0, 1), cB + hstep, voffB); PG8_STAGE(PG8_SA(0, 1), cA + hstep, voffA);
        if (wr == 1) PG8_BAR;
        PG8_WAIT_V(4); PG8_BAR;
        PG8_STAGE(PG8_SB(1, 0), cB + kstep, voffB); PG8_STAGE(PG8_SA(1, 0), cA + kstep, voffA); PG8_STAGE(PG8_SB(1, 1), cB + hstep + kstep, voffB);
        PG8_WAIT_V(6); PG8_BAR;
    }
    for (;;) {
        const bool has_next = S.next(ui + 1, nxt);
        const char* nA = has_next ? (const char*)g.A + (size_t)nxt.pm * tstep : cA; const char* nB = has_next ? (const char*)g.Bt + (size_t)nxt.pn * tstep : cB;
        for (int t = 0; t < nt; t += 2) {
            const bool last = (t == nt - 2);
            const char* a1 = cA + (size_t)(t + 1) * kstep;
            const char* a2 = last ? nA : cA + (size_t)(t + 2) * kstep; const char* b2 = last ? nB : cB + (size_t)(t + 2) * kstep;
            const char* a3 = a2 + kstep; const char* b3 = b2 + kstep;
            if (last && has_next) S.a_ready(nxt);
            if constexpr (SP2) {
            PG8_LDB(B0, 0, 0); PG8_LDB(B1, 0, 1); PG8_SCHED; PG8_LDA(At, 0, 0); PG8_STAGE(PG8_SA(1, 1), a1 + hstep, voffA);
            PG8_WAIT_V(8); PG8_WAIT_L(0); PG8_BAR; PG8_MMA(0, 0, At, B0); PG8_MMA(0, 1, At, B1); PG8_BAR; PG8_SCHED;
            PG8_LDA(At, 0, 1); PG8_STAGE(PG8_SB(0, 0), b2, voffB); PG8_STAGE(PG8_SB(0, 1), b2 + hstep, voffB); PG8_STAGE(PG8_SA(0, 0), a2, voffA);
            PG8_WAIT_V(8); PG8_WAIT_L(0); PG8_BAR; PG8_MMA(1, 0, At, B0); PG8_MMA(1, 1, At, B1); PG8_BAR; PG8_SCHED;
            PG8_LDB(B0, 1, 0); PG8_LDB(B1, 1, 1); PG8_SCHED; PG8_LDA(At, 1, 0); PG8_STAGE(PG8_SA(0, 1), a2 + hstep, voffA);
            PG8_WAIT_V(8); PG8_WAIT_L(0); PG8_BAR; PG8_MMA(0, 0, At, B0); PG8_MMA(0, 1, At, B1); PG8_BAR; PG8_SCHED;
            PG8_LDA(At, 1, 1); PG8_STAGE(PG8_SB(1, 0), b3, voffB); PG8_STAGE(PG8_SB(1, 1), b3 + hstep, voffB); PG8_STAGE(PG8_SA(1, 0), a3, voffA);
            PG8_WAIT_V(8); PG8_WAIT_L(0); PG8_BAR; PG8_MMA(1, 0, At, B0); PG8_MMA(1, 1, At, B1); PG8_BAR; PG8_SCHED;
            } else {
            PG8_LDB(B0, 0, 0); PG8_SCHED; PG8_LDA(At, 0, 0); PG8_STAGE(PG8_SA(1, 1), a1 + hstep, voffA);
            PG8_WAIT_L(8); PG8_BAR; PG8_WAIT_L(0); PG8_MMA(0, 0, At, B0); PG8_BAR; PG8_SCHED;
            PG8_LDB(B1, 0, 1); PG8_STAGE(PG8_SB(0, 0), b2, voffB);
            PG8_BAR; PG8_WAIT_L(0); PG8_MMA(0, 1, At, B1); PG8_BAR;
            PG8_LDA(At, 0, 1); PG8_STAGE(PG8_SA(0, 0), a2, voffA);
            PG8_BAR; PG8_WAIT_L(0); PG8_MMA(1, 0, At, B0); PG8_BAR; PG8_SCHED;
            PG8_STAGE(PG8_SB(0, 1), b2 + hstep, voffB);
            PG8_WAIT_V(6); PG8_BAR; PG8_MMA(1, 1, At, B1); PG8_BAR;
            PG8_LDB(B0, 1, 0); PG8_SCHED; PG8_LDA(At, 1, 0); PG8_STAGE(PG8_SA(0, 1), a2 + hstep, voffA);
            PG8_WAIT_L(8); PG8_BAR; PG8_WAIT_L(0); PG8_MMA(0, 0, At, B0); PG8_BAR; PG8_SCHED;
            PG8_LDB(B1, 1, 1); PG8_STAGE(PG8_SB(1, 0), b3, voffB);
            PG8_BAR; PG8_WAIT_L(0); PG8_MMA(0, 1, At, B1); PG8_BAR;
            PG8_LDA(At, 1, 1); PG8_STAGE(PG8_SA(1, 0), a3, voffA);
            PG8_BAR; PG8_WAIT_L(0); PG8_MMA(1, 0, At, B0); PG8_BAR; PG8_SCHED;
            PG8_STAGE(PG8_SB(1, 1), b3 + hstep, voffB);
            PG8_WAIT_V(6); PG8_BAR; PG8_MMA(1, 1, At, B1); PG8_BAR;
            }
        }
        if constexpr (ALIGN_EPI) { if (wr == 0) PG8_BAR; }
        if constexpr (!Epi::AFTER_DRAIN) { E(acc, cur, wr, wc, fr, fq); S.done(cur); }
        if (!has_next) break;
#pragma unroll
        for (int a = 0; a < 2; ++a)
#pragma unroll
            for (int b = 0; b < 2; ++b)
#pragma unroll
                for (int m = 0; m < 4; ++m)
#pragma unroll
                    for (int n = 0; n < 2; ++n) acc[a][b][m][n] = (f32x4){0.f, 0.f, 0.f, 0.f};
        cur = nxt; cA = nA; cB = nB; ++ui;
        if constexpr (ALIGN_EPI) { if (wr == 1) PG8_BAR; }
    }
    PG8_WAIT_V(0);
    if constexpr (!ALIGN_EPI) { if (wr == 0) PG8_BAR; }
    PG8_BAR;
    if constexpr (Epi::AFTER_DRAIN) { E.fused(acc, cur, wr, wc, fr, fq, lds, wid, lane); S.done(cur); }
#undef PG8_SA
#undef PG8_SB
#undef PG8_STAGE
#undef PG8_LDA
#undef PG8_LDB
#undef PG8_MMA
#undef PG8_WAIT_V
#undef PG8_WAIT_L
#undef PG8_BAR
#undef PG8_SCHED
}
}

namespace pg8 {
typedef _Float16 h16x8 __attribute__((ext_vector_type(8)));
typedef float f32x8 __attribute__((ext_vector_type(8)));
__device__ __forceinline__ h16x8 cvt8(f32x4 a, f32x4 b) { const f32x8 v = {a[0], a[1], a[2], a[3], b[0], b[1], b[2], b[3]}; return __builtin_convertvector(v, h16x8); }
__device__ __forceinline__ float silu1(float x) { return x * __builtin_amdgcn_rcpf(1.f + __expf(-x)); }
__device__ __forceinline__ f32x4 silu4(f32x4 x) { return (f32x4){silu1(x[0]), silu1(x[1]), silu1(x[2]), silu1(x[3])}; }

struct EpiF32 {
    static constexpr bool PERM = false, AFTER_DRAIN = false;
    float* C; int ldc;
    __device__ __forceinline__ void operator()(const f32x4 (&acc)[2][2][4][2], const Unit& u, int wr, int wc, int, int) const {
        const int lane_ = lane_id_opaque(); const int fr = lane_ & 15, fq = lane_ >> 4;
        const int row0 = u.pm * BM + wr * 64 + fr, col0 = u.pn * BM + wc * 32 + 4 * fq;
#pragma unroll
        for (int ai = 0; ai < 2; ++ai)
#pragma unroll
            for (int m = 0; m < 4; ++m) { float* rowp = C + (size_t)(row0 + ai * HALF + m * 16) * ldc + col0;
#pragma unroll
                for (int bj = 0; bj < 2; ++bj)
#pragma unroll
                    for (int n = 0; n < 2; ++n) *(f32x4*)(rowp + bj * HALF + n * 16) = acc[ai][bj][m][n]; }
    }
};
struct EpiF16 {
    static constexpr bool PERM = true, AFTER_DRAIN = false;
    f16* C; int ldc;
    __device__ __forceinline__ void operator()(const f32x4 (&acc)[2][2][4][2], const Unit& u, int wr, int wc, int, int) const {
        const int lane_ = lane_id_opaque(); const int fr = lane_ & 15, fq = lane_ >> 4;
        const int row0 = u.pm * BM + wr * 64 + fr, col0 = u.pn * BM + wc * 32 + 8 * fq;
#pragma unroll
        for (int ai = 0; ai < 2; ++ai)
#pragma unroll
            for (int m = 0; m < 4; ++m) { f16* rowp = C + (unsigned)((row0 + ai * HALF + m * 16) * ldc + col0);
                st16_wt<0>(rowp, __builtin_bit_cast(u32x4, cvt8(acc[ai][0][m][0], acc[ai][0][m][1]))); st16_wt<HALF * 2>(rowp, __builtin_bit_cast(u32x4, cvt8(acc[ai][1][m][0], acc[ai][1][m][1]))); }
    }
};
struct EpiSwiGLU {
    static constexpr bool PERM = true, AFTER_DRAIN = false;
    f16* act;
    __device__ __forceinline__ void operator()(const f32x4 (&acc)[2][2][4][2], const Unit& u, int wr, int wc, int, int) const {
        const int lane_ = lane_id_opaque(); const int fr = lane_ & 15, fq = lane_ >> 4;
        const int row0 = u.pm * BM + wr * 64 + fr, col0 = u.pn * 128 + wc * 32 + 8 * fq;
#pragma unroll
        for (int ai = 0; ai < 2; ++ai)
#pragma unroll
            for (int m = 0; m < 4; ++m) {
                const f32x4 o0 = silu4(acc[ai][0][m][0]) * acc[ai][1][m][0], o1 = silu4(acc[ai][0][m][1]) * acc[ai][1][m][1];
                st16_wt(act + (unsigned)((row0 + ai * HALF + m * 16) * FF + col0), op_pk8(o0, o1)); asm volatile("" ::: "memory"); }
    }
};
struct EpiHgrn {
    static constexpr bool PERM = true, AFTER_DRAIN = false;
    f16* qh; f16* kh; u16* vh; f16* gh; float* lf; const float* lb;
    __device__ __forceinline__ void operator()(const f32x4 (&acc)[2][2][4][2], const Unit& u, int wr, int wc, int, int) const {
        const int lane_ = lane_id_opaque(); const int fr = lane_ & 15, fq = lane_ >> 4;
        const int grp = (u.pn >> 2) & 3, row0 = u.pm * BM + wr * 64 + fr, col0 = ((u.pn & 3) + 4 * (u.pn >> 4)) * BM + wc * 32 + 8 * fq;
        if (grp == 1) {
#pragma unroll
            for (int bj = 0; bj < 2; ++bj) {
                const f32x4 lba = *(const f32x4*)(lb + col0 + bj * HALF), lbb = *(const f32x4*)(lb + col0 + bj * HALF + 4);
#pragma unroll
                for (int ai = 0; ai < 2; ++ai)
#pragma unroll
                    for (int m = 0; m < 4; ++m) { const unsigned ro = (unsigned)(row0 + ai * HALF + m * 16) * DM + col0 + bj * HALF; f32x4 kk[2], lg[2];
#pragma unroll
                        for (int n = 0; n < 2; ++n)
#pragma unroll
                            for (int j = 0; j < 4; ++j) { const float l = n ? lbb[j] : lba[j]; const float sg = __builtin_amdgcn_rcpf(1.f + __expf(-acc[ai][bj][m][n][j])); const float fg = l + (1.f - l) * sg;
                                kk[n][j] = 1.f - fg; lg[n][j] = __logf(fg); }
                        st16_wt<0>(kh + ro, __builtin_bit_cast(u32x4, cvt8(kk[0], kk[1])));
                        st16_wt<0>(lf + ro, __builtin_bit_cast(u32x4, lg[0])); st16_wt<16>(lf + ro, __builtin_bit_cast(u32x4, lg[1]));
                        asm volatile("" ::: "memory"); }
            }
        } else if (grp == 2) {
#pragma unroll
            for (int ai = 0; ai < 2; ++ai)
#pragma unroll
                for (int m = 0; m < 4; ++m) { const unsigned ro = (unsigned)(row0 + ai * HALF + m * 16) * DM + col0;
#pragma unroll
                    for (int bj = 0; bj < 2; ++bj) { const f32x4 a = acc[ai][bj][m][0], b = acc[ai][bj][m][1];
                        u32x4 w; w.x = f2bf(a[0]) | ((unsigned)f2bf(a[1]) << 16); w.y = f2bf(a[2]) | ((unsigned)f2bf(a[3]) << 16); w.z = f2bf(b[0]) | ((unsigned)f2bf(b[1]) << 16); w.w = f2bf(b[2]) | ((unsigned)f2bf(b[3]) << 16);
                        if (bj == 0) st16_wt<0>(vh + ro, w); else st16_wt<HALF * 2>(vh + ro, w); } }
        } else {
            f16* dst = grp == 0 ? qh : gh;
#pragma unroll
            for (int ai = 0; ai < 2; ++ai)
#pragma unroll
                for (int m = 0; m < 4; ++m) { const unsigned ro = (unsigned)(row0 + ai * HALF + m * 16) * DM + col0;
                    st16_wt<0>(dst + ro, __builtin_bit_cast(u32x4, cvt8(silu4(acc[ai][0][m][0]), silu4(acc[ai][0][m][1])))); st16_wt<HALF * 2>(dst + ro, __builtin_bit_cast(u32x4, cvt8(silu4(acc[ai][1][m][0]), silu4(acc[ai][1][m][1])))); }
        }
    }
};
struct EpiRot {
    static constexpr bool PERM = true, AFTER_DRAIN = false;
    f16* dst; int nheads; const float* rope; float* kmean; f16* vdst; int nrot;
    __device__ __forceinline__ void operator()(const f32x4 (&acc)[2][2][4][2], const Unit& u, int wr, int wc, int, int) const {
        const int lane_ = lane_id_opaque(); const int fr = lane_ & 15, fq = lane_ >> 4;
        const int b = u.pm >> 4, t0 = (u.pm & 15) * BM + wr * 64 + fr;
        if (u.pn < nrot) {
            const int head = 2 * u.pn + (wc >> 1), dd0 = 32 * (wc & 1) + 8 * fq;
            f16* base = dst + ((size_t)(b * nheads + head) * SEQ) * 128 + dd0;
            f32x4 s1a = {0.f, 0.f, 0.f, 0.f}, s1b = s1a, s2a = s1a, s2b = s1a;
#pragma unroll
            for (int ai = 0; ai < 2; ++ai)
#pragma unroll
                for (int m = 0; m < 4; ++m) { const int t = t0 + ai * HALF + m * 16;
                    const f32x4 c0 = *(const f32x4*)(rope + t * 64 + dd0), c1 = *(const f32x4*)(rope + t * 64 + dd0 + 4), s0 = *(const f32x4*)(rope + SEQ * 64 + t * 64 + dd0), s1 = *(const f32x4*)(rope + SEQ * 64 + t * 64 + dd0 + 4);
                    const f32x4 xa = acc[ai][0][m][0], xb = acc[ai][0][m][1], ya = acc[ai][1][m][0], yb = acc[ai][1][m][1];
                    const f32x4 o1a = xa * c0 - ya * s0, o1b = xb * c1 - yb * s1, o2a = ya * c0 + xa * s0, o2b = yb * c1 + xb * s1;
                    *(h16x8*)(base + (size_t)t * 128) = cvt8(o1a, o1b); *(h16x8*)(base + (size_t)t * 128 + 64) = cvt8(o2a, o2b);
                    s1a += o1a; s1b += o1b; s2a += o2a; s2b += o2b; }
            if (kmean) {
#pragma unroll
                for (int j = 0; j < 4; ++j) {
#pragma unroll
                    for (int o = 1; o < 16; o <<= 1) { s1a[j] += __shfl_xor(s1a[j], o); s1b[j] += __shfl_xor(s1b[j], o); s2a[j] += __shfl_xor(s2a[j], o); s2b[j] += __shfl_xor(s2b[j], o); } }
                if (fr == 0) { float* km = kmean + ((size_t)(b * nheads + head) * NBLK + (u.pm & 15)) * 128 + dd0;
#pragma unroll
                    for (int j = 0; j < 4; ++j) { atomicAdd(km + j, s1a[j] * (1.f / MBLK)); atomicAdd(km + 4 + j, s1b[j] * (1.f / MBLK)); atomicAdd(km + 64 + j, s2a[j] * (1.f / MBLK)); atomicAdd(km + 68 + j, s2b[j] * (1.f / MBLK)); } }
            }
        } else {
            const int d0 = 32 * wc + 8 * fq;
#pragma unroll
            for (int bj = 0; bj < 2; ++bj) { f16* base = vdst + ((size_t)(b * nheads + 2 * (u.pn - nrot) + bj) * SEQ) * 128 + d0;
#pragma unroll
                for (int ai = 0; ai < 2; ++ai)
#pragma unroll
                    for (int m = 0; m < 4; ++m) *(h16x8*)(base + (size_t)(t0 + ai * HALF + m * 16) * 128) = cvt8(acc[ai][bj][m][0], acc[ai][bj][m][1]); }
        }
    }
};
}

__global__ __launch_bounds__(256) void k_naive_gemm(const f16* __restrict__ A, const float* __restrict__ W, float* __restrict__ C, int N, int K) {
    __shared__ float As[16][132];
    __shared__ float Bs[16][132];
    const int tid = threadIdx.x, tx = tid & 15, ty = tid >> 4;
    const int bm = blockIdx.y * 128, bn = blockIdx.x * 128;
    float acc[8][8];
#pragma unroll
    for (int i = 0; i < 8; ++i)
#pragma unroll
        for (int j = 0; j < 8; ++j) acc[i][j] = 0.f;
    const int ar = tid >> 1, ac = (tid & 1) * 8;
    const int br = tid >> 4, bc = (tid & 15) * 8;
    for (int k0 = 0; k0 < K; k0 += 16) {
        const f16x8 av = *(const f16x8*)(A + (size_t)(bm + ar) * K + k0 + ac);
        const f32x4 b0 = *(const f32x4*)(W + (size_t)(k0 + br) * N + bn + bc), b1 = *(const f32x4*)(W + (size_t)(k0 + br) * N + bn + bc + 4);
        __syncthreads();
#pragma unroll
        for (int i = 0; i < 8; ++i) As[ac + i][ar] = (float)av[i];
        *(f32x4*)&Bs[br][bc] = b0; *(f32x4*)&Bs[br][bc + 4] = b1;
        __syncthreads();
#pragma unroll
        for (int kk = 0; kk < 16; ++kk) {
            float a[8], b[8];
            const f32x4 a0 = *(const f32x4*)&As[kk][ty * 8], a1 = *(const f32x4*)&As[kk][ty * 8 + 4];
            const f32x4 bb0 = *(const f32x4*)&Bs[kk][tx * 8], bb1 = *(const f32x4*)&Bs[kk][tx * 8 + 4];
            a[0] = a0.x; a[1] = a0.y; a[2] = a0.z; a[3] = a0.w; a[4] = a1.x; a[5] = a1.y; a[6] = a1.z; a[7] = a1.w;
            b[0] = bb0.x; b[1] = bb0.y; b[2] = bb0.z; b[3] = bb0.w; b[4] = bb1.x; b[5] = bb1.y; b[6] = bb1.z; b[7] = bb1.w;
#pragma unroll
            for (int i = 0; i < 8; ++i)
#pragma unroll
                for (int j = 0; j < 8; ++j) acc[i][j] += a[i] * b[j];
        }
    }
#pragma unroll
    for (int i = 0; i < 8; ++i) {
        float* cp = C + (size_t)(bm + ty * 8 + i) * N + bn + tx * 8;
        *(f32x4*)cp = (f32x4){acc[i][0], acc[i][1], acc[i][2], acc[i][3]}; *(f32x4*)(cp + 4) = (f32x4){acc[i][4], acc[i][5], acc[i][6], acc[i][7]};
    }
}
__global__ void k_naive_ffn_act(const float* __restrict__ C, f16* __restrict__ act) {
    const size_t i = (size_t)blockIdx.x * blockDim.x + threadIdx.x;
    if (i >= (size_t)M * FF) return;
    const size_t m = i / FF, j = i % FF;
    act[i] = (f16)(silu_f(C[m * (2 * FF) + j]) * C[m * (2 * FF) + FF + j]);
}
__global__ void k_naive_hgrn_split(const float* __restrict__ C, const float* __restrict__ hgrn_lb, f16* __restrict__ qh, f16* __restrict__ kh, u16* __restrict__ vh, f16* __restrict__ gh, float* __restrict__ lf) {
    const size_t i = (size_t)blockIdx.x * blockDim.x + threadIdx.x;
    if (i >= (size_t)M * DM) return;
    const size_t m = i / DM, j = i % DM;
    const float* c = C + m * (4 * DM);
    const float l0 = hgrn_lb[j], l1 = hgrn_lb[DM + j];
    const float lb = 1.f / (1.f + expf(l1 - l0));
    const float sg = 1.f / (1.f + expf(-c[DM + j]));
    const float forget = lb + (1.f - lb) * sg;
    qh[i] = (f16)silu_f(c[j]);
    kh[i] = (f16)(1.f - forget);
    lf[i] = logf(forget);
    vh[i] = f2bf(c[2 * DM + j]);
    gh[i] = (f16)silu_f(c[3 * DM + j]);
}
__global__ __launch_bounds__(128) void k_naive_scan(const f16* __restrict__ qh, const f16* __restrict__ kh, const u16* __restrict__ vh, const f16* __restrict__ gh, const float* __restrict__ lf,
                                                   const float* __restrict__ gnorm, f16* __restrict__ og) {
    __shared__ float qs[8][128], ks[8][128], fs[8][128];
    __shared__ float red[2];
    const int b = blockIdx.x / NH, h = blockIdx.x % NH, e = threadIdx.x;
    float S[128];
#pragma unroll
    for (int d = 0; d < 128; ++d) S[d] = 0.f;
    const float gn = gnorm[e];
    for (int t0 = 0; t0 < SEQ; t0 += 8) {
        __syncthreads();
#pragma unroll
        for (int i = 0; i < 8; ++i) { const size_t o = (size_t)(b * SEQ + t0 + i) * DM + h * 128 + e; qs[i][e] = (float)qh[o]; ks[i][e] = (float)kh[o]; fs[i][e] = __expf(lf[o]); }
        __syncthreads();
        for (int i = 0; i < 8; ++i) {
            const size_t o = (size_t)(b * SEQ + t0 + i) * DM + h * 128 + e;
            const float v = bf2f(vh[o]);
            float acc = 0.f;
#pragma unroll
            for (int d = 0; d < 128; d += 4) {
                const f32x4 f = *(const f32x4*)&fs[i][d], k = *(const f32x4*)&ks[i][d], q = *(const f32x4*)&qs[i][d];
                S[d] = f.x * S[d] + k.x * v; S[d + 1] = f.y * S[d + 1] + k.y * v; S[d + 2] = f.z * S[d + 2] + k.z * v; S[d + 3] = f.w * S[d + 3] + k.w * v;
                acc += S[d] * q.x + S[d + 1] * q.y + S[d + 2] * q.z + S[d + 3] * q.w;
            }
            const float ss = wave_sum(acc * acc);
            __syncthreads();
            if ((e & 63) == 0) red[e >> 6] = ss;
            __syncthreads();
            const float rstd = rsqrtf((red[0] + red[1]) * (1.f / 128.f) + EPS);
            og[o] = (f16)(acc * rstd * gn * (float)gh[o]);
        }
    }
}
__global__ void k_naive_kv_split(const float* __restrict__ C, const float* __restrict__ rope, f16* __restrict__ K, f16* __restrict__ V) {
    const size_t i = (size_t)blockIdx.x * blockDim.x + threadIdx.x;
    if (i >= (size_t)M * 512) return;
    const int m = (int)(i / 512), j = (int)(i % 512), hh = j / 128, d = j % 128, b = m / SEQ, t = m % SEQ;
    const float* c = C + (size_t)m * 1024;
    const int dd = d & 63; const float cs = rope[t * 64 + dd], sn = rope[SEQ * 64 + t * 64 + dd];
    const float x1 = c[hh * 128 + dd], x2 = c[hh * 128 + dd + 64];
    const float r = d < 64 ? x1 * cs - x2 * sn : x2 * cs + x1 * sn;
    const size_t o = ((size_t)(b * NKV + hh) * SEQ + t) * 128 + d;
    K[o] = (f16)r; V[o] = (f16)c[512 + j];
}
__global__ void k_naive_kmean(const float* __restrict__ C, const float* __restrict__ rope, float* __restrict__ kmean) {
    const int i = blockIdx.x * blockDim.x + threadIdx.x;
    if (i >= BATCH * NKV * NBLK * 128) return;
    const int d = i % 128, blk = (i / 128) % NBLK, hh = (i / (128 * NBLK)) % NKV, b = i / (128 * NBLK * NKV);
    const int dd = d & 63; float s = 0.f;
    for (int tt = 0; tt < MBLK; ++tt) { const int t = blk * MBLK + tt; const float* c = C + (size_t)(b * SEQ + t) * 1024;
        const float cs = rope[t * 64 + dd], sn = rope[SEQ * 64 + t * 64 + dd], x1 = c[hh * 128 + dd], x2 = c[hh * 128 + dd + 64];
        s += d < 64 ? x1 * cs - x2 * sn : x2 * cs + x1 * sn; }
    kmean[i] = s * (1.f / MBLK);
}
__global__ void k_naive_q_split(const float* __restrict__ C, const float* __restrict__ rope, f16* __restrict__ Q) {
    const size_t i = (size_t)blockIdx.x * blockDim.x + threadIdx.x;
    if (i >= (size_t)M * DM) return;
    const int m = (int)(i / DM), j = (int)(i % DM), hh = j / 128, d = j % 128, b = m / SEQ, t = m % SEQ;
    const float* c = C + (size_t)m * DM;
    const int dd = d & 63; const float cs = rope[t * 64 + dd], sn = rope[SEQ * 64 + t * 64 + dd];
    const float x1 = c[hh * 128 + dd], x2 = c[hh * 128 + dd + 64];
    const float r = d < 64 ? x1 * cs - x2 * sn : x2 * cs + x1 * sn;
    Q[((size_t)(b * NH + hh) * SEQ + t) * 128 + d] = (f16)r;
}
__global__ __launch_bounds__(256) void k_naive_attn(const f16* __restrict__ Q, const f16* __restrict__ K, const f16* __restrict__ V, const float* __restrict__ kmean, f16* __restrict__ O) {
    __shared__ float qs[4][128];
    __shared__ float sc[4][4 * MBLK];
    const int w = threadIdx.x >> 6, lane = threadIdx.x & 63;
    const int qi = blockIdx.x * 4 + w;
    const int t = qi % SEQ, bh = qi / SEQ, h = bh % NH, b = bh / NH, kvh = h / (NH / NKV), own = t / MBLK;
    const f16* q = Q + (size_t)qi * 128;
    qs[w][lane] = (float)q[lane]; qs[w][lane + 64] = (float)q[lane + 64];
    __syncthreads();
    float g = -__builtin_inff();
    if (lane < own) { const float* km = kmean + ((size_t)(b * NKV + kvh) * NBLK + lane) * 128; float s = 0.f; for (int d = 0; d < 128; ++d) s += qs[w][d] * km[d]; g = s; }
    int b0 = 0, b1 = 0, b2 = 0, b3 = 0; const int nsel = own < 3 ? own : 3;
    for (int s = 0; s < 3; ++s) {
        float best = g; int bi = lane;
#pragma unroll
        for (int o = 1; o < 64; o <<= 1) { const float ob = __shfl_xor(best, o); const int oi = __shfl_xor(bi, o); if (ob > best || (ob == best && oi < bi)) { best = ob; bi = oi; } }
        if (s == 0) b0 = bi; else if (s == 1) b1 = bi; else b2 = bi;
        if (lane == bi) g = -__builtin_inff();
    }
    if (nsel == 0) b0 = own; else if (nsel == 1) b1 = own; else if (nsel == 2) b2 = own; else b3 = own;
    const int nb = nsel + 1;
#define BLK_OF(s) ((s) == 0 ? b0 : (s) == 1 ? b1 : (s) == 2 ? b2 : b3)
    const f16* Kb = K + (size_t)(b * NKV + kvh) * SEQ * 128; const f16* Vb = V + (size_t)(b * NKV + kvh) * SEQ * 128;
    float mx = -__builtin_inff();
    for (int s = 0; s < nb; ++s) {
        const int blk = BLK_OF(s);
        for (int kk = lane; kk < MBLK; kk += 64) {
            const int key = blk * MBLK + kk; float a = -__builtin_inff();
            if (key <= t) { const f16x8* kr = (const f16x8*)(Kb + (size_t)key * 128); float acc = 0.f;
                for (int d8 = 0; d8 < 16; ++d8) { const f16x8 kv = kr[d8];
#pragma unroll
                    for (int j = 0; j < 8; ++j) acc += qs[w][d8 * 8 + j] * (float)kv[j]; }
                a = acc * ATT_SCALE; }
            sc[w][s * MBLK + kk] = a; mx = fmaxf(mx, a);
        }
    }
#pragma unroll
    for (int o = 1; o < 64; o <<= 1) mx = fmaxf(mx, __shfl_xor(mx, o));
    float sum = 0.f;
    for (int i = lane; i < nb * MBLK; i += 64) { const float p = __expf(sc[w][i] - mx); sc[w][i] = p; sum += p; }
    sum = wave_sum(sum);
    __syncthreads();
    float o0 = 0.f, o1 = 0.f;
    for (int s = 0; s < nb; ++s) { const int blk = BLK_OF(s);
        for (int kk = 0; kk < MBLK; ++kk) { const float p = sc[w][s * MBLK + kk]; if (p != 0.f) { const f16x2 vv = *(const f16x2*)(Vb + (size_t)(blk * MBLK + kk) * 128 + 2 * lane); o0 += p * (float)vv[0]; o1 += p * (float)vv[1]; } } }
    const float inv = 1.f / sum;
    f16x2 ov; ov[0] = (f16)(o0 * inv); ov[1] = (f16)(o1 * inv);
    *(f16x2*)(O + (size_t)(b * SEQ + t) * DM + h * 128 + 2 * lane) = ov;
}


#define XB_TMO      128
#define XB_XCNT(j)  (256  + 64 * (j))
#define XB_XSUB(j)  (1280 + 64 * (j))
#define XB_XGEN(j)  (2304 + 64 * (j))
#define XB_TOP      3328
#define XB_TOPGEN   3392
#define XCD_BAR_WORDS 3456
#define XB_SPIN_CAP (1u << 18)

__device__ __forceinline__ unsigned xb_ld(unsigned* p)              { return __hip_atomic_load(p, __ATOMIC_RELAXED, __HIP_MEMORY_SCOPE_AGENT); }
__device__ __forceinline__ unsigned xb_add(unsigned* p, unsigned v) { return __hip_atomic_fetch_add(p, v, __ATOMIC_RELAXED, __HIP_MEMORY_SCOPE_AGENT); }
__device__ __forceinline__ unsigned xb_xcc_id() { return (unsigned)__builtin_amdgcn_s_getreg((3 << 11) | 20) & 0xFu; }
#define XB_SPIN(cond, bar) do { unsigned _sp = 0; while (cond) { __builtin_amdgcn_s_sleep(1); \
    if ((++_sp & 255u) == 0u) { if (xb_ld(&(bar)[XB_TMO])) break; if (_sp > XB_SPIN_CAP) { atomicAdd(&(bar)[XB_TMO], 1u); break; } } } } while (0)

struct XcdBarrier {
    unsigned* bar; unsigned x;
    volatile LAS unsigned* st;
};

__device__ __forceinline__ XcdBarrier xcd_barrier_post(unsigned* bar, volatile LAS unsigned* st) {
    XcdBarrier b; b.bar = bar; b.x = xb_xcc_id(); b.st = st;
    if (threadIdx.x == 0) (void)xb_add(&bar[XB_XCNT(b.x)], 1u);
    return b;
}
__device__ __forceinline__ void xcd_barrier_complete(unsigned* bar, unsigned x, unsigned& nloc, unsigned& nx) {
    const unsigned G = gridDim.x * gridDim.y * gridDim.z;
    unsigned sum, cnt, mine, sp = 0u;
    for (;;) {
        sum = 0u; cnt = 0u; mine = 0u;
#pragma unroll
        for (unsigned j = 0; j < 16; ++j) { const unsigned c = xb_ld(&bar[XB_XCNT(j)]); sum += c; cnt += (c > 0u) ? 1u : 0u; mine = (j == x) ? c : mine; }
        if (sum == G) break;
        __builtin_amdgcn_s_sleep(1);
        if ((++sp & 255u) == 0u) { if (xb_ld(&bar[XB_TMO])) break; if (sp > XB_SPIN_CAP) { atomicAdd(&bar[XB_TMO], 1u); break; } }
    }
    nloc = mine > 0u ? mine : 1u; nx = cnt > 0u ? cnt : 1u;
}

__device__ __forceinline__ void xcd_barrier(const XcdBarrier& b, const int wave  ) {
    asm volatile("s_waitcnt vmcnt(0)" ::: "memory");
    __syncthreads();
    if (wave == 0 && lane_id_opaque() == 0) {
        unsigned* bar = b.bar;
        __builtin_amdgcn_s_waitcnt(0);
        unsigned nloc = b.st[0], nx = b.st[1];
        if (nloc == 0u) { xcd_barrier_complete(bar, b.x, nloc, nx); b.st[0] = nloc; b.st[1] = nx; }
        const unsigned old = xb_add(&bar[XB_XSUB(b.x)], 1u);
        const unsigned gen = old / nloc;
        if (old + 1u == (gen + 1u) * nloc) {
            __builtin_amdgcn_fence(__ATOMIC_RELEASE, "agent");
            asm volatile("s_waitcnt vmcnt(0)" ::: "memory");
            const unsigned og = xb_add(&bar[XB_TOP], 1u);
            const unsigned tg = og / nx;
            if (og + 1u == (tg + 1u) * nx) xb_add(&bar[XB_TOPGEN], 1u);
            else XB_SPIN(xb_ld(&bar[XB_TOPGEN]) == tg, bar);
            __builtin_amdgcn_fence(__ATOMIC_ACQUIRE, "agent");
            xb_add(&bar[XB_XGEN(b.x)], 1u);
            asm volatile("s_waitcnt vmcnt(0)" ::: "memory");
        } else {
            XB_SPIN(xb_ld(&bar[XB_XGEN(b.x)]) == gen, bar);
            __builtin_amdgcn_fence(__ATOMIC_ACQUIRE, "agent");
            asm volatile("s_waitcnt vmcnt(0)" ::: "memory");
        }
    }
    __syncthreads();
}

namespace scan {
typedef short bf16x8 __attribute__((ext_vector_type(8)));
typedef short bf16x4 __attribute__((ext_vector_type(4)));
typedef unsigned u32x2 __attribute__((ext_vector_type(2)));
constexpr int QT_STRIDE = 272, KT_STRIDE = 144, OB_STRIDE = 132;
constexpr int SC_QT = 0, SC_KH = 17408, SC_KTT = 34816, SC_VT = 53248, SC_P = 71680, SC_AL = 80896, SC_TW = 81408, SC_OB = 85504, SC_END = SC_OB + 64 * OB_STRIDE * 4;
static_assert(SC_END <= 131072, "scan LDS map");
constexpr size_t ST_ATOT = (size_t)256 * 16384;
__device__ __forceinline__ unsigned pkbf(float lo, float hi) { unsigned r; asm volatile("v_cvt_pk_bf16_f32 %0, %1, %2" : "=v"(r) : "v"(lo), "v"(hi)); return r; }
#define MFMA16(a, b, c) __builtin_amdgcn_mfma_f32_16x16x32_bf16((a), (b), (c), 0, 0, 0)

template <bool PHASE_A>
__device__ __forceinline__ void scan_unit(LAS unsigned char* lds, const int u, const int w, const int lane, const f16* __restrict__ QH, const f16* __restrict__ KH, const u16* __restrict__ VH,
                                          const f16* __restrict__ GH, const float* __restrict__ LF, const float* __restrict__ gnorm, float* __restrict__ ST, f16* __restrict__ OG) {
    const int bh = u >> 3, sc = u & 7, b = bh >> 4, h = bh & 15, fl = lane & 15, g = lane >> 4, tid = w * 64 + lane;
    const size_t tok0 = (size_t)b * SEQ + (size_t)sc * 512;
    const size_t eoff = (size_t)h * 128 + 2 * lane;
    LAS unsigned char* Qt = lds + SC_QT; LAS unsigned char* Kh = lds + SC_KH; LAS unsigned char* KtT = lds + SC_KTT; LAS unsigned char* VT = lds + SC_VT; LAS unsigned char* P = lds + SC_P;
    LAS float* AL = (LAS float*)(lds + SC_AL); LAS float* TW = (LAS float*)(lds + SC_TW); LAS float* OB = (LAS float*)(lds + SC_OB);
    f32x4 X[8];
    float* STu = ST + (size_t)u * 16384;
    if (PHASE_A) {
#pragma unroll
        for (int i = 0; i < 8; ++i) X[i] = (f32x4){0.f, 0.f, 0.f, 0.f};
    } else {
#pragma unroll
        for (int i = 0; i < 8; ++i)
#pragma unroll
            for (int r = 0; r < 4; ++r) X[i][r] = STu[(16 * i + 4 * g + r) * 128 + 16 * w + fl];
    }
    float cs0 = 0.f, cs1 = 0.f;
    unsigned rq[8], rk[8], rv[8]; f32x2 rl[8]; f16x8 rg0, rg1;
    const int et = tid >> 3, ees = (tid & 7) * 16;
#define SCAN_LOAD(c) do { _Pragma("unroll") for (int i = 0; i < 8; ++i) { const size_t o = (tok0 + (size_t)(c) * 64 + 8 * w + i) * DM + eoff; \
        if (!PHASE_A) rq[i] = *(const unsigned*)(QH + o); rk[i] = *(const unsigned*)(KH + o); rv[i] = *(const unsigned*)(VH + o); rl[i] = *(const f32x2*)(LF + o); } } while (0)
#define SCAN_LOAD_G(c) do { if (!PHASE_A) { const size_t go = (tok0 + (size_t)(c) * 64 + et) * DM + (size_t)h * 128 + ees; rg0 = *(const f16x8*)(GH + go); rg1 = *(const f16x8*)(GH + go + 8); } } while (0)
    SCAN_LOAD(0); SCAN_LOAD_G(0);
    for (int c = 0; c < 8; ++c) {
        { float r0 = 0.f, r1 = 0.f;
#pragma unroll
            for (int i = 0; i < 8; ++i) { r0 += rl[i].x; r1 += rl[i].y; }
            *(LAS f32x2*)(TW + w * 128 + 2 * lane) = (f32x2){r0, r1}; }
        __syncthreads();
        float off0 = 0.f, off1 = 0.f, tot0 = 0.f, tot1 = 0.f;
#pragma unroll
        for (int ww = 0; ww < 8; ++ww) { const f32x2 t = *(const LAS f32x2*)(TW + ww * 128 + 2 * lane); if (ww < w) { off0 += t.x; off1 += t.y; } tot0 += t.x; tot1 += t.y; }
        unsigned kt0[4], kt1[4], vt0[4], vt1[4]; float cu0 = off0, cu1 = off1;
#pragma unroll
        for (int i = 0; i < 8; ++i) {
            cu0 += rl[i].x; cu1 += rl[i].y;
            const f16x2 kk = __builtin_bit_cast(f16x2, rk[i]); const float k0 = (float)kk[0], k1 = (float)kk[1];
            const float t0 = k0 * __expf(tot0 - cu0), t1 = k1 * __expf(tot1 - cu1);
            if (!PHASE_A) {
                const f16x2 qq = __builtin_bit_cast(f16x2, rq[i]);
                *(LAS unsigned*)(Qt + (8 * w + i) * QT_STRIDE + 4 * lane) = pkbf((float)qq[0] * __expf(cu0), (float)qq[1] * __expf(cu1));
                *(LAS unsigned*)(Kh + (8 * w + i) * QT_STRIDE + 4 * lane) = pkbf(k0 * __expf(-cu0), k1 * __expf(-cu1));
            }
            if (i & 1) { kt0[i >> 1] |= (pkbf(t0, 0.f) << 16); kt1[i >> 1] |= (pkbf(t1, 0.f) << 16); vt0[i >> 1] |= (rv[i] << 16); vt1[i >> 1] |= (rv[i] & 0xffff0000u); }
            else { kt0[i >> 1] = pkbf(t0, 0.f) & 0xffffu; kt1[i >> 1] = pkbf(t1, 0.f) & 0xffffu; vt0[i >> 1] = rv[i] & 0xffffu; vt1[i >> 1] = rv[i] >> 16; }
        }
        *(LAS u32x4*)(KtT + (2 * lane) * KT_STRIDE + 16 * w) = (u32x4){kt0[0], kt0[1], kt0[2], kt0[3]};
        *(LAS u32x4*)(KtT + (2 * lane + 1) * KT_STRIDE + 16 * w) = (u32x4){kt1[0], kt1[1], kt1[2], kt1[3]};
        *(LAS u32x4*)(VT + (2 * lane) * KT_STRIDE + 16 * w) = (u32x4){vt0[0], vt0[1], vt0[2], vt0[3]};
        *(LAS u32x4*)(VT + (2 * lane + 1) * KT_STRIDE + 16 * w) = (u32x4){vt1[0], vt1[1], vt1[2], vt1[3]};
        if (w == 0) *(LAS f32x2*)(AL + 2 * lane) = (f32x2){__expf(tot0), __expf(tot1)};
        cs0 += tot0; cs1 += tot1;
        if (c + 1 < 8) SCAN_LOAD(c + 1);
        __syncthreads();
        f32x4 Y[4];
        if (!PHASE_A) {
            const int ti = w >> 1;
#pragma unroll
            for (int sx = 0; sx < 2; ++sx) { const int si = 2 * (w & 1) + sx; f32x4 z = {0.f, 0.f, 0.f, 0.f};
                if (si <= ti) {
#pragma unroll
                    for (int kd = 0; kd < 4; ++kd) { const bf16x8 a = *(const LAS bf16x8*)(Kh + (16 * si + fl) * QT_STRIDE + (32 * kd + 8 * g) * 2), bq = *(const LAS bf16x8*)(Qt + (16 * ti + fl) * QT_STRIDE + (32 * kd + 8 * g) * 2);
                        z = MFMA16(a, bq, z); }
                    const int t = 16 * ti + fl, s0 = 16 * si + 4 * g;
#pragma unroll
                    for (int r = 0; r < 4; ++r) z[r] = (s0 + r <= t) ? z[r] : 0.f;
                }
                *(LAS u32x2*)(P + (16 * ti + fl) * KT_STRIDE + (16 * si + 4 * g) * 2) = (u32x2){pkbf(z[0], z[1]), pkbf(z[2], z[3])}; }
#pragma unroll
            for (int jt = 0; jt < 4; ++jt) Y[jt] = (f32x4){0.f, 0.f, 0.f, 0.f};
#pragma unroll
            for (int i = 0; i < 4; ++i) { const u32x4 aw = {pkbf(X[2 * i][0], X[2 * i][1]), pkbf(X[2 * i][2], X[2 * i][3]), pkbf(X[2 * i + 1][0], X[2 * i + 1][1]), pkbf(X[2 * i + 1][2], X[2 * i + 1][3])};
                const bf16x8 af = __builtin_bit_cast(bf16x8, aw);
#pragma unroll
                for (int jt = 0; jt < 4; ++jt) { const u32x2 lo = *(const LAS u32x2*)(Qt + (16 * jt + fl) * QT_STRIDE + (32 * i + 4 * g) * 2), hi = *(const LAS u32x2*)(Qt + (16 * jt + fl) * QT_STRIDE + (32 * i + 16 + 4 * g) * 2);
                    const u32x4 bw = {lo.x, lo.y, hi.x, hi.y}; Y[jt] = MFMA16(af, __builtin_bit_cast(bf16x8, bw), Y[jt]); } }
            __syncthreads();
        }
        bf16x8 vf[2];
#pragma unroll
        for (int ks = 0; ks < 2; ++ks) vf[ks] = *(const LAS bf16x8*)(VT + (16 * w + fl) * KT_STRIDE + (32 * ks + 8 * g) * 2);
        if (!PHASE_A) {
#pragma unroll
            for (int jt = 0; jt < 4; ++jt)
#pragma unroll
                for (int ks = 0; ks < 2; ++ks) if (32 * ks <= 16 * jt + 15) { const bf16x8 pf = *(const LAS bf16x8*)(P + (16 * jt + fl) * KT_STRIDE + (32 * ks + 8 * g) * 2); Y[jt] = MFMA16(vf[ks], pf, Y[jt]); }
#pragma unroll
            for (int jt = 0; jt < 4; ++jt) *(LAS f32x4*)(OB + (16 * jt + fl) * OB_STRIDE + 16 * w + 4 * g) = Y[jt];
        }
#pragma unroll
        for (int i = 0; i < 8; ++i) { X[i] = X[i] * *(const LAS f32x4*)(AL + 16 * i + 4 * g);
#pragma unroll
            for (int ks = 0; ks < 2; ++ks) { const bf16x8 a = *(const LAS bf16x8*)(KtT + (16 * i + fl) * KT_STRIDE + (32 * ks + 8 * g) * 2); X[i] = MFMA16(a, vf[ks], X[i]); } }
        __syncthreads();
        if (!PHASE_A) {
            const int t = et, es = ees; f32x4 o[4]; float ss = 0.f;
#pragma unroll
            for (int q = 0; q < 4; ++q) { o[q] = *(const LAS f32x4*)(OB + t * OB_STRIDE + es + 4 * q); ss += (o[q][0] * o[q][0] + o[q][1] * o[q][1]) + (o[q][2] * o[q][2] + o[q][3] * o[q][3]); }
            ss += __shfl_xor(ss, 1); ss += __shfl_xor(ss, 2); ss += __shfl_xor(ss, 4);
            const float rstd = rsqrtf(ss * (1.f / 128.f) + EPS);
            const size_t ro = (tok0 + (size_t)c * 64 + t) * DM + (size_t)h * 128 + es;
            f32x4 r[4];
#pragma unroll
            for (int q = 0; q < 4; ++q) { const f32x4 gn = *(const f32x4*)(gnorm + es + 4 * q);
#pragma unroll
                for (int j = 0; j < 4; ++j) r[q][j] = o[q][j] * rstd * gn[j] * (float)(q < 2 ? rg0[4 * q + j] : rg1[4 * (q - 2) + j]); }
            *(u32x4*)(OG + ro) = op_pk8(r[0], r[1]); *(u32x4*)(OG + ro + 8) = op_pk8(r[2], r[3]);
            if (c + 1 < 8) SCAN_LOAD_G(c + 1);
        }
    }
#undef SCAN_LOAD
#undef SCAN_LOAD_G
    if (PHASE_A) {
#pragma unroll
        for (int i = 0; i < 8; ++i)
#pragma unroll
            for (int r = 0; r < 4; ++r) STu[(16 * i + 4 * g + r) * 128 + 16 * w + fl] = X[i][r];
        if (w == 0) *(f32x2*)(ST + ST_ATOT + (size_t)u * 128 + 2 * lane) = (f32x2){__expf(cs0), __expf(cs1)};
    }
    __syncthreads();
}
__device__ __forceinline__ void scan_carry(float* __restrict__ ST, const int gtid, const int nthreads) {
    for (int i = gtid; i < 32 * 4096; i += nthreads) {
        const int bh = i >> 12, q = i & 4095, d = q >> 5;
        f32x4 s = {0.f, 0.f, 0.f, 0.f};
#pragma unroll
        for (int sc = 0; sc < 8; ++sc) { f32x4* p = (f32x4*)(ST + (size_t)(bh * 8 + sc) * 16384) + q;
            if (sc < 7) { const f32x4 l = *p; const float a = ST[ST_ATOT + (size_t)(bh * 8 + sc) * 128 + d]; *p = s; s = s * a + l; } else *p = s; }
    }
}
#undef MFMA16
}

namespace attn {
constexpr int D = 128;
constexpr float THR = 8.f;
constexpr bool WSKIP = false;
constexpr int OSTRIDE = DM;
constexpr float SCALE = 0.08838834764831845f;
constexpr int NW = 8, QBLK = 32, KVBLK = 64, QB = NW * QBLK;
constexpr int SHM_V = KVBLK * D * 2, SHM_K = KVBLK * D * 2;
constexpr int LDS_BYTES = 2 * SHM_V + 2 * SHM_K + NW * 96 * 4;
using bf16 = _Float16;
typedef short s16x8 __attribute__((ext_vector_type(8)));
typedef _Float16 bf16x8 __attribute__((ext_vector_type(8)));
typedef short s16x4 __attribute__((ext_vector_type(4)));
typedef float f32x16 __attribute__((ext_vector_type(16)));
template <class A, class Bt> struct same_t { static constexpr bool v = false; };
template <class A> struct same_t<A, A> { static constexpr bool v = true; };

#define KSWZ(row, colB) ((row) * 256 + ((colB) ^ (((row) & 7) << 4)))
#define SBAR() __builtin_amdgcn_sched_barrier(0)
__device__ __forceinline__ int v_st(int k, int c) { const int kk = (k & ~0xC) | ((k & 4) << 1) | ((k & 8) >> 1); return ((kk >> 3) * 4 + (c >> 5)) * 512 + ((kk & 7) * 32 + (c & 31)) * 2; }
__device__ __forceinline__ int v_rd_base(int lane) { return ((lane & 3) << 3) | (((lane >> 2) & 3) << 6) | (((lane >> 4) & 1) << 5) | (((lane >> 5) & 1) << 8); }
constexpr int v_rd_off(int d0, int ks, int half) { return d0 * 512 + ks * 4096 + half * 2048; }
__device__ __forceinline__ int crow(int r, int hi) { return (r & 3) + 8 * (r >> 2) + 4 * hi; }
__device__ __forceinline__ unsigned cvtpk(float lo, float hi) {
    unsigned r; asm volatile("v_cvt_pk_f16_f32 %0, %1, %2" : "=v"(r) : "v"(lo), "v"(hi)); return r;
}
__device__ __forceinline__ bf16x8 pack8(f32x4 a, f32x4 b) {
    u32x4 w = {cvtpk(a[0], a[1]), cvtpk(a[2], a[3]), cvtpk(b[0], b[1]), cvtpk(b[2], b[3])};
    return *reinterpret_cast<bf16x8*>(&w);
}
template <class T> __device__ __forceinline__ bf16x8 load8(const T* p) {
    if constexpr (same_t<T, float>::v) { return pack8(*(const f32x4*)p, *(const f32x4*)(p + 4)); }
    else { return *reinterpret_cast<const bf16x8*>(p); }
}
__device__ __forceinline__ void mask_tile(f32x16& p0, f32x16& p1, int dq, unsigned W) {
    const float NEG = -__builtin_inff();
#pragma unroll
    for (int r = 0; r < 16; ++r) {
        const int c = (r & 3) + 8 * (r >> 2);
        if ((unsigned)(dq - c) >= W) p0[r] = NEG;
        if ((unsigned)(dq - c - 32) >= W) p1[r] = NEG;
    }
}
__device__ __forceinline__ void partialSM(f32x16& p0, f32x16& p1, float& m_reg, float& mn, float& alpha, const bool rowok = true) {
    float pmax = p0[0]; for (int r = 1; r < 16; ++r) pmax = fmaxf(pmax, p0[r]); for (int r = 0; r < 16; ++r) pmax = fmaxf(pmax, p1[r]);
    { auto rr = __builtin_amdgcn_permlane32_swap(__float_as_uint(pmax), __float_as_uint(pmax), false, false);
      pmax = fmaxf(__uint_as_float(rr[0]), __uint_as_float(rr[1])); }
    pmax = rowok ? pmax : -__builtin_inff();
    constexpr float C2 = 1.4426950408889634f * SCALE;
    if (__builtin_expect(__all((pmax - m_reg) * SCALE <= THR), 1)) { mn = m_reg; alpha = 1.f; }
    else { mn = fmaxf(m_reg, pmax); alpha = __builtin_amdgcn_exp2f((m_reg - mn) * C2); m_reg = mn; }
    const float mnL = rowok ? -mn * C2 : -__builtin_inff();
    for (int r = 0; r < 16; ++r) p0[r] = fmaf(p0[r], C2, mnL); for (int r = 0; r < 16; ++r) p1[r] = fmaf(p1[r], C2, mnL);
    for (int r = 0; r < 16; ++r) p0[r] = __builtin_amdgcn_exp2f(p0[r]);
}
__device__ __forceinline__ void finishSM(f32x16& p0, f32x16& p1, float alpha, float& l_reg, bf16x8& pa0, bf16x8& pa1, bf16x8& pa2, bf16x8& pa3) {
    for (int r = 0; r < 16; ++r) p1[r] = __builtin_amdgcn_exp2f(p1[r]);
    float ps = 0; for (int r = 0; r < 16; ++r) ps += p0[r]; for (int r = 0; r < 16; ++r) ps += p1[r];
    { auto rr = __builtin_amdgcn_permlane32_swap(__float_as_uint(ps), __float_as_uint(ps), false, false);
      ps = __uint_as_float(rr[0]) + __uint_as_float(rr[1]); }
    l_reg = l_reg * alpha + ps;
#define PK4(P, B_, OUT) do { unsigned a0 = cvtpk(P[B_+0], P[B_+1]), a1 = cvtpk(P[B_+2], P[B_+3]);                          \
        unsigned b0 = cvtpk(P[B_+4], P[B_+5]), b1 = cvtpk(P[B_+6], P[B_+7]);                                             \
        auto r0 = __builtin_amdgcn_permlane32_swap(a0, b0, false, false); auto r1 = __builtin_amdgcn_permlane32_swap(a1, b1, false, false); \
        u32x4 w = {r0[0], r1[0], r0[1], r1[1]}; OUT = *reinterpret_cast<bf16x8*>(&w); } while (0)
    PK4(p0, 0, pa0); PK4(p0, 8, pa1); PK4(p1, 0, pa2); PK4(p1, 8, pa3);
#undef PK4
}
template <int KB, bool SK>
__device__ __forceinline__ void qkt(f32x16& p0, f32x16& p1, const char* K_lds, int r32, int hi, const bf16x8* qr, bool act) {
    if (SK && !act) { const float NEG = -__builtin_inff();
#pragma unroll
        for (int r = 0; r < 16; ++r) { p0[r] = NEG; p1[r] = NEG; } return; }
    p0 = f32x16{}; p1 = f32x16{};
    const char* kb[4];
#pragma unroll
    for (int dd = 0; dd < 4; ++dd) kb[dd] = K_lds + KB * SHM_K + KSWZ(r32, (dd * 16 + hi * 8) * 2);
#pragma unroll
    for (int d0 = 0; d0 < 8; ++d0) { const char* a = kb[d0 & 3] + (d0 >> 2) * 128;
        bf16x8 b0 = *reinterpret_cast<const bf16x8*>(a);
        bf16x8 b1 = *reinterpret_cast<const bf16x8*>(a + 32 * 256);
        p0 = __builtin_amdgcn_mfma_f32_32x32x16_f16(b0, qr[d0], p0, 0, 0, 0);
        p1 = __builtin_amdgcn_mfma_f32_32x32x16_f16(b1, qr[d0], p1, 0, 0, 0); }
}
template <int VB, bool SK>
__device__ __forceinline__ void pv_tile(f32x16* o, int vb0, bf16x8 pa0, bf16x8 pa1, bf16x8 pa2, bf16x8 pa3, bool act) {
    if (SK && !act) return;
#define TRRD(dst, off) asm volatile("ds_read_b64_tr_b16 %0, %1 offset:%2" : "=&v"(dst) : "v"(vb0), "i"(off) : "memory")
#define PV_D0(d0) do { s16x4 l0, l1, l2, l3, h0, h1, h2, h3; constexpr int b_ = VB * SHM_V + v_rd_off(d0, 0, 0);     \
        TRRD(l0, b_); TRRD(h0, b_ + 2048); TRRD(l1, b_ + 4096); TRRD(h1, b_ + 6144); TRRD(l2, b_ + 8192); TRRD(h2, b_ + 10240); TRRD(l3, b_ + 12288); TRRD(h3, b_ + 14336); \
        asm volatile("s_waitcnt lgkmcnt(0)" ::: "memory"); SBAR();                 \
        o[d0] = __builtin_amdgcn_mfma_f32_32x32x16_f16(pa0, __builtin_bit_cast(bf16x8, (s16x8){l0[0], l0[1], l0[2], l0[3], h0[0], h0[1], h0[2], h0[3]}), o[d0], 0, 0, 0);   \
        o[d0] = __builtin_amdgcn_mfma_f32_32x32x16_f16(pa1, __builtin_bit_cast(bf16x8, (s16x8){l1[0], l1[1], l1[2], l1[3], h1[0], h1[1], h1[2], h1[3]}), o[d0], 0, 0, 0);   \
        o[d0] = __builtin_amdgcn_mfma_f32_32x32x16_f16(pa2, __builtin_bit_cast(bf16x8, (s16x8){l2[0], l2[1], l2[2], l2[3], h2[0], h2[1], h2[2], h2[3]}), o[d0], 0, 0, 0);   \
        o[d0] = __builtin_amdgcn_mfma_f32_32x32x16_f16(pa3, __builtin_bit_cast(bf16x8, (s16x8){l3[0], l3[1], l3[2], l3[3], h3[0], h3[1], h3[2], h3[3]}), o[d0], 0, 0, 0); } while (0)
    PV_D0(0); PV_D0(1); PV_D0(2); PV_D0(3);
#undef PV_D0
#undef TRRD
}

template <class TIn, class TOut> struct BlockRef { const TIn* Q; const TIn* K; const TIn* V; TOut* O; int P0; const float* KM; int own; };
template <class TIn> struct Seam {
    bf16x8 qr[8];
    bf16x8 st_v0, st_v1, st_k0, st_k1; f32x4 sf0, sf1, sf2, sf3;
    f32x4 tq[16];
};
__device__ __forceinline__ int swa_jlo(int P0, int W) { const int lowk = P0 - W + 1; return lowk > 0 ? lowk / KVBLK : 0; }
#define ROW(p, k0, rr) ((p) + (size_t)((k0) + (rr)) * D + sc)
#define VMW() asm volatile("s_waitcnt vmcnt(0)" ::: "memory")
#define VMWN(n) asm volatile("s_waitcnt vmcnt(%0)" :: "i"(n) : "memory")
#define SLOAD_H(Kp, Vp, k0) do { S.st_v0 = load8<TIn>(ROW(Vp, k0, sr)); S.st_v1 = load8<TIn>(ROW(Vp, k0, 32 + sr));              \
                         S.st_k0 = load8<TIn>(ROW(Kp, k0, sr)); S.st_k1 = load8<TIn>(ROW(Kp, k0, 32 + sr)); } while (0)
#define SWRITE_HK(bf) do { *(bf16x8*)(K_lds + (bf) * SHM_K + kws) = S.st_k0; *(bf16x8*)(K_lds + (bf) * SHM_K + kws + 32 * 256) = S.st_k1; } while (0)
#define SWRITE_HV(bf) do { *(bf16x8*)(V_lds + (bf) * SHM_V + vst0) = S.st_v0; *(bf16x8*)(V_lds + (bf) * SHM_V + vst1) = S.st_v1; } while (0)
#define SWRITE_H(bf) do { SWRITE_HV(bf); SWRITE_HK(bf); } while (0)
#define SLOAD_F(p, k0) do { S.sf0 = *(const f32x4*)ROW(p, k0, sr); S.sf1 = *(const f32x4*)(ROW(p, k0, sr) + 4);                \
                            S.sf2 = *(const f32x4*)ROW(p, k0, 32 + sr); S.sf3 = *(const f32x4*)(ROW(p, k0, 32 + sr) + 4); } while (0)
#define SWRITE_KF(bf) do { *(bf16x8*)(K_lds + (bf) * SHM_K + kws) = pack8(S.sf0, S.sf1); *(bf16x8*)(K_lds + (bf) * SHM_K + kws + 32 * 256) = pack8(S.sf2, S.sf3); } while (0)
#define SWRITE_VF(bf) do { *(bf16x8*)(V_lds + (bf) * SHM_V + vst0) = pack8(S.sf0, S.sf1); *(bf16x8*)(V_lds + (bf) * SHM_V + vst1) = pack8(S.sf2, S.sf3); } while (0)
template <class TIn, class TOut>
__device__ __forceinline__ void causal_swa_prime(const BlockRef<TIn, TOut>& cur, char* lds, Seam<TIn>& S, const int wid) {
    constexpr bool F32 = same_t<TIn, float>::v;
    const int lane = lane_id_opaque(), tid = wid * 64 + lane, r32 = lane & 31, hi = lane >> 5;
    const int sr = tid >> 4, sc = (tid & 15) * 8, kws = KSWZ(sr, sc * 2); char* K_lds = lds + 2 * SHM_V;
    const int kb0 = 0;
    for (int d0 = 0; d0 < 8; ++d0) S.qr[d0] = load8<TIn>(cur.Q + (size_t)(wid * QBLK + r32) * D + d0 * 16 + hi * 8);
    if constexpr (F32) { SLOAD_F((const float*)cur.K, kb0); VMW(); SWRITE_KF(0); SBAR(); SLOAD_F((const float*)cur.V, kb0); }
    else { SLOAD_H(cur.K, cur.V, kb0); VMW(); SWRITE_HK(0); }
    __syncthreads();
}
template <class TIn, class TOut>
__device__ __forceinline__ void causal_swa_block(const BlockRef<TIn, TOut>& cur, const BlockRef<TIn, TOut>& nxt, int skv, char* lds, Seam<TIn>& S, const int wid) {
    constexpr bool F32 = same_t<TIn, float>::v;
    const int lane = lane_id_opaque(), tid = wid * 64 + lane, r32 = lane & 31, hi = lane >> 5;
    const int j_lo = 0, own = cur.own; constexpr int W = 0x7fffffff;
    int j_hi = (cur.P0 + QB - 1) / KVBLK + 1; if (j_hi > skv / KVBLK) j_hi = skv / KVBLK;
    const int NT = j_hi - j_lo;
    const int kbn = 0;
    const int qlo = cur.P0 + wid * QBLK, qm = qlo + r32 - 4 * hi;
    char* V_lds = lds; char* K_lds = lds + 2 * SHM_V;
    float* ws = (float*)(lds + 2 * SHM_V + 2 * SHM_K) + wid * 96; float* li_l = ws, * al_l = ws + 32; unsigned* sel_l = (unsigned*)(ws + 64);
    float m_reg = -1e30f, l_reg = 0; f32x16 o[4] = {};
    const int sr = tid >> 4, sc = (tid & 15) * 8, vst0 = v_st(sr, sc), vst1 = v_st(32 + sr, sc), kws = KSWZ(sr, sc * 2);
    const int vb0 = (int)(uintptr_t)V_lds + v_rd_base(lane);
    const TIn* Kh = cur.K; const TIn* Vh = cur.V;
#define RESC(a) do { if (__any((a) < 1.f)) { if (hi == 0) al_l[r32] = (a); asm volatile("s_waitcnt lgkmcnt(0)" ::: "memory");              \
                     for (int d_ = 0; d_ < 4; ++d_) for (int r = 0; r < 16; ++r) o[d_][r] *= al_l[crow(r, hi)]; } } while (0)
#define KBASE(t) ((j_lo + (t)) * KVBLK)
#define ACT(t) (KBASE(t) <= qlo + QBLK - 1 && KBASE(t) + KVBLK - 1 >= qlo - W + 1)
#define MASKT(P0_, P1_, t) do { const int kb_ = KBASE(t); if ((((t) >> 2) == own) && (kb_ + KVBLK - 1 > qlo)) mask_tile(P0_, P1_, qm - kb_, (unsigned)W); } while (0)
#define ROWOK(t) ((((t) >> 2) == own) || ((sel_l[r32] >> ((t) >> 2)) & 1u))
    constexpr int NQL = F32 ? 16 : 8;
    constexpr bool SK = WSKIP && !F32;
#define SEAM_K0() do { VMWN(NQL); if constexpr (F32) { SWRITE_KF(0); SBAR(); SLOAD_F((const float*)nxt.V, kbn); } else { SWRITE_HK(0); } SBAR(); } while (0)
    f32x16 pA0, pA1, pB0, pB1; float mnA, mnB, alA, alB; bf16x8 pa0, pa1, pa2, pa3;
    { f32x16 pg = {};
      const int jg = (r32 & 3) + 4 * (r32 >> 3); const bool live = (r32 & 4) == 0;
#pragma unroll
      for (int d0 = 0; d0 < 8; ++d0) { f32x4 a = {0.f, 0.f, 0.f, 0.f}, b2 = a;
          if (live) { a = *(const f32x4*)(cur.KM + jg * 128 + d0 * 16 + hi * 8); b2 = *(const f32x4*)(cur.KM + jg * 128 + d0 * 16 + hi * 8 + 4); }
          pg = __builtin_amdgcn_mfma_f32_32x32x16_f16(pack8(a, b2), S.qr[d0], pg, 0, 0, 0); }
      unsigned sel = 0u;
#pragma unroll
      for (int rep_ = 0; rep_ < 3; ++rep_) { float best = -__builtin_inff(); int bi = -1;
#pragma unroll
          for (int j = 0; j < 16; ++j) { const bool ok = (j < own) && !((sel >> j) & 1u) && (pg[j] > best); best = ok ? pg[j] : best; bi = ok ? j : bi; }
          if (bi >= 0) sel |= 1u << bi; }
      if (hi == 0) sel_l[r32] = sel;
      asm volatile("s_waitcnt lgkmcnt(0)" ::: "memory"); }
    if constexpr (F32) { VMW(); SWRITE_VF(0); SBAR(); } else { SWRITE_HV(0); SBAR(); }
    if (NT > 1) { if constexpr (F32) SLOAD_F((const float*)Kh, KBASE(1)); else SLOAD_H(Kh, Vh, KBASE(1)); }
    SBAR(); qkt<0, SK>(pA0, pA1, K_lds, r32, hi, S.qr, ACT(0));
    if constexpr (F32) { if (NT > 1) { VMW(); SWRITE_KF(1); SBAR(); SLOAD_F((const float*)Vh, KBASE(1)); } }
    MASKT(pA0, pA1, 0); partialSM(pA0, pA1, m_reg, mnA, alA, ROWOK(0));
    if (NT > 1) { VMW(); if constexpr (F32) { SWRITE_VF(1); SBAR(); if (NT > 2) SLOAD_F((const float*)Kh, KBASE(2)); } else SWRITE_H(1); }
    __syncthreads();
#define HALF_STEP(PX0, PX1, mnX, alX, PY0, PY1, alY, t, KB, VB, SB) do {                                                      \
        SBAR(); qkt<KB, SK>(PX0, PX1, K_lds, r32, hi, S.qr, ACT(t));                                             \
        finishSM(PY0, PY1, alY, l_reg, pa0, pa1, pa2, pa3); SBAR();                                                           \
        if ((t) + 1 < NT) { if constexpr (F32) { VMW(); SWRITE_KF(SB); SBAR(); SLOAD_F((const float*)Vh, KBASE((t) + 1)); }  \
                            else { SLOAD_H(Kh, Vh, KBASE((t) + 1)); } SBAR(); }                                               \
        pv_tile<VB, SK>(o, vb0, pa0, pa1, pa2, pa3, ACT((t) - 1)); MASKT(PX0, PX1, (t)); partialSM(PX0, PX1, m_reg, mnX, alX, ROWOK((t)));                                        \
        __syncthreads();                                                                                                      \
        if ((t) + 1 < NT) { VMW(); if constexpr (F32) { SWRITE_VF(SB); SBAR(); if ((t) + 2 < NT) SLOAD_F((const float*)Kh, KBASE((t) + 2)); } \
                            else { SWRITE_H(SB); } }                                                                          \
        RESC(alX); __syncthreads(); } while (0)
    for (int t = 1; t + 1 < NT; t += 2) {
        HALF_STEP(pB0, pB1, mnB, alB, pA0, pA1, alA, t, 1, 0, 0);
        HALF_STEP(pA0, pA1, mnA, alA, pB0, pB1, alB, t + 1, 0, 1, 1);
    }
    const bool even = (NT & 1) == 0;
    if (even) { SBAR(); qkt<1, SK>(pB0, pB1, K_lds, r32, hi, S.qr, ACT(NT - 1)); SBAR(); }
#define QROW(e) (nxt.Q + (size_t)(wid * QBLK + r32) * D + ((e) >> 1) * 16 + hi * 8 + ((e) & 1) * 4)
    if constexpr (F32) { SLOAD_F((const float*)nxt.K, kbn); SBAR();
#pragma unroll
        for (int e = 0; e < 8; ++e) S.tq[e] = *(const f32x4*)QROW(e); }
    else { SLOAD_H(nxt.K, nxt.V, kbn); SBAR();
#pragma unroll
        for (int d0 = 0; d0 < 8; ++d0) S.qr[d0] = load8<TIn>(nxt.Q + (size_t)(wid * QBLK + r32) * D + d0 * 16 + hi * 8); }
    SBAR();
    finishSM(pA0, pA1, alA, l_reg, pa0, pa1, pa2, pa3); SBAR();
    if constexpr (F32) {
#pragma unroll
        for (int e = 8; e < 16; ++e) S.tq[e] = *(const f32x4*)QROW(e); SBAR(); }
#undef QROW
    pv_tile<0, SK>(o, vb0, pa0, pa1, pa2, pa3, ACT(even ? NT - 2 : NT - 1));
    if (even) { MASKT(pB0, pB1, NT - 1); partialSM(pB0, pB1, m_reg, mnB, alB, ROWOK(NT - 1)); __syncthreads(); RESC(alB);
        finishSM(pB0, pB1, alB, l_reg, pa0, pa1, pa2, pa3); SBAR(); pv_tile<1, SK>(o, vb0, pa0, pa1, pa2, pa3, ACT(NT - 1)); }
    SBAR(); SEAM_K0();
    if (hi == 0) li_l[r32] = l_reg; asm volatile("s_waitcnt lgkmcnt(0)" ::: "memory");
    float rli[16];
#pragma unroll
    for (int r = 0; r < 16; ++r) rli[r] = __builtin_amdgcn_rcpf(li_l[crow(r, hi)]);
    TOut* Ow = cur.O + (size_t)(wid * QBLK) * OSTRIDE;
#pragma unroll
    for (int r = 0; r < 16; ++r) { const int orow = crow(r, hi);
#pragma unroll
        for (int d0 = 0; d0 < 4; ++d0) { const float v = o[d0][r] * rli[r];
            if constexpr (same_t<TOut, float>::v) { Ow[(size_t)orow * OSTRIDE + d0 * 32 + r32] = v; }
            else { const float vn = __shfl_xor(v, 1);
                   if ((r32 & 1) == 0) *(unsigned*)(Ow + (size_t)orow * OSTRIDE + d0 * 32 + r32) = op_pk2(v, vn); } } }
    if constexpr (F32) {
#pragma unroll
        for (int d0 = 0; d0 < 8; ++d0) S.qr[d0] = pack8(S.tq[2 * d0], S.tq[2 * d0 + 1]); }
    __syncthreads();
#undef RESC
#undef KBASE
#undef ACT
#undef MASKT
#undef ROWOK
#undef SEAM_K0
#undef HALF_STEP
}
#undef ROW
#undef VMW
#undef VMWN
#undef SLOAD_H
#undef SWRITE_HK
#undef SWRITE_HV
#undef SWRITE_H
#undef SLOAD_F
#undef SWRITE_KF
#undef SWRITE_VF
__device__ __forceinline__ BlockRef<f16, f16> moba_ref(const int L, const int pass, const f16* Q, const f16* K, const f16* V, const float* KM, f16* O) {
    const int grp = L >> 5, hq = (L >> 3) & 3, y = L & 7, b = grp >> 2, kvh = grp & 3, h = kvh * 4 + hq, qb = pass ? 15 - y : y;
    BlockRef<f16, f16> r;
    r.Q = Q + ((size_t)(b * NH + h) * SEQ + (size_t)qb * QB) * D; r.K = K + (size_t)(b * NKV + kvh) * SEQ * D; r.V = V + (size_t)(b * NKV + kvh) * SEQ * D;
    r.O = O + ((size_t)b * SEQ + (size_t)qb * QB) * OSTRIDE + h * D; r.P0 = qb * QB; r.KM = KM + (size_t)(b * NKV + kvh) * NBLK * D; r.own = qb;
    return r;
}
__device__ __forceinline__ void moba_phase(char* lds, const int wid, const int vcu, const int G, const f16* Q, const f16* K, const f16* V, const float* KM, f16* O) {
    constexpr int total = BATCH * NH * (NBLK / 2);
    int L = vcu; if (L >= total) return;
    int pass = 0;
    BlockRef<f16, f16> cur = moba_ref(L, 0, Q, K, V, KM, O);
    Seam<f16> S;
    causal_swa_prime<f16, f16>(cur, lds, S, wid);
    for (;;) {
        const bool more_pass = pass == 0, more_item = L + G < total, last = !more_pass && !more_item;
        int passn = pass + 1, Ln = L;
        if (!more_pass) { passn = 0; Ln = more_item ? L + G : L; }
        const BlockRef<f16, f16> nxt = last ? cur : moba_ref(Ln, passn, Q, K, V, KM, O);
        causal_swa_block<f16, f16>(cur, nxt, SEQ, lds, S, wid);
        if (last) break;
        cur = nxt; pass = passn; L = Ln;
    }
}
}

constexpr int NWAVES = 8;
constexpr int RING_BYTES = 131072, LDSCTL_OFF = RING_BYTES, MISC_OFF = LDSCTL_OFF + 320, LDS_BYTES = 147456;
constexpr size_t W16_GU = 0, W16_GU_SZ = (size_t)2 * FF * DM, W16_DN = 4 * W16_GU_SZ, W16_DN_SZ = (size_t)DM * FF, W16_IN = W16_DN + 4 * W16_DN_SZ, W16_OUT = W16_IN + (size_t)4 * DM * DM,
                 W16_KV = W16_OUT + (size_t)DM * DM, W16_Q = W16_KV + (size_t)1024 * DM, W16_O = W16_Q + (size_t)DM * DM, W16_END = W16_O + (size_t)DM * DM;
static_assert(WS_W16 + W16_END * 2 <= WS_END, "fp16 weights fit");
enum { PC_PRO = 0, PC_NORM0 = 1, PC_S0_FA = 2, PC_S0_FB = 3, PC_S0_NF = 4, PC_HG = 5, PC_SA = 6, PC_SB = 7, PC_SC = 8, PC_HO = 9, PC_NM0 = 10, PC_S1_FA = 11, PC_S1_FB = 12, PC_S1_NF = 13,
       PC_KV = 14, PC_S2_FA = 15, PC_S2_FB = 16, PC_S2_NF = 17, PC_QP = 18, PC_AT = 19, PC_OP = 20, PC_NM1 = 21, PC_S3_FA = 22, PC_S3_FB = 23, PC_S3_NF = 24, PC_END = 25 };

struct MegaArgs { const float* in[16]; float* out; unsigned char* ws; int lo, hi; };

enum { MAP_NAT = 0, MAP_SWIGLU = 1, MAP_ROT = 2, MAP_HGRN = 3 };
__device__ __forceinline__ int map_col(int kind, int nrot_rows, int n) {
    if (kind == MAP_SWIGLU) return ((n >> 7) & 1) * FF + (n >> 8) * 128 + (n & 127);
    if (kind == MAP_HGRN) { const int pn = n >> 8; return ((pn >> 2) & 3) * DM + ((pn & 3) + 4 * (pn >> 4)) * 256 + (n & 255); }
    if (kind == MAP_ROT && n < nrot_rows) return (2 * (n >> 8) + ((n >> 6) & 1)) * 128 + ((n >> 7) & 1) * 64 + (n & 63);
    return n;
}
constexpr int PTAB_OFF = LDSCTL_OFF + 1024;
__device__ __forceinline__ unsigned long long ldptr(LAS unsigned char* lds, int i) {
    const volatile LAS unsigned* t = (const volatile LAS unsigned*)(lds + PTAB_OFF) + 2 * i;
    const unsigned a = __builtin_amdgcn_readfirstlane(t[0]), b = __builtin_amdgcn_readfirstlane(t[1]);
    return ((unsigned long long)b << 32) | a;
}
struct ConvItem { const float* src; f16* dst; int N, K; };
__device__ __forceinline__ ConvItem conv_decode(const float* W, int K, int N, f16* WT, int kind, int nrot_rows, int item, int lane) {
    const int nblk = N >> 5, kb = item / nblk, nb = item - kb * nblk, k0 = kb * 64, n0 = nb * 32, ns0 = map_col(kind, nrot_rows, n0);
    const int r = lane >> 3, q = lane & 7;
    ConvItem c; c.src = W + (size_t)(k0 + 8 * r) * N + ns0 + 4 * q; c.dst = WT + (size_t)(n0 + 4 * q) * K + k0 + 8 * r; c.N = N; c.K = K; return c;
}
__device__ __forceinline__ void conv_load(const ConvItem& c, f32x4 (&v)[8]) {
#pragma unroll
    for (int i = 0; i < 8; ++i) v[i] = __builtin_nontemporal_load((const f32x4*)(c.src + (size_t)i * c.N));
}
__device__ __forceinline__ void conv_store(const ConvItem& c, const f32x4 (&v)[8]) {
#pragma unroll
    for (int nn = 0; nn < 4; ++nn) { const pg8::f32x8 o = {v[0][nn], v[1][nn], v[2][nn], v[3][nn], v[4][nn], v[5][nn], v[6][nn], v[7][nn]};
        *(u32x4*)(c.dst + (size_t)nn * c.K) = op_pk8((f32x4){o[0], o[1], o[2], o[3]}, (f32x4){o[4], o[5], o[6], o[7]}); }
}
constexpr int CI_GU = (DM / 64) * (2 * FF / 32), CI_DN = (FF / 64) * (DM / 32), CI_IN = (DM / 64) * (4 * DM / 32), CI_SQ = (DM / 64) * (DM / 32), CI_KV = (DM / 64) * (1024 / 32);
constexpr int CONV_NITEMS = 4 * CI_GU + 4 * CI_DN + CI_IN + CI_SQ + CI_KV + CI_SQ + CI_SQ;
constexpr int CR_GU0 = 0, CR_DN0 = 4 * CI_GU, CR_IN = CR_DN0 + 4 * CI_DN, CR_OUT = CR_IN + CI_IN, CR_KV = CR_OUT + CI_SQ, CR_Q = CR_KV + CI_KV, CR_O = CR_Q + CI_SQ;
static_assert(CR_O + CI_SQ == CONV_NITEMS, "conversion item ranges");
#define W16P_(wsb, off) ((f16*)((wsb) + WS_W16) + (off))
__device__ __forceinline__ ConvItem conv_item_of(LAS unsigned char* lds, unsigned char* ws, int it, int lane) {
    int r = it;
    if (r < 4 * CI_GU) { const int s = r / CI_GU; return conv_decode((const float*)ldptr(lds, 6) + (size_t)s * DM * 2 * FF, DM, 2 * FF, W16P_(ws, W16_GU + s * W16_GU_SZ), MAP_SWIGLU, 0, r - s * CI_GU, lane); } r -= 4 * CI_GU;
    if (r < 4 * CI_DN) { const int s = r / CI_DN; return conv_decode((const float*)ldptr(lds, 7) + (size_t)s * FF * DM, FF, DM, W16P_(ws, W16_DN + s * W16_DN_SZ), MAP_NAT, 0, r - s * CI_DN, lane); } r -= 4 * CI_DN;
    if (r < CI_IN) return conv_decode((const float*)ldptr(lds, 8), DM, 4 * DM, W16P_(ws, W16_IN), MAP_HGRN, 0, r, lane); r -= CI_IN;
    if (r < CI_SQ) return conv_decode((const float*)ldptr(lds, 11), DM, DM, W16P_(ws, W16_OUT), MAP_NAT, 0, r, lane); r -= CI_SQ;
    if (r < CI_KV) return conv_decode((const float*)ldptr(lds, 13), DM, 1024, W16P_(ws, W16_KV), MAP_ROT, 512, r, lane); r -= CI_KV;
    if (r < CI_SQ) return conv_decode((const float*)ldptr(lds, 14), DM, DM, W16P_(ws, W16_Q), MAP_ROT, DM, r, lane); r -= CI_SQ;
    return conv_decode((const float*)ldptr(lds, 15), DM, DM, W16P_(ws, W16_O), MAP_NAT, 0, r, lane);
}
__device__ __forceinline__ void conv_range(LAS unsigned char* lds, unsigned char* ws, int it0, int it1, int gw, int nw, int lane) {
    for (int it = it0 + gw; it < it1; it += 2 * nw) {
        const ConvItem a = conv_item_of(lds, ws, it, lane); f32x4 va[8], vb[8]; conv_load(a, va);
        const bool two = it + nw < it1;
        if (two) { const ConvItem b = conv_item_of(lds, ws, it + nw, lane); conv_load(b, vb); conv_store(a, va); conv_store(b, vb); }
        else conv_store(a, va);
    }
}

#define WSP(T, off) ((T)(ws + (off)))
#define PHASE_LANE() const int lane = lane_id_opaque(); const int tid = wave * 64 + lane; (void)tid
#define LDP(T, i) ((T)ldptr(lds, (i)))
#define PH_BEGIN if (pc >= lo && pc < hi) { unsigned char* const ws = LDP(unsigned char*, 17); PHASE_LANE();
#define PH_END if (pc + 1 < hi) xcd_barrier(bar, wave); } ++pc;
#define GEMM_CALL(EpiT, Aptr, Btptr, Nn, Kk, Eobj) do { pg8::Gemm g_{(const pg8::bf16_t*)(Aptr), (const pg8::bf16_t*)(Btptr), M, (Nn), (Kk)}; pg8::StaticOrder S_; S_.init(M, (Nn), G, bx); \
        pg8::gemm_phase<EpiT, pg8::StaticOrder, false, true>(lds, g_, S_, (Eobj), wave); } while (0)
#define W16P(off) (WSP(f16*, WS_W16) + (off))
#define SIDE_CONV(i0, i1) do { if (G == 256 && bx >= 128) conv_range(lds, ws, (i0), (i1), (bx - 128) * NWAVES + wave, 128 * NWAVES, lane); } while (0)


template <int s>
__device__ __forceinline__ void sub_body(LAS unsigned char* lds, const int G, const int bx, const int vcu, const int wave, const int lo, const int hi, const XcdBarrier bar, int& pc) {
    constexpr int l = s >> 1, half = s & 1;

        if (half == 1) {
            if (l == 0) {
                PH_BEGIN { pg8::EpiHgrn E{WSP(f16*, WS_QH), WSP(f16*, WS_KH), WSP(u16*, WS_VH), WSP(f16*, WS_GH), WSP(float*, WS_LF), WSP(const float*, WS_LBT)}; GEMM_CALL(pg8::EpiHgrn, WSP(f16*, WS_H), W16P(W16_IN), 4 * DM, DM, E); } PH_END
                PH_BEGIN { for (int u = vcu; u < 256; u += G) if ((u & 7) != 7) scan::scan_unit<true>(lds, u, wave, lane, WSP(const f16*, WS_QH), WSP(const f16*, WS_KH), WSP(const u16*, WS_VH), WSP(const f16*, WS_GH), WSP(const float*, WS_LF), LDP(const float*, 10), WSP(float*, WS_ST), WSP(f16*, WS_OG)); } PH_END
                PH_BEGIN { scan::scan_carry(WSP(float*, WS_ST), vcu * 512 + tid, G * 512); } PH_END
                PH_BEGIN { for (int u = vcu; u < 256; u += G) scan::scan_unit<false>(lds, u, wave, lane, WSP(const f16*, WS_QH), WSP(const f16*, WS_KH), WSP(const u16*, WS_VH), WSP(const f16*, WS_GH), WSP(const float*, WS_LF), LDP(const float*, 10), WSP(float*, WS_ST), WSP(f16*, WS_OG)); } PH_END
                PH_BEGIN { pg8::EpiF16 E{WSP(f16*, WS_Y), DM}; GEMM_CALL(pg8::EpiF16, WSP(f16*, WS_OG), W16P(W16_OUT), DM, DM, E); } PH_END
            } else {
                PH_BEGIN { pg8::EpiRot E{WSP(f16*, WS_Q), NH, WSP(const float*, WS_ROPE), nullptr, nullptr, DM / 256}; GEMM_CALL(pg8::EpiRot, WSP(f16*, WS_H), W16P(W16_Q), DM, DM, E); } PH_END
                PH_BEGIN { attn::moba_phase((char*)lds, wave, vcu, G, WSP(const f16*, WS_Q), WSP(const f16*, WS_K), WSP(const f16*, WS_V), WSP(const float*, WS_KMEAN), WSP(f16*, WS_O)); } PH_END
                PH_BEGIN { pg8::EpiF16 E{WSP(f16*, WS_Y), DM}; GEMM_CALL(pg8::EpiF16, WSP(f16*, WS_O), W16P(W16_O), DM, DM, E); } PH_END
            }
            PH_BEGIN
            {
                float* mods = WSP(float*, WS_MODS); const float* norm_pre = LDP(const float*, 4); const float* norm_post = LDP(const float*, 5);
                NormArgs2 a{}; a.x_in = WSP(const f16*, WS_X16); a.y = WSP(const f16*, WS_Y); a.x_out = WSP(f16*, WS_X16); a.h = WSP(f16*, WS_H); a.gate = mods + (size_t)(l * 2) * MODW + 1 * 3 * DM + 2 * DM; a.post = norm_post + (l * 3 + 1) * DM;
                a.pre = norm_pre + (l * 3 + 2) * DM; a.shift = mods + (size_t)(l * 2) * MODW + 2 * 3 * DM; a.scale = a.shift + DM; a.w = 1.0f; a.has_y = 1; a.has_h = 1;
                norm_rows_lds<true, true>(a, lds, vcu, G, wave, lane);
            }
            PH_END
        }
        if (s == 2) {
            PH_BEGIN { pg8::EpiRot E{WSP(f16*, WS_K), NKV, WSP(const float*, WS_ROPE), WSP(float*, WS_KMEAN), WSP(f16*, WS_V), 2}; GEMM_CALL(pg8::EpiRot, WSP(f16*, WS_HKV), W16P(W16_KV), 1024, DM, E);
                SIDE_CONV(CR_DN0 + 2 * CI_DN, CR_DN0 + 3 * CI_DN); SIDE_CONV(CR_Q, CONV_NITEMS); } PH_END
        }
        PH_BEGIN { pg8::EpiSwiGLU E{WSP(f16*, WS_ACT)}; GEMM_CALL(pg8::EpiSwiGLU, WSP(f16*, WS_H), W16P(W16_GU + s * W16_GU_SZ), 2 * FF, DM, E);
            if (s == 0) { SIDE_CONV(CR_DN0, CR_DN0 + CI_DN); SIDE_CONV(CR_IN, CR_KV); }
            if (s == 1) { SIDE_CONV(CR_DN0 + CI_DN, CR_DN0 + 2 * CI_DN); SIDE_CONV(CR_KV, CR_Q); SIDE_CONV(CR_GU0 + 2 * CI_GU, CR_GU0 + 3 * CI_GU); }
            if (s == 2) { SIDE_CONV(CR_GU0 + 3 * CI_GU, CR_GU0 + 4 * CI_GU); SIDE_CONV(CR_DN0 + 3 * CI_DN, CR_DN0 + 4 * CI_DN); }
        } PH_END
        PH_BEGIN { pg8::EpiF16 E{WSP(f16*, WS_Y), DM}; GEMM_CALL(pg8::EpiF16, WSP(f16*, WS_ACT), W16P(W16_DN + s * W16_DN_SZ), DM, FF, E); } PH_END
        PH_BEGIN
        {
            float* mods = WSP(float*, WS_MODS); const float* norm_pre = LDP(const float*, 4); const float* norm_post = LDP(const float*, 5);
            NormArgs2 a{}; a.x_in = (s == 0) ? (const void*)LDP(const float*, 0) : (const void*)WSP(const f16*, WS_X16); a.y = WSP(const f16*, WS_Y); a.x_out = (s == 3) ? (void*)LDP(float*, 16) : (void*)WSP(f16*, WS_X16);
            a.h = WSP(f16*, WS_H); a.h2 = WSP(f16*, WS_HKV); a.kvn = LDP(const float*, 12);
            a.gate = mods + (size_t)(l * 2) * MODW + (half * 2) * 3 * DM + 2 * DM; a.post = norm_post + (l * 3 + half * 2) * DM; a.w = 0.5f; a.has_y = 1;
            if (half == 0) { a.pre = norm_pre + (l * 3 + 1) * DM; a.shift = mods + (size_t)(l * 2) * MODW + 1 * 3 * DM; a.scale = a.shift + DM; a.has_h = 1; }
            else if (l == 0) { a.pre = norm_pre + 3 * DM; a.shift = mods + (size_t)2 * MODW; a.scale = a.shift + DM; a.has_h = 1; a.has_kv = 1; }
            else { a.pre = norm_pre; a.shift = mods; a.scale = mods; }
            norm_rows_lds<(s != 0), (s != 3)>(a, lds, vcu, G, wave, lane);
        }
        PH_END
    }

__global__ void __launch_bounds__(NWAVES * 64, 2) mega(MegaArgs args) {
    extern __shared__ __attribute__((aligned(16))) unsigned char lds_raw[];
    LAS unsigned char* lds = (LAS unsigned char*)lds_raw;
    volatile LAS unsigned* MISC = (volatile LAS unsigned*)(lds + MISC_OFF);
    const int wave = __builtin_amdgcn_readfirstlane(threadIdx.x >> 6);
    const int G = gridDim.x, bx = blockIdx.x, vcu = (G % 8 == 0) ? (bx % 8) * (G / 8) + bx / 8 : bx;
    const int lo = args.lo, hi = args.hi;
    { const int tid = threadIdx.x;
    if (tid < 18) ((LAS unsigned long long*)(lds + PTAB_OFF))[tid] = (tid < 16) ? (unsigned long long)args.in[tid] : (tid == 16 ? (unsigned long long)args.out : (unsigned long long)args.ws);
    for (int u = tid; u < 64; u += NWAVES * 64) ((LAS unsigned*)(lds + LDSCTL_OFF))[u + 80] = 0u; }
    __syncthreads();
    XcdBarrier bar; bar.bar = (unsigned*)(args.ws + WS_CTL) + 4096; bar.x = 0; bar.st = nullptr;
    if (hi - lo > 1) bar = xcd_barrier_post((unsigned*)(args.ws + WS_CTL) + 4096, MISC + 8);

    int pc = 0;
    PH_BEGIN
    {
        const float* cvec = LDP(const float*, 1); const float* ada_w = LDP(const float*, 2); const float* ada_b = LDP(const float*, 3);
        float* mods = WSP(float*, WS_MODS); float* rope = WSP(float*, WS_ROPE); float* kmean = WSP(float*, WS_KMEAN);
        LAS float* sc = (LAS float*)lds; LAS float* red = (LAS float*)(lds + 16384);
        for (int i = tid; i < 2 * DM; i += 512) sc[i] = silu_f(cvec[i]);
        __syncthreads();
        constexpr int nchunk = MODW / 64;
        for (int u = vcu; u < 2 * nchunk; u += G) {
            const int l = u / nchunk, c0 = (u % nchunk) * 64;
            const float* W = ada_w + (size_t)l * DM * MODW + c0 + lane;
            float a0 = 0.f, a1 = 0.f; const int k0 = wave * 256;
#pragma unroll 16
            for (int k = 0; k < 256; ++k) { const float wv = W[(size_t)(k0 + k) * MODW]; a0 += sc[k0 + k] * wv; a1 += sc[DM + k0 + k] * wv; }
            red[(wave * 2 + 0) * 64 + lane] = a0; red[(wave * 2 + 1) * 64 + lane] = a1;
            __syncthreads();
            if (tid < 128) { const int b = tid >> 6; float s = 0.f;
#pragma unroll
                for (int ww = 0; ww < 8; ++ww) s += red[(ww * 2 + b) * 64 + lane];
                mods[(size_t)(l * 2 + b) * MODW + c0 + lane] = s + ada_b[(size_t)l * MODW + c0 + lane]; }
            __syncthreads();
        }
        for (int i = vcu * 512 + tid; i < SEQ * 64; i += G * 512) { const int t = i >> 6, d = i & 63; const float inv = powf(10000.0f, -(float)d / 64.0f); const float ang = (float)t * inv; float s, c; sincosf(ang, &s, &c); rope[i] = c; rope[SEQ * 64 + i] = s; }
        for (int i = vcu * 512 + tid; i < BATCH * NKV * NBLK * 128; i += G * 512) kmean[i] = 0.f;
        { const float* hl = LDP(const float*, 9); float* lbt = WSP(float*, WS_LBT); for (int i = vcu * 512 + tid; i < DM; i += G * 512) lbt[i] = 1.f / (1.f + expf(hl[DM + i] - hl[i])); }
        if (G == 256) conv_range(lds, ws, CR_GU0, CR_GU0 + 2 * CI_GU, vcu * NWAVES + wave, G * NWAVES, lane);
        else conv_range(lds, ws, 0, CONV_NITEMS, vcu * NWAVES + wave, G * NWAVES, lane);
    }
    PH_END
    PH_BEGIN
    {
        float* mods = WSP(float*, WS_MODS);
        NormArgs2 a{}; a.x_in = LDP(const float*, 0); a.h = WSP(f16*, WS_H); a.pre = LDP(const float*, 4); a.shift = mods; a.scale = mods + DM; a.has_h = 1;
        norm_rows_lds<false, false>(a, lds, vcu, G, wave, lane);
    }
    PH_END
    sub_body<0>(lds, G, bx, vcu, wave, lo, hi, bar, pc);
    sub_body<1>(lds, G, bx, vcu, wave, lo, hi, bar, pc);
    sub_body<2>(lds, G, bx, vcu, wave, lo, hi, bar, pc);
    sub_body<3>(lds, G, bx, vcu, wave, lo, hi, bar, pc);
}

#define FAST_SCAN 1
#define FAST_ATTN 1
#ifndef N_LAUNCH_MODE
#define N_LAUNCH_MODE 1
#endif
extern "C" void kernel_launch(void* const* d_in, const int* in_sizes, int n_in, void* d_out, int out_size, void* d_ws, size_t ws_size, hipStream_t stream) {
    static int grid = 0;
    if (grid == 0) {
        if (n_in != 16 || out_size != M * DM || ws_size < WS_END) { fprintf(stderr, "kernel_launch: unexpected shapes (n_in %d out %d ws %zu)\n", n_in, out_size, ws_size); grid = -1; return; }
        int dev = 0, cus = 0, per_cu = 0;
        if (hipGetDevice(&dev) != hipSuccess || hipDeviceGetAttribute(&cus, hipDeviceAttributeMultiprocessorCount, dev) != hipSuccess) { grid = -1; return; }
        if (hipFuncSetAttribute((const void*)mega, hipFuncAttributeMaxDynamicSharedMemorySize, LDS_BYTES) != hipSuccess) { fprintf(stderr, "kernel_launch: hipFuncSetAttribute failed\n"); grid = -1; return; }
        if (hipOccupancyMaxActiveBlocksPerMultiprocessor(&per_cu, (const void*)mega, NWAVES * 64, LDS_BYTES) != hipSuccess || per_cu < 1) fprintf(stderr, "kernel_launch: occupancy query says %d\n", per_cu);
        (void)hipGetLastError();
        grid = cus;
    }
    if (grid < 0) return;
    unsigned char* ws = (unsigned char*)d_ws;
    (void)hipMemsetAsync(ws + WS_CTL, 0, 1 * MiB, stream);
    MegaArgs a{};
    for (int i = 0; i < 16; ++i) a.in[i] = (const float*)d_in[i];
    a.out = (float*)d_out; a.ws = ws;
#if N_LAUNCH_MODE == 1
    a.lo = 0; a.hi = PC_END;
    hipLaunchKernelGGL(mega, dim3(grid), dim3(NWAVES * 64), LDS_BYTES, stream, a);
#else
    f16* Kb = (f16*)(ws + WS_K); f16* Vb = (f16*)(ws + WS_V); float* kmean = (float*)(ws + WS_KMEAN);
    f16* QH = (f16*)(ws + WS_QH); f16* KH = (f16*)(ws + WS_KH); u16* VH = (u16*)(ws + WS_VH); f16* GH = (f16*)(ws + WS_GH); float* LF = (float*)(ws + WS_LF); f16* OG = (f16*)(ws + WS_OG);
    f16* Qb = (f16*)(ws + WS_Q); f16* Ob = (f16*)(ws + WS_O);
    for (int pc = 0; pc < PC_END; ++pc) {
#ifndef FAST_SCAN
        if (pc == PC_SA) { hipLaunchKernelGGL(k_naive_scan, dim3(BATCH * NH), dim3(128), 0, stream, QH, KH, VH, GH, LF, (const float*)d_in[10], OG); continue; }
        if (pc == PC_SB || pc == PC_SC) continue;
#endif
#ifndef FAST_ATTN
        if (pc == PC_AT) { hipLaunchKernelGGL(k_naive_attn, dim3(BATCH * NH * SEQ / 4), dim3(256), 0, stream, Qb, Kb, Vb, kmean, Ob); continue; }
#endif
        a.lo = pc; a.hi = pc + 1;
        int nrep = 1;
#ifdef PROBE_DUP
        { const int dup[][2] = PROBE_DUP; for (unsigned q = 0; q < sizeof(dup) / sizeof(dup[0]); ++q) if (dup[q][0] == pc) nrep += dup[q][1]; }
#endif
        for (int r = 0; r < nrep; ++r) hipLaunchKernelGGL(mega, dim3(grid), dim3(NWAVES * 64), LDS_BYTES, stream, a);
    }
#endif
}
```
